# Optimizing an MI355X kernel written in HIP

```python
import jax, jax.numpy as jnp
from jax import lax
import numpy as np

D_MODEL = 2048
BATCH = 1
SEQ = 8192
DEPTH = 1

GRID_W = 64
CTX_LEN = 256
MIX_WIDTH = D_MODEL
POOL_WIDTH = MIX_WIDTH // 2
POOL_WINDOWS = (2, 4, 8, 16)
N_POOL_GROUPS = len(POOL_WINDOWS)
POOL_GROUP = POOL_WIDTH // N_POOL_GROUPS
MLSTM_WIDTH = MIX_WIDTH - POOL_WIDTH
MLSTM_HEADS = 4
MLSTM_HEAD_DIM = MLSTM_WIDTH // MLSTM_HEADS
CHUNK = 64
QK_CONV = 3
N_GROUPS = 4
EXPERTS_PER_GROUP = 8
N_EXPERTS = N_GROUPS * EXPERTS_PER_GROUP
TOP_K = 2
D_EXPERT = 512
EPS = 1e-6
Q0 = POOL_WIDTH
O0 = Q0 + MLSTM_WIDTH
K0 = O0 + MLSTM_WIDTH
V0 = K0 + MLSTM_WIDTH
G0 = V0 + MLSTM_WIDTH
IN_COLS = G0 + 4 * MLSTM_HEADS

kernel_name = "hymba_pool_mlstm_hmoe_dit_layer"


def rmsnorm(x, g):
    xf = x.astype(jnp.float32)
    y = xf * lax.rsqrt(jnp.mean(xf * xf, axis=-1, keepdims=True) + EPS)
    return (y * g).astype(x.dtype)


def modulate(h, shift, scale):
    return h * (1.0 + scale) + shift


def adaln(cond, w, b):
    return jax.nn.silu(cond) @ w + b


def box_mean(x, win, axis):
    L = x.shape[axis]
    t = np.arange(L)
    lo = np.clip(t - win // 2, 0, L)
    hi = np.clip(t - win // 2 + win, 0, L)
    xf = jnp.moveaxis(x.astype(jnp.float32), axis, 0)
    cs = jnp.concatenate([jnp.zeros_like(xf[:1]), jnp.cumsum(xf, axis=0)], axis=0)
    cnt = jnp.asarray(hi - lo, jnp.float32).reshape((L,) + (1,) * (xf.ndim - 1))
    return jnp.moveaxis((cs[hi] - cs[lo]) / cnt, 0, axis)


def pool_mix(u, w_pool, pool_scale, rows):
    B, T, _ = u.shape
    ug = u.reshape(B, T, N_POOL_GROUPS, POOL_GROUP)
    diffs = []
    for gi, win in enumerate(POOL_WINDOWS):
        ux = ug[:, :, gi]
        if rows is None:
            mean = box_mean(ux, win, 1)
        else:
            grid = ux.reshape(B, rows, GRID_W, POOL_GROUP)
            mean = box_mean(box_mean(grid, win, 1), win, 2).reshape(B, T, POOL_GROUP)
        diffs.append(mean.astype(u.dtype) - ux)
    d = jnp.stack(diffs, axis=2)
    y = jnp.einsum("btgc,gcd->btgd", d, w_pool).reshape(B, T, POOL_WIDTH)
    return y * pool_scale


def dwconv(x, w):
    K, C = w.shape
    return lax.conv_general_dilated(x, w[:, None, :].astype(x.dtype), (1,), [(K // 2, K // 2)],
                                    dimension_numbers=("NWC", "WIO", "NWC"), feature_group_count=C)


def split_heads(a):
    B, T, _ = a.shape
    return a.reshape(B, T, MLSTM_HEADS, MLSTM_HEAD_DIM).transpose(0, 2, 1, 3)


def mlstm_q(u_q, w_conv_q):
    return split_heads(jax.nn.silu(dwconv(u_q, w_conv_q)) * (MLSTM_HEAD_DIM ** -0.5))


def mlstm_kv_gates(p, w_conv_k, gate_bias):
    B, T, _ = p.shape
    k = jax.nn.silu(dwconv(p[..., :MLSTM_WIDTH], w_conv_k))
    v = p[..., MLSTM_WIDTH:2 * MLSTM_WIDTH]
    gates = p[..., 2 * MLSTM_WIDTH:].astype(jnp.float32) + gate_bias.reshape(-1).astype(jnp.float32)
    gates = gates.reshape(B, T, 4, MLSTM_HEADS).transpose(2, 0, 3, 1)
    return split_heads(k), split_heads(v), gates


def zero_state(B):
    H, Dh = MLSTM_HEADS, MLSTM_HEAD_DIM
    return (jnp.zeros((B, H, Dh, Dh), jnp.float32), jnp.zeros((B, H, Dh), jnp.float32),
            jnp.zeros((B, H), jnp.float32))


def mlstm_scan(q, k, v, i_pre, f_pre, state):
    need_out = q is not None
    B, H, T, Dh = k.shape
    nc = T // CHUNK

    def chunks(a):
        a = a.reshape((B, H, nc, CHUNK) + a.shape[3:])
        return jnp.moveaxis(a, 2, 0)

    logf = jax.nn.log_sigmoid(f_pre)
    xs = (chunks(k.astype(jnp.float32)), chunks(v.astype(jnp.float32)), chunks(i_pre), chunks(logf))
    if need_out:
        xs = xs + (chunks(q.astype(jnp.float32)),)
    tril = jnp.tril(jnp.ones((CHUNK, CHUNK), dtype=bool))

    def step(carry, inp):
        C, n, m = carry
        kc, vc, ic, lfc = inp[:4]
        b = jnp.cumsum(lfc, axis=-1)
        g = b[..., -1]
        a = g[..., None] - b + ic
        m_new = jnp.maximum(g + m, jnp.max(a, axis=-1))
        decay = jnp.exp(g + m - m_new)
        wk = jnp.exp(a - m_new[..., None])
        C_new = decay[..., None, None] * C + jnp.einsum("bhl,bhlv,bhlk->bhvk", wk, vc, kc)
        n_new = decay[..., None] * n + jnp.einsum("bhl,bhlk->bhk", wk, kc)
        if not need_out:
            return (C_new, n_new, m_new), None
        qc = inp[4]
        dmat = b[..., :, None] - b[..., None, :] + ic[..., None, :]
        dmat = jnp.where(tril, dmat, -jnp.inf)
        inter = b + m[..., None]
        m_t = jnp.maximum(inter, jnp.max(dmat, axis=-1))
        w_inter = jnp.exp(inter - m_t)
        wts = jnp.exp(dmat - m_t[..., None]) * jnp.einsum("bhtd,bhsd->bhts", qc, kc)
        num = (w_inter[..., None] * jnp.einsum("bhvk,bhtk->bhtv", C, qc)
               + jnp.einsum("bhts,bhsv->bhtv", wts, vc))
        den = w_inter * jnp.einsum("bhk,bhtk->bht", n, qc) + jnp.sum(wts, axis=-1)
        h = num / jnp.maximum(jnp.abs(den), jnp.exp(-m_t))[..., None]
        return (C_new, n_new, m_new), h

    state, hs = lax.scan(step, state, xs)
    if not need_out:
        return state, None
    return state, jnp.moveaxis(hs, 0, 2).reshape(B, H, T, Dh)


def bidir_mlstm(q, k, v, gates, init_f, init_b):
    rev = lambda a: jnp.flip(a, axis=2)
    st_f, h_f = mlstm_scan(q, k, v, gates[0], gates[1], init_f)
    st_b, h_b = mlstm_scan(None if q is None else rev(q), rev(k), rev(v), rev(gates[2]), rev(gates[3]), init_b)
    h = None if q is None else h_f + rev(h_b)
    return st_f, st_b, h


def mlstm_readout(h, o_pre, head_g):
    B, H, T, Dh = h.shape
    mu = jnp.mean(h, axis=-1, keepdims=True)
    var = jnp.mean(jnp.square(h - mu), axis=-1, keepdims=True)
    hn = ((h - mu) * lax.rsqrt(var + EPS)).transpose(0, 2, 1, 3).reshape(B, T, H * Dh)
    return (hn * head_g).astype(o_pre.dtype) * jax.nn.sigmoid(o_pre)


def mix_out(u, h_m, w_pool, pool_scale, head_g, w_out, rows):
    p = pool_mix(u[..., :POOL_WIDTH], w_pool, pool_scale, rows)
    m = mlstm_readout(h_m, u[..., O0:K0], head_g)
    return jnp.concatenate([p, m], axis=-1) @ w_out


def hier_moe(xn, w_group, b_group, w_router, b_router, w1, w3, w2):
    B, T, D = xn.shape
    xt = xn.reshape(B * T, D)
    grp_logits = (xt @ w_group).astype(jnp.float32) + b_group
    p_grp = jax.nn.softmax(grp_logits, axis=-1)
    _, g_sel = lax.top_k(grp_logits, 1)
    exp_logits = ((xt @ w_router).astype(jnp.float32) + b_router).reshape(-1, N_GROUPS, EXPERTS_PER_GROUP)
    sel_logits = jnp.take_along_axis(exp_logits, g_sel[:, :, None], axis=1)[:, 0]
    p_exp = jax.nn.softmax(sel_logits, axis=-1)
    top_p, top_i = lax.top_k(p_exp, TOP_K)
    top_p = top_p / jnp.sum(top_p, axis=-1, keepdims=True)
    w_tok = jnp.take_along_axis(p_grp, g_sel, axis=1) * top_p
    eid = g_sel * EXPERTS_PER_GROUP + top_i
    combine = jnp.einsum("nk,nke->ne", w_tok, jax.nn.one_hot(eid, N_EXPERTS, dtype=jnp.float32)).astype(xt.dtype)
    y = jnp.zeros_like(xt)
    for e in range(N_EXPERTS):
        he = jax.nn.silu(xt @ w1[e]) * (xt @ w3[e])
        y = y + combine[:, e:e + 1] * (he @ w2[e])
    return y.reshape(B, T, D)


def setup_inputs(seed: int = 0) -> dict:
    key = jax.random.key(seed)
    ks = jax.random.split(key, 24)
    nrm = lambda k, s: jax.random.normal(k, s, jnp.float32)
    D = D_MODEL
    fb = jnp.linspace(3.0, 6.0, MLSTM_HEADS)
    zb = jnp.zeros((MLSTM_HEADS,), jnp.float32)
    gate_base = jnp.stack([zb, fb, zb, fb])
    return {
        "x": nrm(ks[0], (BATCH, SEQ, D)),
        "c": nrm(ks[1], (BATCH, D)),
        "ctx": nrm(ks[2], (BATCH, CTX_LEN, D)),
        "c_ctx": nrm(ks[3], (D,)),
        "w_mod": nrm(ks[4], (DEPTH, D, 6 * D)) * (0.5 * D ** -0.5),
        "b_mod": 0.02 * nrm(ks[5], (DEPTH, 6 * D)),
        "norm1_g": 1.0 + 0.02 * nrm(ks[6], (DEPTH, D)),
        "w_in": nrm(ks[7], (DEPTH, D, IN_COLS)) * D ** -0.5,
        "w_conv_q": nrm(ks[8], (DEPTH, QK_CONV, MLSTM_WIDTH)) * QK_CONV ** -0.5,
        "w_conv_k": nrm(ks[9], (DEPTH, QK_CONV, MLSTM_WIDTH)) * QK_CONV ** -0.5,
        "gate_bias": gate_base + 0.1 * nrm(ks[10], (DEPTH, 4, MLSTM_HEADS)),
        "head_norm_g": 1.0 + 0.02 * nrm(ks[11], (DEPTH, MLSTM_WIDTH)),
        "w_pool": nrm(ks[12], (DEPTH, N_POOL_GROUPS, POOL_GROUP, POOL_GROUP)) * POOL_GROUP ** -0.5,
        "pool_scale": 1.0 + 0.02 * nrm(ks[13], (DEPTH, POOL_WIDTH)),
        "w_out": nrm(ks[14], (DEPTH, MIX_WIDTH, D)) * MIX_WIDTH ** -0.5,
        "norm2_g": 1.0 + 0.02 * nrm(ks[15], (DEPTH, D)),
        "w_group": nrm(ks[16], (DEPTH, D, N_GROUPS)) * D ** -0.5,
        "b_group": 0.01 * nrm(ks[17], (DEPTH, N_GROUPS)),
        "w_router": nrm(ks[18], (DEPTH, D, N_EXPERTS)) * D ** -0.5,
        "b_router": 0.01 * nrm(ks[19], (DEPTH, N_EXPERTS)),
        "w1": nrm(ks[20], (DEPTH, N_EXPERTS, D, D_EXPERT)) * D ** -0.5,
        "w3": nrm(ks[21], (DEPTH, N_EXPERTS, D, D_EXPERT)) * D ** -0.5,
        "w2": nrm(ks[22], (DEPTH, N_EXPERTS, D_EXPERT, D)) * D_EXPERT ** -0.5,
        "final_g": 1.0 + 0.02 * nrm(ks[23], (D,)),
    }


def reference(x, c, ctx, c_ctx, w_mod, b_mod, norm1_g, w_in, w_conv_q, w_conv_k, gate_bias,
              head_norm_g, w_pool, pool_scale, w_out, norm2_g, w_group, b_group, w_router,
              b_router, w1, w3, w2, final_g):
    B = x.shape[0]
    rows = x.shape[1] // GRID_W
    D = D_MODEL
    h_lat, h_ctx = x, ctx
    for layer in range(DEPTH):
        last = layer == DEPTH - 1
        sh1, sc1, g1, sh2, sc2, g2 = jnp.split(adaln(c, w_mod[layer], b_mod[layer])[:, None, :], 6, axis=-1)
        n_ctx_mod = 2 if last else 6
        mod_ctx = jnp.split(adaln(c_ctx, w_mod[layer][:, :n_ctx_mod * D], b_mod[layer][:n_ctx_mod * D]),
                            n_ctx_mod, axis=-1)

        cn = modulate(rmsnorm(h_ctx, norm1_g[layer]), mod_ctx[0], mod_ctx[1])
        if last:
            uc_state = cn @ w_in[layer][:, K0:]
            q_c = None
        else:
            uc = cn @ w_in[layer]
            uc_state = uc[..., K0:]
            q_c = mlstm_q(uc[..., Q0:O0], w_conv_q[layer])
        k_c, v_c, gt_c = mlstm_kv_gates(uc_state, w_conv_k[layer], gate_bias[layer])
        st_f, st_b, hm_c = bidir_mlstm(q_c, k_c, v_c, gt_c, zero_state(B), zero_state(B))

        xn = modulate(rmsnorm(h_lat, norm1_g[layer]), sh1, sc1)
        u = xn @ w_in[layer]
        q_l = mlstm_q(u[..., Q0:O0], w_conv_q[layer])
        k_l, v_l, gt_l = mlstm_kv_gates(u[..., K0:], w_conv_k[layer], gate_bias[layer])
        _, _, hm_l = bidir_mlstm(q_l, k_l, v_l, gt_l, st_f, st_b)
        mix_l = mix_out(u, hm_l, w_pool[layer], pool_scale[layer], head_norm_g[layer], w_out[layer], rows)
        h_lat = h_lat + g1 * mix_l
        fn = modulate(rmsnorm(h_lat, norm2_g[layer]), sh2, sc2)
        h_lat = h_lat + g2 * hier_moe(fn, w_group[layer], b_group[layer], w_router[layer],
                                      b_router[layer], w1[layer], w3[layer], w2[layer])

        if not last:
            c_sh1, c_sc1, c_g1, c_sh2, c_sc2, c_g2 = mod_ctx
            mix_c = mix_out(uc, hm_c, w_pool[layer], pool_scale[layer], head_norm_g[layer], w_out[layer], None)
            h_ctx = h_ctx + c_g1 * mix_c
            fc = modulate(rmsnorm(h_ctx, norm2_g[layer]), c_sh2, c_sc2)
            h_ctx = h_ctx + c_g2 * hier_moe(fc, w_group[layer], b_group[layer], w_router[layer],
                                            b_router[layer], w1[layer], w3[layer], w2[layer])
    return rmsnorm(h_lat, final_g)
```

```cpp
#define STAGE 4
#define N_LAUNCHES 1
#include <hip/hip_runtime.h>
#include <hip/hip_cooperative_groups.h>
#include <cstdio>
#include <cstdint>
namespace cg = cooperative_groups;

#define LAS __attribute__((address_space(3)))
#define GAS __attribute__((address_space(1)))
typedef unsigned short bf16_t;
typedef short bf16x8 __attribute__((ext_vector_type(8)));
typedef float f32x4 __attribute__((ext_vector_type(4)));
typedef float f32x2 __attribute__((ext_vector_type(2)));
typedef unsigned u32x4 __attribute__((ext_vector_type(4)));
typedef unsigned u32x2 __attribute__((ext_vector_type(2)));
typedef __bf16 bf16x2_t __attribute__((ext_vector_type(2)));

constexpr int D = 2048, SEQ = 8192, CTXL = 256, MTOT = SEQ + CTXL;
constexpr int INC = 5136, NPAD = 5376;
constexpr int NCH = SEQ / 64, NCHT = MTOT / 64;
constexpr int NEXP = 32, DEXP = 512;
constexpr float EPSF = 1e-6f;

constexpr size_t MiB = 1u << 20;
constexpr size_t WS_CTL = 0;
constexpr size_t WS_MOD = 1 * MiB;
constexpr size_t WS_GATES = 2 * MiB;
constexpr size_t WS_E = 3 * MiB;
constexpr size_t WS_BC = 3 * MiB + 288 * 1024;
constexpr size_t WS_GC = 3 * MiB + 576 * 1024;
constexpr size_t WS_NST = 4 * MiB;
constexpr size_t WS_SUMSQ = 5 * MiB;
constexpr size_t WS_ROUTE = 6 * MiB;
constexpr size_t WS_PERM = 7 * MiB;
constexpr size_t WS_WPOOLT = 8 * MiB;
constexpr size_t WS_WOUTT = 9 * MiB;
constexpr size_t WS_WINT = 17 * MiB;
constexpr size_t WS_W13T = 38 * MiB;
constexpr size_t WS_W2T = 166 * MiB;
constexpr size_t WS_XN = 230 * MiB;
constexpr size_t WS_DP = 230 * MiB;
constexpr size_t WS_UP = 263 * MiB;
constexpr size_t WS_UQ = 279 * MiB;
constexpr size_t WS_A2 = 263 * MiB;
constexpr size_t WS_UO = 295 * MiB;
constexpr size_t WS_UK = 311 * MiB;
constexpr size_t WS_UV = 328 * MiB;
constexpr size_t WS_QC = 345 * MiB;
constexpr size_t WS_KC = 361 * MiB;
constexpr size_t WS_KT = 378 * MiB;
constexpr size_t WS_VT = 395 * MiB;
constexpr size_t WS_VSF = 413 * MiB;
constexpr size_t WS_VSB = 431 * MiB;
constexpr size_t WS_CST = 449 * MiB;
constexpr size_t WS_Y = 449 * MiB;
constexpr size_t WS_H = 545 * MiB;
constexpr size_t WS_FNS = 295 * MiB;
constexpr size_t WS_END = 577 * MiB;
constexpr int MAXSLOT = 24576;

constexpr int RING_BYTES = 131072;
constexpr int LDSCTL_OFF = RING_BYTES;
constexpr int LDS_BYTES = 147456;

__device__ __forceinline__ float bf2f(unsigned short b) { return __uint_as_float((unsigned)b << 16); }
__device__ __forceinline__ unsigned cvtpk(float lo, float hi) { f32x2 v = {lo, hi}; bf16x2_t b = __builtin_convertvector(v, bf16x2_t); return __builtin_bit_cast(unsigned, b); }
__device__ __forceinline__ float bflo(unsigned w) { return __uint_as_float(w << 16); }
__device__ __forceinline__ float bfhi(unsigned w) { return __uint_as_float(w & 0xffff0000u); }
__device__ __forceinline__ float siluf(float x) { return x / (1.0f + __expf(-x)); }
__device__ __forceinline__ float sigmoidf_(float x) { return 1.0f / (1.0f + __expf(-x)); }
__device__ __forceinline__ float logsigmoidf_(float x) { return fminf(x, 0.f) - log1pf(__expf(-fabsf(x))); }
__device__ __forceinline__ float wave_sum(float v) {
#pragma unroll
    for (int o = 1; o < 64; o <<= 1) v += __shfl_xor(v, o);
    return v;
}
__device__ __forceinline__ float wave_max(float v) {
#pragma unroll
    for (int o = 1; o < 64; o <<= 1) v = fmaxf(v, __shfl_xor(v, o));
    return v;
}
__device__ __forceinline__ int otid() { int t = threadIdx.x; asm volatile("" : "+v"(t)); return t; }
#define LDS_WAIT() asm volatile("s_waitcnt lgkmcnt(0)" ::: "memory")
#define VM_WAIT() asm volatile("s_waitcnt vmcnt(0)" ::: "memory")

struct Params { const float* in[24]; float* out; unsigned char* ws; int ph_lo, ph_hi; };
enum { I_X = 0, I_C, I_CTX, I_CCTX, I_WMOD, I_BMOD, I_N1G, I_WIN, I_WCQ, I_WCK, I_GB, I_HNG, I_WPOOL, I_PSC, I_WOUT, I_N2G, I_WGRP, I_BGRP, I_WRT, I_BRT, I_W1, I_W3, I_W2, I_FG };
namespace pg8 {
constexpr int BM = 256, BK = 64, HALF = 128, HTB = HALF * BK * 2, STAGE_BYTES = 8 * HTB, NXCD = 8, WGM = 8;
__host__ __device__ __forceinline__ int lds_byte(int r, int c) { const int st = (r >> 4) * 2 + (c >> 5), rr = r & 15, cc = c & 31, ob = rr * 64 + cc * 2; return st * 1024 + (ob ^ (((ob >> 9) & 1) << 5)); }
__host__ __device__ __forceinline__ void stage_rc(int b, int& R, int& C) { const int st = b / 1024, sb = b % 1024, swz = sb ^ (((sb >> 9) & 1) << 5); R = (st >> 1) * 16 + swz / 64; C = (st & 1) * 32 + (swz % 64) / 2; }
__host__ __device__ __forceinline__ int perm32(int rho) { const int n = rho >> 4, i = rho & 15; return 8 * (i >> 2) + 4 * n + (i & 3); }

struct Unit { int am, bn, acol, ex; };
struct Gemm { const bf16_t* A; const bf16_t* Bt; int lda, ldb, K; };

__device__ __forceinline__ void static_unit(int L, int nM, int nN, int& pm, int& pn) {
    const int nwg = nM * nN; int wgid = L; { const int q = nwg / NXCD, r = nwg % NXCD, xcd = wgid % NXCD, off = wgid / NXCD; wgid = (xcd < r ? xcd * (q + 1) : r * (q + 1) + (xcd - r) * q) + off; }
    const int nig = WGM * nN, gid = wgid / nig, fm = gid * WGM, gsz = (nM - fm) < WGM ? (nM - fm) : WGM;
    pm = fm + ((wgid % nig) % gsz); pn = (wgid % nig) / gsz;
}

template <class Epi, class Sched>
__device__ __forceinline__ void gemm_phase(LAS unsigned char* lds, const Gemm g, const Sched& S, const Epi& E) {
    const int tid = otid(), wid = __builtin_amdgcn_readfirstlane(tid >> 6), lane = tid & 63, wr = wid >> 2, wc = wid & 3, fr = lane & 15, fq = lane >> 4;
    const int K = g.K, nt = K / BK;
    unsigned voffA[2], voffB[2];
#pragma unroll
    for (int i = 0; i < 2; ++i) { int R, C; stage_rc(tid * 16 + i * 8192, R, C); const int Rb = Epi::PERM ? ((R & ~31) + perm32(R & 31)) : R;
        voffA[i] = (unsigned)(R * g.lda + C) * 2u; voffB[i] = (unsigned)(Rb * g.ldb + C) * 2u; }
    const size_t kstep = (size_t)(BK * 2);
    const size_t hstepA = (size_t)HALF * g.lda * 2, hstepB = (size_t)HALF * g.ldb * 2;
    const size_t tstepA = 2 * hstepA, tstepB = 2 * hstepB;
    const unsigned ldsw = (unsigned)wid * 1024u;
    const int aoff = lds_byte(wr * 64 + fr, fq * 8), boff = lds_byte(wc * 32 + fr, fq * 8);
#define PG8_SA(b, h) (((b) * 2 + (h)) * HTB)
#define PG8_SB(b, h) ((4 + (b) * 2 + (h)) * HTB)
#define PG8_STAGE(bufoff, gbase, voff) do { _Pragma("unroll") for (int _i = 0; _i < 2; ++_i) \
        __builtin_amdgcn_global_load_lds((const unsigned*)((const char*)(gbase) + (voff)[_i]), (LAS unsigned*)(lds + (bufoff) + ldsw + _i * 8192), 16, 0, 0); } while (0)
#define PG8_LDA(dst, b, h) do { _Pragma("unroll") for (int m = 0; m < 4; ++m) _Pragma("unroll") for (int k = 0; k < 2; ++k) dst[m][k] = *(const LAS bf16x8*)(lds + PG8_SA(b, h) + aoff + m * 2048 + k * 1024); } while (0)
#define PG8_LDB(dst, b, h) do { _Pragma("unroll") for (int n = 0; n < 2; ++n) _Pragma("unroll") for (int k = 0; k < 2; ++k) dst[n][k] = *(const LAS bf16x8*)(lds + PG8_SB(b, h) + boff + n * 2048 + k * 1024); } while (0)
#define PG8_MMA(ai, bj, At, Bt) do { __builtin_amdgcn_s_setprio(1); _Pragma("unroll") for (int m = 0; m < 4; ++m) _Pragma("unroll") for (int n = 0; n < 2; ++n) _Pragma("unroll") for (int k = 0; k < 2; ++k) \
        acc[ai][bj][m][n] = __builtin_amdgcn_mfma_f32_16x16x32_bf16(Bt[n][k], At[m][k], acc[ai][bj][m][n], 0, 0, 0); __builtin_amdgcn_s_setprio(0); } while (0)
#define PG8_WAIT_V(n) asm volatile("s_waitcnt vmcnt(" #n ")" ::: "memory")
#define PG8_WAIT_L(n) asm volatile("s_waitcnt lgkmcnt(" #n ")" ::: "memory")
#define PG8_BAR __builtin_amdgcn_s_barrier()
#define PG8_SCHED __builtin_amdgcn_sched_barrier(0)
    Unit cur, nxt; int ui = 0;
    if (!S.next(0, cur)) return;
    f32x4 acc[2][2][4][2];
#pragma unroll
    for (int a = 0; a < 2; ++a)
#pragma unroll
        for (int b = 0; b < 2; ++b)
#pragma unroll
            for (int m = 0; m < 4; ++m)
#pragma unroll
                for (int n = 0; n < 2; ++n) acc[a][b][m][n] = (f32x4){0.f, 0.f, 0.f, 0.f};
    bf16x8 At[4][2], B0[2][2], B1[2][2];
    const char* cA = (const char*)g.A + (size_t)cur.am * tstepA + (size_t)cur.acol * 2; const char* cB = (const char*)g.Bt + (size_t)cur.bn * tstepB;
    PG8_STAGE(PG8_SB(0, 0), cB, voffB); PG8_STAGE(PG8_SB(0, 1), cB + hstepB, voffB); PG8_STAGE(PG8_SA(0, 0), cA, voffA); PG8_STAGE(PG8_SA(0, 1), cA + hstepA, voffA);
    if (wr == 1) PG8_BAR;
    PG8_WAIT_V(2); PG8_BAR;
    PG8_STAGE(PG8_SB(1, 0), cB + kstep, voffB); PG8_STAGE(PG8_SA(1, 0), cA + kstep, voffA); PG8_STAGE(PG8_SB(1, 1), cB + hstepB + kstep, voffB);
    PG8_WAIT_V(6); PG8_BAR;
    for (;;) {
        const bool has_next = S.next(ui + 1, nxt);
        const char* nA = has_next ? (const char*)g.A + (size_t)nxt.am * tstepA + (size_t)nxt.acol * 2 : cA; const char* nB = has_next ? (const char*)g.Bt + (size_t)nxt.bn * tstepB : cB;
#pragma unroll 1
        for (int t = 0; t < nt; t += 2) {
            const bool last = (t == nt - 2);
            const char* a1 = cA + (size_t)(t + 1) * kstep;
            const char* a2 = last ? nA : cA + (size_t)(t + 2) * kstep; const char* b2 = last ? nB : cB + (size_t)(t + 2) * kstep;
            const char* a3 = a2 + kstep; const char* b3 = b2 + kstep;
            PG8_LDB(B0, 0, 0); PG8_LDB(B1, 0, 1); PG8_SCHED; PG8_LDA(At, 0, 0); PG8_STAGE(PG8_SA(1, 1), a1 + hstepA, voffA);
            PG8_WAIT_V(8); PG8_WAIT_L(0); PG8_BAR; PG8_MMA(0, 0, At, B0); PG8_MMA(0, 1, At, B1); PG8_BAR; PG8_SCHED;
            PG8_LDA(At, 0, 1); PG8_STAGE(PG8_SB(0, 0), b2, voffB); PG8_STAGE(PG8_SB(0, 1), b2 + hstepB, voffB); PG8_STAGE(PG8_SA(0, 0), a2, voffA);
            PG8_WAIT_V(8); PG8_WAIT_L(0); PG8_BAR; PG8_MMA(1, 0, At, B0); PG8_MMA(1, 1, At, B1); PG8_BAR; PG8_SCHED;
            PG8_LDB(B0, 1, 0); PG8_LDB(B1, 1, 1); PG8_SCHED; PG8_LDA(At, 1, 0); PG8_STAGE(PG8_SA(0, 1), a2 + hstepA, voffA);
            PG8_WAIT_V(8); PG8_WAIT_L(0); PG8_BAR; PG8_MMA(0, 0, At, B0); PG8_MMA(0, 1, At, B1); PG8_BAR; PG8_SCHED;
            PG8_LDA(At, 1, 1); PG8_STAGE(PG8_SB(1, 0), b3, voffB); PG8_STAGE(PG8_SB(1, 1), b3 + hstepB, voffB); PG8_STAGE(PG8_SA(1, 0), a3, voffA);
            PG8_WAIT_V(8); PG8_WAIT_L(0); PG8_BAR; PG8_MMA(1, 0, At, B0); PG8_MMA(1, 1, At, B1); PG8_BAR; PG8_SCHED;
        }
        if (wr == 0) PG8_BAR;
        E(acc, cur, wr, wc, fr, fq);
        if (!has_next) break;
#pragma unroll
        for (int a = 0; a < 2; ++a)
#pragma unroll
            for (int b = 0; b < 2; ++b)
#pragma unroll
                for (int m = 0; m < 4; ++m)
#pragma unroll
                    for (int n = 0; n < 2; ++n) acc[a][b][m][n] = (f32x4){0.f, 0.f, 0.f, 0.f};
        cur = nxt; cA = nA; cB = nB; ++ui;
        if (wr == 1) PG8_BAR;
    }
    PG8_WAIT_V(0);
    PG8_BAR;
#undef PG8_SA
#undef PG8_SB
#undef PG8_STAGE
#undef PG8_LDA
#undef PG8_LDB
#undef PG8_MMA
#undef PG8_WAIT_V
#undef PG8_WAIT_L
#undef PG8_BAR
#undef PG8_SCHED
}
}
using pg8::Unit;
struct SchedG1 { int G, c;
    __device__ __forceinline__ bool next(int i, Unit& u) const { const int L = i * G + c; if (L >= 681) return false;
        if (L < 672) { int pm, pn; pg8::static_unit(L, 32, 21, pm, pn); u.am = pm; u.bn = pn; } else { u.am = 32; u.bn = 12 + (L - 672); }
        u.acol = 0; u.ex = 0; return true; } };
struct EpiG1 { static constexpr bool PERM = true;
    unsigned char* ws; const float* gate_bias;
    __device__ __forceinline__ void operator()(const f32x4 (&acc)[2][2][4][2], const Unit& u, int wr, int wc, int fr, int fq) const {
        const int row0 = u.am * 256 + wr * 64 + fr; const int seg = u.bn >> 2;
        if (seg < 5) {
            const size_t so = seg == 0 ? WS_UP : seg == 1 ? WS_UQ : seg == 2 ? WS_UO : seg == 3 ? WS_UK : WS_UV;
            bf16_t* base = (bf16_t*)(ws + so); const int col0 = (u.bn & 3) * 256 + wc * 32 + 8 * fq;
#pragma unroll
            for (int ai = 0; ai < 2; ++ai)
#pragma unroll
                for (int m = 0; m < 4; ++m) { bf16_t* rowp = base + (size_t)(row0 + ai * 128 + m * 16) * 1024 + col0;
#pragma unroll
                    for (int bj = 0; bj < 2; ++bj) { const f32x4 v0 = acc[ai][bj][m][0], v1 = acc[ai][bj][m][1];
                        u32x4 w; w.x = cvtpk(v0[0], v0[1]); w.y = cvtpk(v0[2], v0[3]); w.z = cvtpk(v1[0], v1[1]); w.w = cvtpk(v1[2], v1[3]);
                        *(u32x4*)(rowp + bj * 128) = w; } }
        } else {
            if (wc == 0 && fq < 2) { float* G = (float*)(ws + WS_GATES);
                const f32x4 b0 = *(const f32x4*)(gate_bias + 8 * fq), b1 = *(const f32x4*)(gate_bias + 8 * fq + 4);
#pragma unroll
                for (int ai = 0; ai < 2; ++ai)
#pragma unroll
                    for (int m = 0; m < 4; ++m) { float* rowp = G + (size_t)(row0 + ai * 128 + m * 16) * 16 + 8 * fq;
                        *(f32x4*)(rowp) = acc[ai][0][m][0] + b0; *(f32x4*)(rowp + 4) = acc[ai][0][m][1] + b1; } }
        }
    } };
struct SchedPool { int G, c;
    __device__ __forceinline__ bool next(int i, Unit& u) const { if (c < 0) return false; const int L = i * G + c; if (L >= 128) return false;
        u.am = L >> 2; u.bn = L & 3; u.acol = (L & 3) * 256; u.ex = 0; return true; } };
struct EpiPool { static constexpr bool PERM = true;
    bf16_t* A2;
    __device__ __forceinline__ void operator()(const f32x4 (&acc)[2][2][4][2], const Unit& u, int wr, int wc, int fr, int fq) const {
        const int row0 = u.am * 256 + wr * 64 + fr; const int col0 = u.bn * 256 + wc * 32 + 8 * fq;
#pragma unroll
        for (int ai = 0; ai < 2; ++ai)
#pragma unroll
            for (int m = 0; m < 4; ++m) { bf16_t* rowp = A2 + (size_t)(row0 + ai * 128 + m * 16) * 2048 + col0;
#pragma unroll
                for (int bj = 0; bj < 2; ++bj) { const f32x4 v0 = acc[ai][bj][m][0], v1 = acc[ai][bj][m][1];
                    u32x4 w; w.x = cvtpk(v0[0], v0[1]); w.y = cvtpk(v0[2], v0[3]); w.z = cvtpk(v1[0], v1[1]); w.w = cvtpk(v1[2], v1[3]);
                    *(u32x4*)(rowp + bj * 128) = w; } }
    } };
struct SchedG2 { int G, c;
    __device__ __forceinline__ bool next(int i, Unit& u) const { const int L = i * G + c; if (L >= 256) return false;
        int pm, pn; pg8::static_unit(L, 32, 8, pm, pn); u.am = pm; u.bn = pn; u.acol = 0; u.ex = 0; return true; } };
struct EpiG2 { static constexpr bool PERM = false;
    const float* x; const float* g1; float* out; float* sumsq;
    __device__ __forceinline__ void operator()(const f32x4 (&acc)[2][2][4][2], const Unit& u, int wr, int wc, int fr, int fq) const {
        const int row0 = u.am * 256 + wr * 64 + fr, col0 = u.bn * 256 + wc * 32 + 4 * fq;
        f32x4 gv[2][2];
#pragma unroll
        for (int bj = 0; bj < 2; ++bj)
#pragma unroll
            for (int n = 0; n < 2; ++n) gv[bj][n] = *(const f32x4*)(g1 + col0 + bj * 128 + n * 16);
#pragma unroll
        for (int ai = 0; ai < 2; ++ai)
#pragma unroll
            for (int m = 0; m < 4; ++m) { const int row = row0 + ai * 128 + m * 16; const size_t off = (size_t)row * 2048 + col0; float ss = 0.f;
#pragma unroll
                for (int bj = 0; bj < 2; ++bj)
#pragma unroll
                    for (int n = 0; n < 2; ++n) { const f32x4 xv = *(const f32x4*)(x + off + bj * 128 + n * 16); const f32x4 h = xv + gv[bj][n] * acc[ai][bj][m][n];
                        *(f32x4*)(out + off + bj * 128 + n * 16) = h; ss += (h[0] * h[0] + h[1] * h[1]) + (h[2] * h[2] + h[3] * h[3]); }
                ss += __shfl_xor(ss, 16); ss += __shfl_xor(ss, 32);
                if (fq == 0) sumsq[(size_t)row * 32 + u.bn * 4 + wc] = ss; }
    } };
struct SchedMoE { int G, c, NN, btpe; const LAS int* tab;
    __device__ __forceinline__ bool next(int i, Unit& u) const { const int L = i * G + c; const int nt = tab[0]; if (L >= nt * NN) return false;
        const int tau = L / NN, pn = L - tau * NN; const int e = tab[1 + tau]; u.am = tau; u.bn = e * btpe + pn; u.acol = 0; u.ex = pn; return true; } };
struct EpiUp { static constexpr bool PERM = true;
    bf16_t* H;
    __device__ __forceinline__ void operator()(const f32x4 (&acc)[2][2][4][2], const Unit& u, int wr, int wc, int fr, int fq) const {
        const int row0 = u.am * 256 + wr * 64 + fr; const int col0 = u.ex * 128 + wc * 16 + 4 * fq;
#pragma unroll
        for (int ai = 0; ai < 2; ++ai)
#pragma unroll
            for (int m = 0; m < 4; ++m) { bf16_t* rowp = H + (size_t)(row0 + ai * 128 + m * 16) * 512 + col0;
#pragma unroll
                for (int bj = 0; bj < 2; ++bj) { const f32x4 v0 = acc[ai][bj][m][0], v1 = acc[ai][bj][m][1];
                    u32x2 w; w.x = cvtpk(siluf(v0[0]) * v0[1], siluf(v0[2]) * v0[3]); w.y = cvtpk(siluf(v1[0]) * v1[1], siluf(v1[2]) * v1[3]);
                    *(u32x2*)(rowp + bj * 64) = w; } }
    } };
struct EpiDown { static constexpr bool PERM = true;
    bf16_t* Y;
    __device__ __forceinline__ void operator()(const f32x4 (&acc)[2][2][4][2], const Unit& u, int wr, int wc, int fr, int fq) const {
        const int row0 = u.am * 256 + wr * 64 + fr; const int col0 = u.ex * 256 + wc * 32 + 8 * fq;
#pragma unroll
        for (int ai = 0; ai < 2; ++ai)
#pragma unroll
            for (int m = 0; m < 4; ++m) { bf16_t* rowp = Y + (size_t)(row0 + ai * 128 + m * 16) * 2048 + col0;
#pragma unroll
                for (int bj = 0; bj < 2; ++bj) { const f32x4 v0 = acc[ai][bj][m][0], v1 = acc[ai][bj][m][1];
                    u32x4 w; w.x = cvtpk(v0[0], v0[1]); w.y = cvtpk(v0[2], v0[3]); w.z = cvtpk(v1[0], v1[1]); w.w = cvtpk(v1[2], v1[3]);
                    *(u32x4*)(rowp + bj * 128) = w; } }
    } };
__device__ __forceinline__ void p0_adaln(const Params& P, LAS unsigned char* lds) {
    const int tid = otid();
    LAS float* sc = (LAS float*)lds; LAS float* scc = sc + 2048; LAS float* red = scc + 2048; LAS float* red2 = red + 42 * 48;
    const float* c = P.in[I_C]; const float* cc = P.in[I_CCTX]; const float* wmod = P.in[I_WMOD]; const float* bmod = P.in[I_BMOD];
    float* mod = (float*)(P.ws + WS_MOD); float* modc = mod + 16384;
    for (int i = tid; i < 2048; i += 512) { sc[i] = siluf(c[i]); scc[i] = siluf(cc[i]); }
    __syncthreads();
    for (int cb = blockIdx.x; cb < 256; cb += gridDim.x) {
        const int n0 = 48 * cb; const bool has_ctx = n0 < 4096;
        if (tid < 504) { const int col4 = tid % 12, rg = tid / 12;
            const f32x4* wp = (const f32x4*)(wmod + n0) + col4;
            f32x4 a = {0.f, 0.f, 0.f, 0.f}, a2 = {0.f, 0.f, 0.f, 0.f};
#pragma unroll 7
            for (int k = rg; k < 2048; k += 42) { const f32x4 w = wp[(size_t)k * 3072]; a += w * sc[k]; if (has_ctx) a2 += w * scc[k]; }
            *(LAS f32x4*)(red + rg * 48 + col4 * 4) = a; *(LAS f32x4*)(red2 + rg * 48 + col4 * 4) = a2; }
        __syncthreads();
        if (tid < 48) { float s = 0.f; for (int r = 0; r < 42; ++r) s += red[r * 48 + tid]; mod[n0 + tid] = s + bmod[n0 + tid]; }
        else if (has_ctx && tid >= 64 && tid < 112) { const int t = tid - 64; if (n0 + t < 4096) { float s = 0.f; for (int r = 0; r < 42; ++r) s += red2[r * 48 + t]; modc[n0 + t] = s + bmod[n0 + t]; } }
        __syncthreads();
    }
}
__device__ __forceinline__ void transpose_item(const float* W, int K, int N, bf16_t* WT, int row_off, int rmul, LAS float* scr, int item, int lane, const float* nscale = nullptr) {
    const int nblk = (N + 31) >> 5, kb = item / nblk, nb = item - kb * nblk, k0 = 64 * kb, n0 = 32 * nb;
    const int nn = n0 + (lane & 31); const bool ok = nn < N; const float scl = (nscale && ok) ? nscale[nn] : 1.0f;
#pragma unroll 8
    for (int i = 0; i < 32; ++i) { const int kk = 2 * i + (lane >> 5); scr[kk * 33 + (lane & 31)] = ok ? W[(size_t)(k0 + kk) * N + nn] * scl : 0.f; }
    LDS_WAIT(); asm volatile("" ::: "memory");
    const int cch = lane & 7;
#pragma unroll
    for (int j = 0; j < 4; ++j) { const int n = (lane >> 3) + 8 * j; const LAS float* s = scr + (8 * cch) * 33 + n;
        u32x4 o; o.x = cvtpk(s[0 * 33], s[1 * 33]); o.y = cvtpk(s[2 * 33], s[3 * 33]); o.z = cvtpk(s[4 * 33], s[5 * 33]); o.w = cvtpk(s[6 * 33], s[7 * 33]);
        *(u32x4*)(WT + (size_t)(row_off + (n0 + n) * rmul) * K + k0 + 8 * cch) = o; }
    LDS_WAIT(); asm volatile("" ::: "memory");
}
__device__ __forceinline__ void p0_transposes(const Params& P, LAS unsigned char* lds, int lo_item, int hi_item) {
    const int tid = otid(), lane = tid & 63, wave = __builtin_amdgcn_readfirstlane(tid >> 6);
    LAS float* scr = (LAS float*)(lds + 32768 + wave * 8704);
    const int gw = blockIdx.x * 8 + wave, NGW = gridDim.x * 8;
    constexpr int I_IN = 32 * 161, I_OUT = 32 * 64, I_PL = 4 * 32, I_E13 = 32 * 16, I_E2 = 8 * 64;
    constexpr int B_OUT = I_IN, B_PL = B_OUT + I_OUT, B_W1 = B_PL + I_PL, B_W3 = B_W1 + 32 * I_E13, B_W2 = B_W3 + 32 * I_E13, B_END = B_W2 + 32 * I_E2;
    if (hi_item > B_END) hi_item = B_END;
    for (int it = lo_item + gw; it < hi_item; it += NGW) {
        if (it < B_OUT) transpose_item(P.in[I_WIN], 2048, INC, (bf16_t*)(P.ws + WS_WINT), 0, 1, scr, it, lane);
        else if (it < B_PL) transpose_item(P.in[I_WOUT], 2048, 2048, (bf16_t*)(P.ws + WS_WOUTT), 0, 1, scr, it - B_OUT, lane);
        else if (it < B_W1) { const int r = it - B_PL, g = r >> 5; transpose_item(P.in[I_WPOOL] + (size_t)g * 65536, 256, 256, (bf16_t*)(P.ws + WS_WPOOLT) + (size_t)g * 65536, 0, 1, scr, r & 31, lane, P.in[I_PSC] + g * 256); }
        else if (it < B_W3) { const int r = it - B_W1, e = r / I_E13; transpose_item(P.in[I_W1] + (size_t)e * 2048 * 512, 2048, 512, (bf16_t*)(P.ws + WS_W13T) + (size_t)e * 1024 * 2048, 0, 2, scr, r - e * I_E13, lane); }
        else if (it < B_W2) { const int r = it - B_W3, e = r / I_E13; transpose_item(P.in[I_W3] + (size_t)e * 2048 * 512, 2048, 512, (bf16_t*)(P.ws + WS_W13T) + (size_t)e * 1024 * 2048, 1, 2, scr, r - e * I_E13, lane); }
        else { const int r = it - B_W2, e = r / I_E2; transpose_item(P.in[I_W2] + (size_t)e * 512 * 2048, 512, 2048, (bf16_t*)(P.ws + WS_W2T) + (size_t)e * 2048 * 512, 0, 1, scr, r - e * I_E2, lane); }
    }
}
constexpr int TR_ITEMS_EARLY = 32 * 161 + 32 * 64 + 4 * 32;
constexpr int TR_ITEMS_ALL = TR_ITEMS_EARLY + 64 * 512 + 32 * 512;
__device__ __forceinline__ void p0_zero_pad(const Params& P) {
    u32x4* z = (u32x4*)((bf16_t*)(P.ws + WS_WINT) + (size_t)5152 * 2048); const int n = (NPAD - 5152) * 2048 / 8;
    for (int i = blockIdx.x * 512 + threadIdx.x; i < n; i += gridDim.x * 512) z[i] = (u32x4){0u, 0u, 0u, 0u};
}
__device__ __forceinline__ void p1_xn(const Params& P) {
    const int tid = otid(), lane = tid & 63, wave = tid >> 6;
    const int gw = blockIdx.x * 8 + wave, NGW = gridDim.x * 8;
    const float* mod = (const float*)(P.ws + WS_MOD); const float* modc = mod + 16384; const float* g = P.in[I_N1G];
    bf16_t* XN = (bf16_t*)(P.ws + WS_XN);
    for (int pass = 0; pass < 2; ++pass) {
        const float* sh = pass == 0 ? mod : modc; const float* scl = pass == 0 ? mod + 2048 : modc + 2048;
        const float* src = pass == 0 ? P.in[I_X] : P.in[I_CTX]; const int nrows = pass == 0 ? SEQ : CTXL; const int rbase = pass == 0 ? 0 : SEQ;
        if (gw >= nrows) continue;
        f32x4 a[8], s[8];
#pragma unroll
        for (int j = 0; j < 8; ++j) { const int d0 = 4 * lane + 256 * j; const f32x4 gg = *(const f32x4*)(g + d0), sv = *(const f32x4*)(scl + d0); a[j] = gg * (sv + 1.0f); s[j] = *(const f32x4*)(sh + d0); }
        for (int r = gw; r < nrows; r += NGW) {
            const f32x4* xr = (const f32x4*)(src + (size_t)r * D) + lane; f32x4 v[8]; float ss = 0.f;
#pragma unroll
            for (int j = 0; j < 8; ++j) { v[j] = xr[64 * j]; ss += (v[j][0] * v[j][0] + v[j][1] * v[j][1]) + (v[j][2] * v[j][2] + v[j][3] * v[j][3]); }
            const float rstd = 1.0f / sqrtf(wave_sum(ss) * (1.0f / D) + EPSF);
            u32x2* o = (u32x2*)(XN + (size_t)(rbase + r) * D) + lane;
#pragma unroll
            for (int j = 0; j < 8; ++j) { const f32x4 y = v[j] * rstd * a[j] + s[j]; u32x2 w; w.x = cvtpk(y[0], y[1]); w.y = cvtpk(y[2], y[3]); o[64 * j] = w; }
        }
    }
}
__device__ __forceinline__ void p3_qk_task(const Params& P, int isk, int j, int h) {
    const int tid = otid(), o = tid >> 6, f4 = tid & 63;
    const int t0 = 64 * j, seq_lo = j < 128 ? 0 : SEQ, seq_hi = j < 128 ? SEQ : MTOT;
    const bf16_t* U = (const bf16_t*)(P.ws + (isk ? WS_UK : WS_UQ)); const float* wc = P.in[isk ? I_WCK : I_WCQ];
    const int f0 = h * 256 + 4 * f4;
    const f32x4 w0 = *(const f32x4*)(wc + f0), w1 = *(const f32x4*)(wc + 1024 + f0), w2 = *(const f32x4*)(wc + 2048 + f0);
    const float osc = isk ? 1.0f : 0.0625f;
    u32x2 raw[10];
#pragma unroll
    for (int i = 0; i < 10; ++i) { const int t = t0 + 8 * o - 1 + i; raw[i] = (t >= seq_lo && t < seq_hi) ? *(const u32x2*)(U + (size_t)t * 1024 + f0) : (u32x2){0u, 0u}; }
    float outv[8][4];
#pragma unroll
    for (int i = 0; i < 8; ++i) {
        const f32x4 a = {bflo(raw[i].x), bfhi(raw[i].x), bflo(raw[i].y), bfhi(raw[i].y)}, b = {bflo(raw[i + 1].x), bfhi(raw[i + 1].x), bflo(raw[i + 1].y), bfhi(raw[i + 1].y)},
                    c = {bflo(raw[i + 2].x), bfhi(raw[i + 2].x), bflo(raw[i + 2].y), bfhi(raw[i + 2].y)};
        const f32x4 s = a * w0 + b * w1 + c * w2;
#pragma unroll
        for (int e = 0; e < 4; ++e) outv[i][e] = siluf(s[e]) * osc;
    }
    bf16_t* R = (bf16_t*)(P.ws + (isk ? WS_KC : WS_QC));
#pragma unroll
    for (int i = 0; i < 8; ++i) { u32x2 w; w.x = cvtpk(outv[i][0], outv[i][1]); w.y = cvtpk(outv[i][2], outv[i][3]); *(u32x2*)(R + (size_t)(t0 + 8 * o + i) * 1024 + f0) = w; }
    if (isk) { bf16_t* KT = (bf16_t*)(P.ws + WS_KT);
#pragma unroll
        for (int e = 0; e < 4; ++e) { u32x4 w; w.x = cvtpk(outv[0][e], outv[1][e]); w.y = cvtpk(outv[2][e], outv[3][e]); w.z = cvtpk(outv[4][e], outv[5][e]); w.w = cvtpk(outv[6][e], outv[7][e]);
            *(u32x4*)(KT + (size_t)(f0 + e) * MTOT + t0 + 8 * o) = w; } }
}
__device__ __forceinline__ void p3_v_task(const Params& P, LAS unsigned char* lds, int j, int h) {
    const int tid = otid(), lane = tid & 63, wave = tid >> 6, o = tid >> 6, f4 = tid & 63;
    const int t0 = 64 * j; LAS float* wkl = (LAS float*)lds;
    __syncthreads();
    if (wave < 2) { const int d = wave; const float* G = (const float*)(P.ws + WS_GATES) + (size_t)(t0 + lane) * 16;
        const float ig = G[(2 * d) * 4 + h], fg = G[(2 * d + 1) * 4 + h];
        float b = logsigmoidf_(fg);
        if (d == 0) {
#pragma unroll
            for (int s = 1; s < 64; s <<= 1) { const float t = __shfl_up(b, s); if (lane >= s) b += t; }
        } else {
#pragma unroll
            for (int s = 1; s < 64; s <<= 1) { const float t = __shfl_down(b, s); if (lane + s < 64) b += t; }
        }
        const float gtot = __shfl(b, d == 0 ? 63 : 0); const float e = ig - b; const float em = wave_max(e);
        const size_t ix = (size_t)(d * 4 + h) * MTOT + t0 + lane;
        ((float*)(P.ws + WS_E))[ix] = e; ((float*)(P.ws + WS_BC))[ix] = b;
        if (lane == 0) { float* gc = (float*)(P.ws + WS_GC); gc[(d * 4 + h) * 132 + j] = gtot; gc[2048 + (d * 4 + h) * 132 + j] = em; }
        wkl[d * 64 + lane] = __expf(e - em);
    }
    __syncthreads();
    const bf16_t* U = (const bf16_t*)(P.ws + WS_UV); const int f0 = h * 256 + 4 * f4;
    float v[8][4];
#pragma unroll
    for (int i = 0; i < 8; ++i) { const u32x2 r = *(const u32x2*)(U + (size_t)(t0 + 8 * o + i) * 1024 + f0); v[i][0] = bflo(r.x); v[i][1] = bfhi(r.x); v[i][2] = bflo(r.y); v[i][3] = bfhi(r.y); }
    bf16_t* VT = (bf16_t*)(P.ws + WS_VT); bf16_t* VSF = (bf16_t*)(P.ws + WS_VSF); bf16_t* VSB = (bf16_t*)(P.ws + WS_VSB);
    float sf[8], sb[8];
#pragma unroll
    for (int i = 0; i < 8; ++i) { sf[i] = wkl[8 * o + i]; sb[i] = wkl[64 + 8 * o + i]; }
#pragma unroll
    for (int e = 0; e < 4; ++e) { const size_t off = (size_t)(h * 272 + 4 * f4 + e) * MTOT + t0 + 8 * o; u32x4 w;
        w.x = cvtpk(v[0][e], v[1][e]); w.y = cvtpk(v[2][e], v[3][e]); w.z = cvtpk(v[4][e], v[5][e]); w.w = cvtpk(v[6][e], v[7][e]); *(u32x4*)(VT + off) = w;
        w.x = cvtpk(v[0][e] * sf[0], v[1][e] * sf[1]); w.y = cvtpk(v[2][e] * sf[2], v[3][e] * sf[3]); w.z = cvtpk(v[4][e] * sf[4], v[5][e] * sf[5]); w.w = cvtpk(v[6][e] * sf[6], v[7][e] * sf[7]); *(u32x4*)(VSF + off) = w;
        w.x = cvtpk(v[0][e] * sb[0], v[1][e] * sb[1]); w.y = cvtpk(v[2][e] * sb[2], v[3][e] * sb[3]); w.z = cvtpk(v[4][e] * sb[4], v[5][e] * sb[5]); w.w = cvtpk(v[6][e] * sb[6], v[7][e] * sb[7]); *(u32x4*)(VSB + off) = w; }
    if (tid < 128) {
        const int rr = tid >> 3, oc = tid & 7; const size_t off = (size_t)(h * 272 + 256 + rr) * MTOT + t0 + 8 * oc; u32x4 w1 = {0u, 0u, 0u, 0u}, wf = w1, wb = w1;
        if (rr == 0) { w1 = (u32x4){0x3f803f80u, 0x3f803f80u, 0x3f803f80u, 0x3f803f80u};
            wf.x = cvtpk(wkl[8 * oc], wkl[8 * oc + 1]); wf.y = cvtpk(wkl[8 * oc + 2], wkl[8 * oc + 3]); wf.z = cvtpk(wkl[8 * oc + 4], wkl[8 * oc + 5]); wf.w = cvtpk(wkl[8 * oc + 6], wkl[8 * oc + 7]);
            wb.x = cvtpk(wkl[64 + 8 * oc], wkl[64 + 8 * oc + 1]); wb.y = cvtpk(wkl[64 + 8 * oc + 2], wkl[64 + 8 * oc + 3]); wb.z = cvtpk(wkl[64 + 8 * oc + 4], wkl[64 + 8 * oc + 5]); wb.w = cvtpk(wkl[64 + 8 * oc + 6], wkl[64 + 8 * oc + 7]); }
        *(u32x4*)(VT + off) = w1; *(u32x4*)(VSF + off) = wf; *(u32x4*)(VSB + off) = wb; }
}
__device__ __forceinline__ void p3_pool_task(const Params& P, LAS unsigned char* lds, int r, int gi) {
    const int tid = otid(), chunk = tid & 31, cb = tid >> 5; const int win = 2 << gi, hw = win >> 1;
    const int rlo = max(r - hw, 0), rhi = min(r - hw + win, 128);
    const bf16_t* U = (const bf16_t*)(P.ws + WS_UP) + gi * 256 + 8 * chunk; LAS float* vs = (LAS float*)lds;
    __syncthreads();
    float own[4][8];
#pragma unroll
    for (int i = 0; i < 4; ++i) { const int c = cb + 16 * i; float a[8];
#pragma unroll
        for (int e = 0; e < 8; ++e) a[e] = 0.f;
        for (int rr = rlo; rr < rhi; ++rr) { const u32x4 w = *(const u32x4*)(U + (size_t)(rr * 64 + c) * 1024);
            const float x[8] = {bflo(w.x), bfhi(w.x), bflo(w.y), bfhi(w.y), bflo(w.z), bfhi(w.z), bflo(w.w), bfhi(w.w)};
#pragma unroll
            for (int e = 0; e < 8; ++e) a[e] += x[e];
            if (rr == r) {
#pragma unroll
                for (int e = 0; e < 8; ++e) own[i][e] = x[e]; } }
        *(LAS f32x4*)(vs + c * 256 + 8 * chunk) = (f32x4){a[0], a[1], a[2], a[3]}; *(LAS f32x4*)(vs + c * 256 + 8 * chunk + 4) = (f32x4){a[4], a[5], a[6], a[7]}; }
    __syncthreads();
    bf16_t* Dp = (bf16_t*)(P.ws + WS_DP) + gi * 256 + 8 * chunk;
#pragma unroll
    for (int i = 0; i < 4; ++i) { const int c = cb + 16 * i; const int clo = max(c - hw, 0), chi = min(c - hw + win, 64);
        f32x4 s0 = {0.f, 0.f, 0.f, 0.f}, s1 = s0;
        for (int cc = clo; cc < chi; ++cc) { s0 += *(const LAS f32x4*)(vs + cc * 256 + 8 * chunk); s1 += *(const LAS f32x4*)(vs + cc * 256 + 8 * chunk + 4); }
        const float inv = 1.0f / (float)((rhi - rlo) * (chi - clo));
        u32x4 w; w.x = cvtpk(s0[0] * inv - own[i][0], s0[1] * inv - own[i][1]); w.y = cvtpk(s0[2] * inv - own[i][2], s0[3] * inv - own[i][3]);
        w.z = cvtpk(s1[0] * inv - own[i][4], s1[1] * inv - own[i][5]); w.w = cvtpk(s1[2] * inv - own[i][6], s1[3] * inv - own[i][7]);
        *(u32x4*)(Dp + (size_t)(r * 64 + c) * 1024) = w; }
}
__device__ __forceinline__ void p3_all(const Params& P, LAS unsigned char* lds) {
    for (int t = blockIdx.x; t < 2080; t += gridDim.x) {
        if (t < 512) p3_qk_task(P, 0, t >> 2, t & 3);
        else if (t < 1040) p3_qk_task(P, 1, (t - 512) >> 2, (t - 512) & 3);
        else if (t < 1568) p3_v_task(P, lds, (t - 1040) >> 2, (t - 1040) & 3);
        else p3_pool_task(P, lds, (t - 1568) >> 2, (t - 1568) & 3);
    }
}
__device__ __forceinline__ int step_chunk(int d, int j) { return d == 0 ? (j < 4 ? 128 + j : j - 4) : (j < 4 ? 131 - j : 131 - j); }
__device__ __forceinline__ void p4_state(const Params& P, LAS unsigned char* lds, int sb) {
    const int tid = otid(), lane = tid & 63, wave = __builtin_amdgcn_readfirstlane(tid >> 6);
    const int hd = sb / 18, h = hd >> 1, d = hd & 1;
    LAS float* tg = (LAS float*)lds; LAS float* te = tg + 132; LAS float* tdec = te + 132; LAS float* tsf = tdec + 132;
    const float* gc = (const float*)(P.ws + WS_GC);
    if (tid < 132) { const int ci = step_chunk(d, tid); tg[tid] = gc[(d * 4 + h) * 132 + ci]; te[tid] = gc[2048 + (d * 4 + h) * 132 + ci]; }
    __syncthreads();
    if (tid == 0) { float m = 0.f; float* mst = (float*)(P.ws + WS_GC) + 4096 + (d * 4 + h) * 132; const bool wr = (sb % 18) == 0;
        for (int j = 0; j < 132; ++j) { const float em = te[j], Mf = fmaxf(m, em); tdec[j] = __expf(m - Mf); tsf[j] = __expf(em - Mf); if (wr) mst[step_chunk(d, j)] = m; m = tg[j] + Mf; } }
    __syncthreads();
    const int wt = sb * 8 + wave, rem = wt % 144, kt = rem / 9, vg = rem % 9; const int ntile = vg < 8 ? 2 : 1, vt0 = vg < 8 ? 2 * vg : 16;
    const int fr = lane & 15, fq = lane >> 4;
    const bf16_t* KT = (const bf16_t*)(P.ws + WS_KT) + (size_t)(h * 256 + kt * 16 + fr) * MTOT + 8 * fq;
    const bf16_t* VS = (const bf16_t*)(P.ws + (d == 0 ? WS_VSF : WS_VSB)) + (size_t)(h * 272 + vt0 * 16 + fr) * MTOT + 8 * fq;
    bf16_t* CST = (bf16_t*)(P.ws + WS_CST); float* NST = (float*)(P.ws + WS_NST);
    f32x4 C0 = {0.f, 0.f, 0.f, 0.f}, C1 = C0;
    bf16x8 a[2], b0[2], b1[2], na[2], nb0[2], nb1[2];
    { const int tc = 64 * step_chunk(d, 0);
#pragma unroll
      for (int ks = 0; ks < 2; ++ks) { a[ks] = *(const bf16x8*)(KT + tc + 32 * ks); b0[ks] = *(const bf16x8*)(VS + tc + 32 * ks); b1[ks] = ntile == 2 ? *(const bf16x8*)(VS + (size_t)16 * MTOT + tc + 32 * ks) : b0[ks]; } }
    for (int j = 0; j < 132; ++j) {
        if (j + 1 < 132) { const int tc = 64 * step_chunk(d, j + 1);
#pragma unroll
            for (int ks = 0; ks < 2; ++ks) { na[ks] = *(const bf16x8*)(KT + tc + 32 * ks); nb0[ks] = *(const bf16x8*)(VS + tc + 32 * ks); nb1[ks] = ntile == 2 ? *(const bf16x8*)(VS + (size_t)16 * MTOT + tc + 32 * ks) : nb0[ks]; } }
        const int ci = step_chunk(d, j);
        if (ci < 128) {
            if (vt0 < 16) { bf16_t* cp = CST + ((((size_t)ci * 4 + h) * 2 + d) * 256 + vt0 * 16 + fr) * 256 + kt * 16 + 4 * fq;
                u32x2 w; w.x = cvtpk(C0[0], C0[1]); w.y = cvtpk(C0[2], C0[3]); *(u32x2*)cp = w;
                w.x = cvtpk(C1[0], C1[1]); w.y = cvtpk(C1[2], C1[3]); *(u32x2*)(cp + 16 * 256) = w;
            } else if (fr == 0) { *(f32x4*)(NST + (((size_t)ci * 4 + h) * 2 + d) * 256 + kt * 16 + 4 * fq) = C0; }
        }
        f32x4 D0 = {0.f, 0.f, 0.f, 0.f}, D1 = D0;
#pragma unroll
        for (int ks = 0; ks < 2; ++ks) { D0 = __builtin_amdgcn_mfma_f32_16x16x32_bf16(a[ks], b0[ks], D0, 0, 0, 0); D1 = __builtin_amdgcn_mfma_f32_16x16x32_bf16(a[ks], b1[ks], D1, 0, 0, 0); }
        const float dec = tdec[j], sf = tsf[j];
        C0 = C0 * dec + D0 * sf; C1 = C1 * dec + D1 * sf;
#pragma unroll
        for (int ks = 0; ks < 2; ++ks) { a[ks] = na[ks]; b0[ks] = nb0[ks]; b1[ks] = nb1[ks]; }
    }
}
constexpr int O_QS = 0, O_KS = 33792, O_VT = 67584, O_WS = 106752, O_SC = 125184, O_DEN = 127232, O_RED = 127744, O_END = 131840;
__device__ __forceinline__ void p5_task(const Params& P, LAS unsigned char* lds, int c, int h) {
    const int tid = otid(), lane = tid & 63, wave = __builtin_amdgcn_readfirstlane(tid >> 6), fr = lane & 15, fq = lane >> 4;
    const int t0 = 64 * c;
    LAS float* Es = (LAS float*)(lds + O_SC); LAS float* Ms = Es + 128; LAS float* Wi = Ms + 128; LAS float* Fl = Wi + 128; LAS float* dens = (LAS float*)(lds + O_DEN); LAS float* red = (LAS float*)(lds + O_RED);
    __syncthreads();
    { const bf16_t* Q = (const bf16_t*)(P.ws + WS_QC) + (size_t)t0 * 1024 + h * 256; const bf16_t* Kc = (const bf16_t*)(P.ws + WS_KC) + (size_t)t0 * 1024 + h * 256;
#pragma unroll
      for (int i = 0; i < 4; ++i) { const int idx = tid + 512 * i, r = idx >> 5, ch = idx & 31;
          const u32x4 qv = *(const u32x4*)(Q + (size_t)r * 1024 + 8 * ch), kv = *(const u32x4*)(Kc + (size_t)r * 1024 + 8 * ch);
          *(LAS u32x4*)(lds + O_QS + r * 528 + 16 * ch) = qv; *(LAS u32x4*)(lds + O_KS + r * 528 + 16 * ch) = kv; }
      const bf16_t* VT = (const bf16_t*)(P.ws + WS_VT) + (size_t)(h * 272) * MTOT + t0;
      for (int idx = tid; idx < 272 * 8; idx += 512) { const int r = idx >> 3, ch = idx & 7; *(LAS u32x4*)(lds + O_VT + r * 144 + 16 * ch) = *(const u32x4*)(VT + (size_t)r * MTOT + 8 * ch); } }
    if (wave < 2) { const int d = wave; const size_t ix = (size_t)(d * 4 + h) * MTOT + t0 + lane;
        const float e = ((const float*)(P.ws + WS_E))[ix], b = ((const float*)(P.ws + WS_BC))[ix]; const float m = ((const float*)(P.ws + WS_GC))[4096 + (d * 4 + h) * 132 + c];
        float pm = e;
        if (d == 0) {
#pragma unroll
            for (int s = 1; s < 64; s <<= 1) { const float t = __shfl_up(pm, s); if (lane >= s) pm = fmaxf(pm, t); }
        } else {
#pragma unroll
            for (int s = 1; s < 64; s <<= 1) { const float t = __shfl_down(pm, s); if (lane + s < 64) pm = fmaxf(pm, t); }
        }
        const float Mt = fmaxf(m, pm);
        Es[d * 64 + lane] = e; Ms[d * 64 + lane] = Mt; Wi[d * 64 + lane] = __expf(m - Mt); Fl[d * 64 + lane] = __expf(-(b + Mt)); }
    __syncthreads();
    { const int st = wave >> 1, tt0 = 2 * (wave & 1); f32x4 S0 = {0.f, 0.f, 0.f, 0.f}, S1 = S0;
#pragma unroll
      for (int ks = 0; ks < 8; ++ks) { const bf16x8 ak = *(const LAS bf16x8*)(lds + O_KS + (16 * st + fr) * 528 + 64 * ks + 16 * fq);
          const bf16x8 bq0 = *(const LAS bf16x8*)(lds + O_QS + (16 * tt0 + fr) * 528 + 64 * ks + 16 * fq), bq1 = *(const LAS bf16x8*)(lds + O_QS + (16 * tt0 + 16 + fr) * 528 + 64 * ks + 16 * fq);
          S0 = __builtin_amdgcn_mfma_f32_16x16x32_bf16(ak, bq0, S0, 0, 0, 0); S1 = __builtin_amdgcn_mfma_f32_16x16x32_bf16(ak, bq1, S1, 0, 0, 0); }
      const int s0 = 16 * st + 4 * fq;
#pragma unroll
      for (int d = 0; d < 2; ++d) { const f32x4 ev = *(const LAS f32x4*)(Es + d * 64 + s0);
#pragma unroll
          for (int q = 0; q < 2; ++q) { const int t = 16 * (tt0 + q) + fr; const float Mt = Ms[d * 64 + t]; const f32x4 S = q == 0 ? S0 : S1; float w[4];
#pragma unroll
              for (int i = 0; i < 4; ++i) { const int s = s0 + i; const bool on = d == 0 ? (s <= t) : (s >= t); w[i] = on ? __expf(ev[i] - Mt) * S[i] : 0.f; }
              u32x2 pk; pk.x = cvtpk(w[0], w[1]); pk.y = cvtpk(w[2], w[3]); *(LAS u32x2*)(lds + O_WS + (d * 64 + t) * 144 + 2 * s0) = pk; } } }
    __syncthreads();
    f32x4 acc[2][2][4];
    const bf16_t* CST = (const bf16_t*)(P.ws + WS_CST);
#pragma unroll
    for (int d = 0; d < 2; ++d) {
        const bf16_t* Cp = CST + ((((size_t)c * 4 + h) * 2 + d) * 256 + 32 * wave + fr) * 256 + 8 * fq;
        bf16x8 ca[2][8];
#pragma unroll
        for (int v = 0; v < 2; ++v)
#pragma unroll
            for (int ks = 0; ks < 8; ++ks) ca[v][ks] = *(const bf16x8*)(Cp + (size_t)v * 16 * 256 + 32 * ks);
#pragma unroll
        for (int v = 0; v < 2; ++v)
#pragma unroll
            for (int tt = 0; tt < 4; ++tt) acc[d][v][tt] = (f32x4){0.f, 0.f, 0.f, 0.f};
#pragma unroll
        for (int ks = 0; ks < 8; ++ks) {
#pragma unroll
            for (int tt = 0; tt < 4; ++tt) { const bf16x8 bq = *(const LAS bf16x8*)(lds + O_QS + (16 * tt + fr) * 528 + 64 * ks + 16 * fq);
                acc[d][0][tt] = __builtin_amdgcn_mfma_f32_16x16x32_bf16(ca[0][ks], bq, acc[d][0][tt], 0, 0, 0); acc[d][1][tt] = __builtin_amdgcn_mfma_f32_16x16x32_bf16(ca[1][ks], bq, acc[d][1][tt], 0, 0, 0); } }
#pragma unroll
        for (int tt = 0; tt < 4; ++tt) { const float wi = Wi[d * 64 + 16 * tt + fr]; acc[d][0][tt] *= wi; acc[d][1][tt] *= wi; }
#pragma unroll
        for (int ks = 0; ks < 2; ++ks) { const bf16x8 va0 = *(const LAS bf16x8*)(lds + O_VT + (32 * wave + fr) * 144 + 64 * ks + 16 * fq), va1 = *(const LAS bf16x8*)(lds + O_VT + (32 * wave + 16 + fr) * 144 + 64 * ks + 16 * fq);
#pragma unroll
            for (int tt = 0; tt < 4; ++tt) { const bf16x8 bw = *(const LAS bf16x8*)(lds + O_WS + (d * 64 + 16 * tt + fr) * 144 + 64 * ks + 16 * fq);
                acc[d][0][tt] = __builtin_amdgcn_mfma_f32_16x16x32_bf16(va0, bw, acc[d][0][tt], 0, 0, 0); acc[d][1][tt] = __builtin_amdgcn_mfma_f32_16x16x32_bf16(va1, bw, acc[d][1][tt], 0, 0, 0); } }
    }
    { const int tt = wave & 3, d = wave >> 2; f32x4 dn = {0.f, 0.f, 0.f, 0.f};
      const float* np = (const float*)(P.ws + WS_NST) + (((size_t)c * 4 + h) * 2 + d) * 256 + 8 * fq;
#pragma unroll
      for (int ks = 0; ks < 8; ++ks) { bf16x8 an = {0, 0, 0, 0, 0, 0, 0, 0};
          if (fr == 0) { const f32x4 n0 = *(const f32x4*)(np + 32 * ks), n1 = *(const f32x4*)(np + 32 * ks + 4); u32x4 w; w.x = cvtpk(n0[0], n0[1]); w.y = cvtpk(n0[2], n0[3]); w.z = cvtpk(n1[0], n1[1]); w.w = cvtpk(n1[2], n1[3]); an = __builtin_bit_cast(bf16x8, w); }
          const bf16x8 bq = *(const LAS bf16x8*)(lds + O_QS + (16 * tt + fr) * 528 + 64 * ks + 16 * fq);
          dn = __builtin_amdgcn_mfma_f32_16x16x32_bf16(an, bq, dn, 0, 0, 0); }
      dn *= Wi[d * 64 + 16 * tt + fr];
#pragma unroll
      for (int ks = 0; ks < 2; ++ks) { const bf16x8 va = *(const LAS bf16x8*)(lds + O_VT + (256 + fr) * 144 + 64 * ks + 16 * fq); const bf16x8 bw = *(const LAS bf16x8*)(lds + O_WS + (d * 64 + 16 * tt + fr) * 144 + 64 * ks + 16 * fq);
          dn = __builtin_amdgcn_mfma_f32_16x16x32_bf16(va, bw, dn, 0, 0, 0); }
      if (fq == 0) dens[d * 64 + 16 * tt + fr] = dn[0]; }
    __syncthreads();
    float hv[2][4][4];
#pragma unroll
    for (int tt = 0; tt < 4; ++tt) { const int t = 16 * tt + fr; const float rf = 1.0f / fmaxf(fabsf(dens[t]), Fl[t]), rb = 1.0f / fmaxf(fabsf(dens[64 + t]), Fl[64 + t]);
        float s = 0.f, s2 = 0.f;
#pragma unroll
        for (int v = 0; v < 2; ++v)
#pragma unroll
            for (int i = 0; i < 4; ++i) { const float x = acc[0][v][tt][i] * rf + acc[1][v][tt][i] * rb; hv[v][tt][i] = x; s += x; s2 += x * x; }
        s += __shfl_xor(s, 16); s += __shfl_xor(s, 32); s2 += __shfl_xor(s2, 16); s2 += __shfl_xor(s2, 32);
        if (fq == 0) { red[(wave * 64 + t) * 2] = s; red[(wave * 64 + t) * 2 + 1] = s2; } }
    __syncthreads();
    { const float* hg = P.in[I_HNG] + h * 256; const bf16_t* UO = (const bf16_t*)(P.ws + WS_UO); bf16_t* A2 = (bf16_t*)(P.ws + WS_A2);
#pragma unroll
      for (int tt = 0; tt < 4; ++tt) { const int t = 16 * tt + fr; float s = 0.f, s2 = 0.f;
#pragma unroll
          for (int w = 0; w < 8; ++w) { s += red[(w * 64 + t) * 2]; s2 += red[(w * 64 + t) * 2 + 1]; }
          const float mu = s * (1.0f / 256.0f), var = fmaxf(s2 * (1.0f / 256.0f) - mu * mu, 0.f), rstd = 1.0f / sqrtf(var + EPSF);
#pragma unroll
          for (int v = 0; v < 2; ++v) { const int vf = 32 * wave + 16 * v + 4 * fq; const f32x4 g = *(const f32x4*)(hg + vf);
              const u32x2 ow = *(const u32x2*)(UO + (size_t)(t0 + t) * 1024 + h * 256 + vf); const float o[4] = {bflo(ow.x), bfhi(ow.x), bflo(ow.y), bfhi(ow.y)}; float r[4];
#pragma unroll
              for (int i = 0; i < 4; ++i) r[i] = (hv[v][tt][i] - mu) * rstd * g[i] * sigmoidf_(o[i]);
              u32x2 pk; pk.x = cvtpk(r[0], r[1]); pk.y = cvtpk(r[2], r[3]); *(u32x2*)(A2 + (size_t)(t0 + t) * 2048 + 1024 + h * 256 + vf) = pk; } } }
}
__device__ __forceinline__ void p7a_route(const Params& P) {
    const int tid = otid(), lane = tid & 63, wave = tid >> 6; const int gw = blockIdx.x * 8 + wave, NGW = gridDim.x * 8;
    const float* mod = (const float*)(P.ws + WS_MOD); const float* g = P.in[I_N2G]; const float* sumsq = (const float*)(P.ws + WS_SUMSQ);
    const float* wg = P.in[I_WGRP]; const float* wr = P.in[I_WRT]; const float* bg = P.in[I_BGRP]; const float* br = P.in[I_BRT];
    int* cnt = (int*)(P.ws + WS_CTL) + 1024; int* eid = (int*)(P.ws + WS_ROUTE); float* wtok = (float*)(P.ws + WS_ROUTE + 65536); int* spos = (int*)(P.ws + WS_ROUTE + 131072); int* perm = (int*)(P.ws + WS_PERM);
    for (int r = gw; r < SEQ; r += NGW) {
        float ss = lane < 32 ? sumsq[(size_t)r * 32 + lane] : 0.f; ss = wave_sum(ss);
        const float rstd = 1.0f / sqrtf(ss * (1.0f / D) + EPSF);
        const f32x4* hr = (const f32x4*)(P.out + (size_t)r * D) + lane;
        float lg[4], le[32];
#pragma unroll
        for (int i = 0; i < 4; ++i) lg[i] = 0.f;
#pragma unroll
        for (int i = 0; i < 32; ++i) le[i] = 0.f;
#pragma unroll 2
        for (int j = 0; j < 8; ++j) { const int d0 = 4 * lane + 256 * j; const f32x4 hv = hr[64 * j]; const f32x4 gg = *(const f32x4*)(g + d0), sc = *(const f32x4*)(mod + 8192 + d0), sh = *(const f32x4*)(mod + 6144 + d0);
            const f32x4 y = hv * rstd * gg * (sc + 1.0f) + sh;
#pragma unroll
            for (int e = 0; e < 4; ++e) { const float yv = y[e]; const f32x4 w4 = *(const f32x4*)(wg + (size_t)(d0 + e) * 4);
                lg[0] += yv * w4[0]; lg[1] += yv * w4[1]; lg[2] += yv * w4[2]; lg[3] += yv * w4[3];
                const f32x4* wrr = (const f32x4*)(wr + (size_t)(d0 + e) * 32);
#pragma unroll
                for (int q = 0; q < 8; ++q) { const f32x4 w = wrr[q]; le[4 * q] += yv * w[0]; le[4 * q + 1] += yv * w[1]; le[4 * q + 2] += yv * w[2]; le[4 * q + 3] += yv * w[3]; } } }
#pragma unroll
        for (int i = 0; i < 4; ++i) lg[i] = wave_sum(lg[i]) + bg[i];
#pragma unroll
        for (int i = 0; i < 32; ++i) le[i] = wave_sum(le[i]) + br[i];
        int gs = 0; float gm = lg[0];
#pragma unroll
        for (int i = 1; i < 4; ++i) if (lg[i] > gm) { gm = lg[i]; gs = i; }
        float gsum = 0.f;
#pragma unroll
        for (int i = 0; i < 4; ++i) gsum += __expf(lg[i] - gm);
        const float pg = 1.0f / gsum;
        float sl[8];
#pragma unroll
        for (int i = 0; i < 8; ++i) sl[i] = gs == 0 ? le[i] : gs == 1 ? le[8 + i] : gs == 2 ? le[16 + i] : le[24 + i];
        int i1 = 0; float m1 = sl[0];
#pragma unroll
        for (int i = 1; i < 8; ++i) if (sl[i] > m1) { m1 = sl[i]; i1 = i; }
        int i2 = -1; float m2 = -3.0e38f;
#pragma unroll
        for (int i = 0; i < 8; ++i) if (i != i1 && sl[i] > m2) { m2 = sl[i]; i2 = i; }
        const float p2 = __expf(m2 - m1); const float w1 = pg / (1.0f + p2), w2 = pg * p2 / (1.0f + p2);
        if (lane == 0) { const int e1 = gs * 8 + i1, e2 = gs * 8 + i2;
            const int s1 = atomicAdd(cnt + e1, 1), s2 = atomicAdd(cnt + e2, 1);
            perm[e1 * 8192 + s1] = r; perm[e2 * 8192 + s2] = r;
            eid[2 * r] = e1; eid[2 * r + 1] = e2; wtok[2 * r] = w1; wtok[2 * r + 1] = w2; spos[2 * r] = s1; spos[2 * r + 1] = s2; }
    }
}
__device__ __forceinline__ void moe_tables(const Params& P, LAS int* tab) {
    __syncthreads();
    if (threadIdx.x == 0) { const int* cnt = (const int*)(P.ws + WS_CTL) + 1024; int tt = 0;
        for (int e = 0; e < NEXP; ++e) { const int c = __hip_atomic_load(cnt + e, __ATOMIC_RELAXED, __HIP_MEMORY_SCOPE_AGENT); const int nt = (c + 255) >> 8; tab[128 + e] = tt; for (int i = 0; i < nt; ++i) tab[1 + tt + i] = e; tt += nt; }
        tab[0] = tt; }
    __syncthreads();
}
__device__ __forceinline__ void p7b_scatter(const Params& P, const LAS int* tab) {
    const int tid = otid(), lane = tid & 63, wave = tid >> 6; const int gw = blockIdx.x * 8 + wave, NGW = gridDim.x * 8;
    const float* mod = (const float*)(P.ws + WS_MOD); const float* g = P.in[I_N2G]; const float* sumsq = (const float*)(P.ws + WS_SUMSQ);
    const int* eid = (const int*)(P.ws + WS_ROUTE); const int* spos = (const int*)(P.ws + WS_ROUTE + 131072); bf16_t* FNS = (bf16_t*)(P.ws + WS_FNS);
    for (int r = gw; r < SEQ; r += NGW) {
        float ss = lane < 32 ? sumsq[(size_t)r * 32 + lane] : 0.f; ss = wave_sum(ss);
        const float rstd = 1.0f / sqrtf(ss * (1.0f / D) + EPSF);
        const int e1 = eid[2 * r], e2 = eid[2 * r + 1]; const size_t sl1 = (size_t)tab[128 + e1] * 256 + spos[2 * r], sl2 = (size_t)tab[128 + e2] * 256 + spos[2 * r + 1];
        const f32x4* hr = (const f32x4*)(P.out + (size_t)r * D) + lane; u32x2* o1 = (u32x2*)(FNS + sl1 * D) + lane; u32x2* o2 = (u32x2*)(FNS + sl2 * D) + lane;
#pragma unroll
        for (int j = 0; j < 8; ++j) { const int d0 = 4 * lane + 256 * j; const f32x4 hv = hr[64 * j]; const f32x4 gg = *(const f32x4*)(g + d0), sc = *(const f32x4*)(mod + 8192 + d0), sh = *(const f32x4*)(mod + 6144 + d0);
            const f32x4 y = hv * rstd * gg * (sc + 1.0f) + sh; u32x2 w; w.x = cvtpk(y[0], y[1]); w.y = cvtpk(y[2], y[3]); o1[64 * j] = w; o2[64 * j] = w; }
    }
}
__device__ __forceinline__ void p10_final(const Params& P, const LAS int* tab) {
    const int tid = otid(), lane = tid & 63, wave = tid >> 6; const int gw = blockIdx.x * 8 + wave, NGW = gridDim.x * 8;
    const float* mod = (const float*)(P.ws + WS_MOD); const float* fg = P.in[I_FG];
    const int* eid = (const int*)(P.ws + WS_ROUTE); const float* wtok = (const float*)(P.ws + WS_ROUTE + 65536); const int* spos = (const int*)(P.ws + WS_ROUTE + 131072); const bf16_t* Y = (const bf16_t*)(P.ws + WS_Y);
    for (int r = gw; r < SEQ; r += NGW) {
        const int e1 = eid[2 * r], e2 = eid[2 * r + 1]; const size_t sl1 = (size_t)tab[128 + e1] * 256 + spos[2 * r], sl2 = (size_t)tab[128 + e2] * 256 + spos[2 * r + 1];
        const float w1 = wtok[2 * r], w2 = wtok[2 * r + 1];
        f32x4* hr = (f32x4*)(P.out + (size_t)r * D) + lane; const u32x2* y1 = (const u32x2*)(Y + sl1 * D) + lane; const u32x2* y2 = (const u32x2*)(Y + sl2 * D) + lane;
        f32x4 v[8]; float ss = 0.f;
#pragma unroll
        for (int j = 0; j < 8; ++j) { const int d0 = 4 * lane + 256 * j; const f32x4 hv = hr[64 * j]; const f32x4 g2 = *(const f32x4*)(mod + 10240 + d0); const u32x2 a = y1[64 * j], b = y2[64 * j];
            const f32x4 ya = {bflo(a.x), bfhi(a.x), bflo(a.y), bfhi(a.y)}, yb = {bflo(b.x), bfhi(b.x), bflo(b.y), bfhi(b.y)};
            v[j] = hv + g2 * (ya * w1 + yb * w2); ss += (v[j][0] * v[j][0] + v[j][1] * v[j][1]) + (v[j][2] * v[j][2] + v[j][3] * v[j][3]); }
        const float rstd = 1.0f / sqrtf(wave_sum(ss) * (1.0f / D) + EPSF);
#pragma unroll
        for (int j = 0; j < 8; ++j) { const int d0 = 4 * lane + 256 * j; hr[64 * j] = v[j] * rstd * *(const f32x4*)(fg + d0); }
    }
}
__device__ __forceinline__ void p10_plain(const Params& P, const float* src) {
    const int tid = otid(), lane = tid & 63, wave = tid >> 6; const int gw = blockIdx.x * 8 + wave, NGW = gridDim.x * 8; const float* fg = P.in[I_FG];
    for (int r = gw; r < SEQ; r += NGW) { const f32x4* sr = (const f32x4*)(src + (size_t)r * D) + lane; f32x4* hr = (f32x4*)(P.out + (size_t)r * D) + lane; f32x4 v[8]; float ss = 0.f;
#pragma unroll
        for (int j = 0; j < 8; ++j) { v[j] = sr[64 * j]; ss += (v[j][0] * v[j][0] + v[j][1] * v[j][1]) + (v[j][2] * v[j][2] + v[j][3] * v[j][3]); }
        const float rstd = 1.0f / sqrtf(wave_sum(ss) * (1.0f / D) + EPSF);
#pragma unroll
        for (int j = 0; j < 8; ++j) hr[64 * j] = v[j] * rstd * *(const f32x4*)(fg + 4 * lane + 256 * j); }
}
#ifndef STAGE
#define STAGE 4
#endif
#ifndef N_LAUNCHES
#define N_LAUNCHES 1
#endif
constexpr int NPHASE = 12;
__global__ void __launch_bounds__(512, 2) mk_fwd(Params P) {
    extern __shared__ __attribute__((aligned(16))) unsigned char lds_raw[];
    LAS unsigned char* lds = (LAS unsigned char*)lds_raw;
    LAS int* tab = (LAS int*)(lds + LDSCTL_OFF + 4096);
    const int lo = P.ph_lo, hi = P.ph_hi; const int G = gridDim.x, bx = blockIdx.x;
#ifndef ONLYP
#define ONLYP -1
#endif
#define IN(k) ((ONLYP < 0 || ONLYP == (k)) && lo <= (k) && (k) < hi)
#define SEAM(k) do { if ((k) + 1 < hi) { cg::this_grid().sync(); } } while (0)
    if (IN(0)) {
#if STAGE >= 2
        p0_adaln(P, lds); p0_transposes(P, lds, 0, STAGE >= 4 ? TR_ITEMS_ALL : TR_ITEMS_EARLY); p0_zero_pad(P);
#endif
        SEAM(0); }
    if (IN(1)) {
#if STAGE >= 2
        p1_xn(P);
#endif
        SEAM(1); }
    if (IN(2)) {
#if STAGE >= 2
        pg8::Gemm g{(const bf16_t*)(P.ws + WS_XN), (const bf16_t*)(P.ws + WS_WINT), 2048, 2048, 2048}; SchedG1 S{G, bx}; EpiG1 E{P.ws, P.in[I_GB]};
        pg8::gemm_phase<EpiG1, SchedG1>(lds, g, S, E);
#endif
        SEAM(2); }
    if (IN(3)) {
#if STAGE >= 2
        p3_all(P, lds);
#endif
        SEAM(3); }
    if (IN(4)) {
#if STAGE >= 2
        const int NSB = STAGE >= 3 ? 144 : 0;
        if (bx < NSB) { p4_state(P, lds, bx); }
        else { pg8::Gemm g{(const bf16_t*)(P.ws + WS_DP), (const bf16_t*)(P.ws + WS_WPOOLT), 1024, 256, 256}; SchedPool S{G - NSB, bx - NSB}; EpiPool E{(bf16_t*)(P.ws + WS_A2)};
            pg8::gemm_phase<EpiPool, SchedPool>(lds, g, S, E); }
#endif
        SEAM(4); }
    if (IN(5)) {
#if STAGE >= 3
        for (int t = bx; t < 512; t += G) p5_task(P, lds, t >> 2, t & 3);
#elif STAGE == 2
        { bf16_t* A2 = (bf16_t*)(P.ws + WS_A2); for (int i = bx * 512 + threadIdx.x; i < SEQ * 128; i += G * 512) { const int r = i >> 7, c8 = i & 127; *(u32x4*)(A2 + (size_t)r * 2048 + 1024 + 8 * c8) = (u32x4){0u, 0u, 0u, 0u}; } }
#endif
        SEAM(5); }
    if (IN(6)) {
#if STAGE >= 2
        pg8::Gemm g{(const bf16_t*)(P.ws + WS_A2), (const bf16_t*)(P.ws + WS_WOUTT), 2048, 2048, 2048}; SchedG2 S{G, bx};
        EpiG2 E{P.in[I_X], (const float*)(P.ws + WS_MOD) + 4096, P.out, (float*)(P.ws + WS_SUMSQ)};
        pg8::gemm_phase<EpiG2, SchedG2>(lds, g, S, E);
#endif
        SEAM(6); }
    if (IN(7)) {
#if STAGE >= 4
        p7a_route(P);
#endif
        SEAM(7); }
    if (IN(8)) {
#if STAGE >= 4
        moe_tables(P, tab); p7b_scatter(P, tab);
#endif
        SEAM(8); }
    if (IN(9)) {
#if STAGE >= 4
        if (lo == 9) moe_tables(P, tab);
        pg8::Gemm g{(const bf16_t*)(P.ws + WS_FNS), (const bf16_t*)(P.ws + WS_W13T), 2048, 2048, 2048}; SchedMoE S{G, bx, 4, 4, tab}; EpiUp E{(bf16_t*)(P.ws + WS_H)};
        pg8::gemm_phase<EpiUp, SchedMoE>(lds, g, S, E);
#endif
        SEAM(9); }
    if (IN(10)) {
#if STAGE >= 4
        if (lo == 10) moe_tables(P, tab);
        pg8::Gemm g{(const bf16_t*)(P.ws + WS_H), (const bf16_t*)(P.ws + WS_W2T), 512, 512, 512}; SchedMoE S{G, bx, 8, 8, tab}; EpiDown E{(bf16_t*)(P.ws + WS_Y)};
        pg8::gemm_phase<EpiDown, SchedMoE>(lds, g, S, E);
#endif
        SEAM(10); }
    if (IN(11)) {
#if STAGE >= 4
        if (lo == 11) moe_tables(P, tab);
        p10_final(P, tab);
#elif STAGE >= 2
        p10_plain(P, P.out);
#else
        p10_plain(P, P.in[I_X]);
#endif
    }
#undef IN
#undef SEAM
}

extern "C" void kernel_launch(void* const* d_in, const int* in_sizes, int n_in, void* d_out, int out_size, void* d_ws, size_t ws_size, hipStream_t stream) {
    static int grid = 0;
    if (grid == 0) {
        if (n_in != 24 || out_size != SEQ * D || ws_size < WS_END) { fprintf(stderr, "kernel_launch: unexpected shapes (n_in %d, out %d, ws %zu < %zu)\n", n_in, out_size, ws_size, (size_t)WS_END); grid = -1; return; }
        int dev = 0, cus = 0, per_cu = 0;
        if (hipGetDevice(&dev) != hipSuccess || hipDeviceGetAttribute(&cus, hipDeviceAttributeMultiprocessorCount, dev) != hipSuccess) { grid = -1; return; }
        if (hipFuncSetAttribute((const void*)mk_fwd, hipFuncAttributeMaxDynamicSharedMemorySize, LDS_BYTES) != hipSuccess) { fprintf(stderr, "kernel_launch: hipFuncSetAttribute failed\n"); grid = -1; return; }
        if (hipOccupancyMaxActiveBlocksPerMultiprocessor(&per_cu, (const void*)mk_fwd, 512, LDS_BYTES) != hipSuccess || per_cu < 1) { fprintf(stderr, "kernel_launch: occupancy query says %d\n", per_cu); per_cu = 1; }
        (void)hipGetLastError();
        grid = cus;
        if (grid < 160) { fprintf(stderr, "kernel_launch: %d CUs is too few for this kernel's phase split\n", grid); grid = -1; return; }
    }
    if (grid < 0) return;
    (void)hipMemsetAsync((char*)d_ws + WS_CTL, 0, 1 * MiB, stream);
    Params p{};
    for (int i = 0; i < 24; ++i) p.in[i] = (const float*)d_in[i];
    p.out = (float*)d_out; p.ws = (unsigned char*)d_ws;
#if N_LAUNCHES == 1
    p.ph_lo = 0; p.ph_hi = NPHASE;
    void* args[] = {&p};
    hipError_t e = hipLaunchCooperativeKernel((const void*)mk_fwd, dim3(grid), dim3(512), args, LDS_BYTES, stream);
    if (e != hipSuccess) fprintf(stderr, "cooperative launch failed: %s (grid %d)\n", hipGetErrorString(e), grid);
#else
    for (int k = 0; k < NPHASE; ++k) { p.ph_lo = k; p.ph_hi = k + 1; hipLaunchKernelGGL(mk_fwd, dim3(grid), dim3(512), LDS_BYTES, stream, p); }
#endif
}
```

```cpp
#define STAGE 4
#define N_LAUNCHES 2
#include <hip/hip_runtime.h>
#include <hip/hip_cooperative_groups.h>
#include <cstdio>
#include <cstdint>
namespace cg = cooperative_groups;

#define LAS __attribute__((address_space(3)))
#define GAS __attribute__((address_space(1)))
typedef unsigned short bf16_t;
typedef short bf16x8 __attribute__((ext_vector_type(8)));
typedef float f32x4 __attribute__((ext_vector_type(4)));
typedef float f32x2 __attribute__((ext_vector_type(2)));
typedef unsigned u32x4 __attribute__((ext_vector_type(4)));
typedef unsigned u32x2 __attribute__((ext_vector_type(2)));
typedef __bf16 bf16x2_t __attribute__((ext_vector_type(2)));

constexpr int D = 2048, SEQ = 8192, CTXL = 256, MTOT = SEQ + CTXL;
constexpr int INC = 5136, NPAD = 5376;
constexpr int NCH = SEQ / 64, NCHT = MTOT / 64;
constexpr int NEXP = 32, DEXP = 512;
constexpr float EPSF = 1e-6f;

constexpr size_t MiB = 1u << 20;
constexpr size_t WS_CTL = 0;
constexpr size_t WS_MOD = 1 * MiB;
constexpr size_t WS_GATES = 2 * MiB;
constexpr size_t WS_E = 3 * MiB;
constexpr size_t WS_BC = 3 * MiB + 288 * 1024;
constexpr size_t WS_GC = 3 * MiB + 576 * 1024;
constexpr size_t WS_NST = 4 * MiB;
constexpr size_t WS_SUMSQ = 5 * MiB;
constexpr size_t WS_ROUTE = 6 * MiB;
constexpr size_t WS_PERM = 7 * MiB;
constexpr size_t WS_WPOOLT = 8 * MiB;
constexpr size_t WS_WOUTT = 9 * MiB;
constexpr size_t WS_WINT = 17 * MiB;
constexpr size_t WS_W13T = 38 * MiB;
constexpr size_t WS_W2T = 166 * MiB;
constexpr size_t WS_XN = 230 * MiB;
constexpr size_t WS_DP = 230 * MiB;
constexpr size_t WS_UP = 263 * MiB;
constexpr size_t WS_UQ = 279 * MiB;
constexpr size_t WS_A2 = 263 * MiB;
constexpr size_t WS_UO = 295 * MiB;
constexpr size_t WS_UK = 311 * MiB;
constexpr size_t WS_UV = 328 * MiB;
constexpr size_t WS_QC = 345 * MiB;
constexpr size_t WS_KC = 361 * MiB;
constexpr size_t WS_KT = 378 * MiB;
constexpr size_t WS_VT = 395 * MiB;
constexpr size_t WS_VSF = 413 * MiB;
constexpr size_t WS_VSB = 431 * MiB;
constexpr size_t WS_CST = 449 * MiB;
constexpr size_t WS_Y = 449 * MiB;
constexpr size_t WS_H = 545 * MiB;
constexpr size_t WS_FNS = 295 * MiB;
constexpr size_t WS_END = 577 * MiB;
constexpr int MAXSLOT = 24576;

constexpr int RING_BYTES = 131072;
constexpr int LDSCTL_OFF = RING_BYTES;
constexpr int LDS_BYTES = 147456;

__device__ __forceinline__ float bf2f(unsigned short b) { return __uint_as_float((unsigned)b << 16); }
__device__ __forceinline__ unsigned cvtpk(float lo, float hi) { f32x2 v = {lo, hi}; bf16x2_t b = __builtin_convertvector(v, bf16x2_t); return __builtin_bit_cast(unsigned, b); }
__device__ __forceinline__ float bflo(unsigned w) { return __uint_as_float(w << 16); }
__device__ __forceinline__ float bfhi(unsigned w) { return __uint_as_float(w & 0xffff0000u); }
__device__ __forceinline__ float siluf(float x) { return x / (1.0f + __expf(-x)); }
__device__ __forceinline__ float sigmoidf_(float x) { return 1.0f / (1.0f + __expf(-x)); }
__device__ __forceinline__ float logsigmoidf_(float x) { return fminf(x, 0.f) - log1pf(__expf(-fabsf(x))); }
__device__ __forceinline__ float wave_sum(float v) {
#pragma unroll
    for (int o = 1; o < 64; o <<= 1) v += __shfl_xor(v, o);
    return v;
}
__device__ __forceinline__ float wave_max(float v) {
#pragma unroll
    for (int o = 1; o < 64; o <<= 1) v = fmaxf(v, __shfl_xor(v, o));
    return v;
}
__device__ __forceinline__ int otid() { int t = threadIdx.x; asm volatile("" : "+v"(t)); return t; }
#define LDS_WAIT() asm volatile("s_waitcnt lgkmcnt(0)" ::: "memory")
#define VM_WAIT() asm volatile("s_waitcnt vmcnt(0)" ::: "memory")

struct Params { const float* in[24]; float* out; unsigned char* ws; int ph_lo, ph_hi; };
enum { I_X = 0, I_C, I_CTX, I_CCTX, I_WMOD, I_BMOD, I_N1G, I_WIN, I_WCQ, I_WCK, I_GB, I_HNG, I_WPOOL, I_PSC, I_WOUT, I_N2G, I_WGRP, I_BGRP, I_WRT, I_BRT, I_W1, I_W3, I_W2, I_FG };
namespace pg8 {
constexpr int BM = 256, BK = 64, HALF = 128, HTB = HALF * BK * 2, STAGE_BYTES = 8 * HTB, NXCD = 8, WGM = 8;
__host__ __device__ __forceinline__ int lds_byte(int r, int c) { const int st = (r >> 4) * 2 + (c >> 5), rr = r & 15, cc = c & 31, ob = rr * 64 + cc * 2; return st * 1024 + (ob ^ (((ob >> 9) & 1) << 5)); }
__host__ __device__ __forceinline__ void stage_rc(int b, int& R, int& C) { const int st = b / 1024, sb = b % 1024, swz = sb ^ (((sb >> 9) & 1) << 5); R = (st >> 1) * 16 + swz / 64; C = (st & 1) * 32 + (swz % 64) / 2; }
__host__ __device__ __forceinline__ int perm32(int rho) { const int n = rho >> 4, i = rho & 15; return 8 * (i >> 2) + 4 * n + (i & 3); }

struct Unit { int am, bn, acol, ex; };
struct Gemm { const bf16_t* A; const bf16_t* Bt; int lda, ldb, K; };

__device__ __forceinline__ void static_unit(int L, int nM, int nN, int& pm, int& pn) {
    const int nwg = nM * nN; int wgid = L; { const int q = nwg / NXCD, r = nwg % NXCD, xcd = wgid % NXCD, off = wgid / NXCD; wgid = (xcd < r ? xcd * (q + 1) : r * (q + 1) + (xcd - r) * q) + off; }
    const int nig = WGM * nN, gid = wgid / nig, fm = gid * WGM, gsz = (nM - fm) < WGM ? (nM - fm) : WGM;
    pm = fm + ((wgid % nig) % gsz); pn = (wgid % nig) / gsz;
}

template <class Epi, class Sched>
__device__ __forceinline__ void gemm_phase(LAS unsigned char* lds, const Gemm g, const Sched& S, const Epi& E) {
    const int tid = otid(), wid = __builtin_amdgcn_readfirstlane(tid >> 6), lane = tid & 63, wr = wid >> 2, wc = wid & 3, fr = lane & 15, fq = lane >> 4;
    const int K = g.K, nt = K / BK;
    unsigned voffA[2], voffB[2];
#pragma unroll
    for (int i = 0; i < 2; ++i) { int R, C; stage_rc(tid * 16 + i * 8192, R, C); const int Rb = Epi::PERM ? ((R & ~31) + perm32(R & 31)) : R;
        voffA[i] = (unsigned)(R * g.lda + C) * 2u; voffB[i] = (unsigned)(Rb * g.ldb + C) * 2u; }
    const size_t kstep = (size_t)(BK * 2);
    const size_t hstepA = (size_t)HALF * g.lda * 2, hstepB = (size_t)HALF * g.ldb * 2;
    const size_t tstepA = 2 * hstepA, tstepB = 2 * hstepB;
    const unsigned ldsw = (unsigned)wid * 1024u;
    const int aoff = lds_byte(wr * 64 + fr, fq * 8), boff = lds_byte(wc * 32 + fr, fq * 8);
#define PG8_SA(b, h) (((b) * 2 + (h)) * HTB)
#define PG8_SB(b, h) ((4 + (b) * 2 + (h)) * HTB)
#define PG8_STAGE(bufoff, gbase, voff) do { _Pragma("unroll") for (int _i = 0; _i < 2; ++_i) \
        __builtin_amdgcn_global_load_lds((const unsigned*)((const char*)(gbase) + (voff)[_i]), (LAS unsigned*)(lds + (bufoff) + ldsw + _i * 8192), 16, 0, 0); } while (0)
#define PG8_LDA(dst, b, h) do { _Pragma("unroll") for (int m = 0; m < 4; ++m) _Pragma("unroll") for (int k = 0; k < 2; ++k) dst[m][k] = *(const LAS bf16x8*)(lds + PG8_SA(b, h) + aoff + m * 2048 + k * 1024); } while (0)
#define PG8_LDB(dst, b, h) do { _Pragma("unroll") for (int n = 0; n < 2; ++n) _Pragma("unroll") for (int k = 0; k < 2; ++k) dst[n][k] = *(const LAS bf16x8*)(lds + PG8_SB(b, h) + boff + n * 2048 + k * 1024); } while (0)
#define PG8_MMA(ai, bj, At, Bt) do { __builtin_amdgcn_s_setprio(1); _Pragma("unroll") for (int m = 0; m < 4; ++m) _Pragma("unroll") for (int n = 0; n < 2; ++n) _Pragma("unroll") for (int k = 0; k < 2; ++k) \
        acc[ai][bj][m][n] = __builtin_amdgcn_mfma_f32_16x16x32_bf16(Bt[n][k], At[m][k], acc[ai][bj][m][n], 0, 0, 0); __builtin_amdgcn_s_setprio(0); } while (0)
#define PG8_WAIT_V(n) asm volatile("s_waitcnt vmcnt(" #n ")" ::: "memory")
#define PG8_WAIT_L(n) asm volatile("s_waitcnt lgkmcnt(" #n ")" ::: "memory")
#define PG8_BAR __builtin_amdgcn_s_barrier()
#define PG8_SCHED __builtin_amdgcn_sched_barrier(0)
    Unit cur, nxt; int ui = 0;
    if (!S.next(0, cur)) return;
    f32x4 acc[2][2][4][2];
#pragma unroll
    for (int a = 0; a < 2; ++a)
#pragma unroll
        for (int b = 0; b < 2; ++b)
#pragma unroll
            for (int m = 0; m < 4; ++m)
#pragma unroll
                for (int n = 0; n < 2; ++n) acc[a][b][m][n] = (f32x4){0.f, 0.f, 0.f, 0.f};
    bf16x8 At[4][2], B0[2][2], B1[2][2];
    const char* cA = (const char*)g.A + (size_t)cur.am * tstepA + (size_t)cur.acol * 2; const char* cB = (const char*)g.Bt + (size_t)cur.bn * tstepB;
    PG8_STAGE(PG8_SB(0, 0), cB, voffB); PG8_STAGE(PG8_SB(0, 1), cB + hstepB, voffB); PG8_STAGE(PG8_SA(0, 0), cA, voffA); PG8_STAGE(PG8_SA(0, 1), cA + hstepA, voffA);
    if (wr == 1) PG8_BAR;
    PG8_WAIT_V(2); PG8_BAR;
    PG8_STAGE(PG8_SB(1, 0), cB + kstep, voffB); PG8_STAGE(PG8_SA(1, 0), cA + kstep, voffA); PG8_STAGE(PG8_SB(1, 1), cB + hstepB + kstep, voffB);
    PG8_WAIT_V(6); PG8_BAR;
    for (;;) {
        const bool has_next = S.next(ui + 1, nxt);
        const char* nA = has_next ? (const char*)g.A + (size_t)nxt.am * tstepA + (size_t)nxt.acol * 2 : cA; const char* nB = has_next ? (const char*)g.Bt + (size_t)nxt.bn * tstepB : cB;
#pragma unroll 1
        for (int t = 0; t < nt; t += 2) {
            const bool last = (t == nt - 2);
            const char* a1 = cA + (size_t)(t + 1) * kstep;
            const char* a2 = last ? nA : cA + (size_t)(t + 2) * kstep; const char* b2 = last ? nB : cB + (size_t)(t + 2) * kstep;
            const char* a3 = a2 + kstep; const char* b3 = b2 + kstep;
            PG8_LDB(B0, 0, 0); PG8_LDB(B1, 0, 1); PG8_SCHED; PG8_LDA(At, 0, 0); PG8_STAGE(PG8_SA(1, 1), a1 + hstepA, voffA);
            PG8_WAIT_V(8); PG8_WAIT_L(0); PG8_BAR; PG8_MMA(0, 0, At, B0); PG8_MMA(0, 1, At, B1); PG8_BAR; PG8_SCHED;
            PG8_LDA(At, 0, 1); PG8_STAGE(PG8_SB(0, 0), b2, voffB); PG8_STAGE(PG8_SB(0, 1), b2 + hstepB, voffB); PG8_STAGE(PG8_SA(0, 0), a2, voffA);
            PG8_WAIT_V(8); PG8_WAIT_L(0); PG8_BAR; PG8_MMA(1, 0, At, B0); PG8_MMA(1, 1, At, B1); PG8_BAR; PG8_SCHED;
            PG8_LDB(B0, 1, 0); PG8_LDB(B1, 1, 1); PG8_SCHED; PG8_LDA(At, 1, 0); PG8_STAGE(PG8_SA(0, 1), a2 + hstepA, voffA);
            PG8_WAIT_V(8); PG8_WAIT_L(0); PG8_BAR; PG8_MMA(0, 0, At, B0); PG8_MMA(0, 1, At, B1); PG8_BAR; PG8_SCHED;
            PG8_LDA(At, 1, 1); PG8_STAGE(PG8_SB(1, 0), b3, voffB); PG8_STAGE(PG8_SB(1, 1), b3 + hstepB, voffB); PG8_STAGE(PG8_SA(1, 0), a3, voffA);
            PG8_WAIT_V(8); PG8_WAIT_L(0); PG8_BAR; PG8_MMA(1, 0, At, B0); PG8_MMA(1, 1, At, B1); PG8_BAR; PG8_SCHED;
        }
        if (wr == 0) PG8_BAR;
        E(acc, cur, wr, wc, fr, fq);
        if (!has_next) break;
#pragma unroll
        for (int a = 0; a < 2; ++a)
#pragma unroll
            for (int b = 0; b < 2; ++b)
#pragma unroll
                for (int m = 0; m < 4; ++m)
#pragma unroll
                    for (int n = 0; n < 2; ++n) acc[a][b][m][n] = (f32x4){0.f, 0.f, 0.f, 0.f};
        cur = nxt; cA = nA; cB = nB; ++ui;
        if (wr == 1) PG8_BAR;
    }
    PG8_WAIT_V(0);
    PG8_BAR;
#undef PG8_SA
#undef PG8_SB
#undef PG8_STAGE
#undef PG8_LDA
#undef PG8_LDB
#undef PG8_MMA
#undef PG8_WAIT_V
#undef PG8_WAIT_L
#undef PG8_BAR
#undef PG8_SCHED
}
}
using pg8::Unit;
struct SchedG1 { int G, c;
    __device__ __forceinline__ bool next(int i, Unit& u) const { const int L = i * G + c; if (L >= 681) return false;
        if (L < 672) { int pm, pn; pg8::static_unit(L, 32, 21, pm, pn); u.am = pm; u.bn = pn; } else { u.am = 32; u.bn = 12 + (L - 672); }
        u.acol = 0; u.ex = 0; return true; } };
struct EpiG1 { static constexpr bool PERM = true;
    unsigned char* ws; const float* gate_bias;
    __device__ __forceinline__ void operator()(const f32x4 (&acc)[2][2][4][2], const Unit& u, int wr, int wc, int fr, int fq) const {
        const int row0 = u.am * 256 + wr * 64 + fr; const int seg = u.bn >> 2;
        if (seg < 5) {
            const size_t so = seg == 0 ? WS_UP : seg == 1 ? WS_UQ : seg == 2 ? WS_UO : seg == 3 ? WS_UK : WS_UV;
            bf16_t* base = (bf16_t*)(ws + so); const int col0 = (u.bn & 3) * 256 + wc * 32 + 8 * fq;
#pragma unroll
            for (int ai = 0; ai < 2; ++ai)
#pragma unroll
                for (int m = 0; m < 4; ++m) { bf16_t* rowp = base + (size_t)(row0 + ai * 128 + m * 16) * 1024 + col0;
#pragma unroll
                    for (int bj = 0; bj < 2; ++bj) { const f32x4 v0 = acc[ai][bj][m][0], v1 = acc[ai][bj][m][1];
                        u32x4 w; w.x = cvtpk(v0[0], v0[1]); w.y = cvtpk(v0[2], v0[3]); w.z = cvtpk(v1[0], v1[1]); w.w = cvtpk(v1[2], v1[3]);
                        *(u32x4*)(rowp + bj * 128) = w; } }
        } else {
            if (wc == 0 && fq < 2) { float* G = (float*)(ws + WS_GATES);
                const f32x4 b0 = *(const f32x4*)(gate_bias + 8 * fq), b1 = *(const f32x4*)(gate_bias + 8 * fq + 4);
#pragma unroll
                for (int ai = 0; ai < 2; ++ai)
#pragma unroll
                    for (int m = 0; m < 4; ++m) { float* rowp = G + (size_t)(row0 + ai * 128 + m * 16) * 16 + 8 * fq;
                        *(f32x4*)(rowp) = acc[ai][0][m][0] + b0; *(f32x4*)(rowp + 4) = acc[ai][0][m][1] + b1; } }
        }
    } };
struct SchedPool { int G, c;
    __device__ __forceinline__ bool next(int i, Unit& u) const { if (c < 0) return false; const int L = i * G + c; if (L >= 128) return false;
        u.am = L >> 2; u.bn = L & 3; u.acol = (L & 3) * 256; u.ex = 0; return true; } };
struct EpiPool { static constexpr bool PERM = true;
    bf16_t* A2;
    __device__ __forceinline__ void operator()(const f32x4 (&acc)[2][2][4][2], const Unit& u, int wr, int wc, int fr, int fq) const {
        const int row0 = u.am * 256 + wr * 64 + fr; const int col0 = u.bn * 256 + wc * 32 + 8 * fq;
#pragma unroll
        for (int ai = 0; ai < 2; ++ai)
#pragma unroll
            for (int m = 0; m < 4; ++m) { bf16_t* rowp = A2 + (size_t)(row0 + ai * 128 + m * 16) * 2048 + col0;
#pragma unroll
                for (int bj = 0; bj < 2; ++bj) { const f32x4 v0 = acc[ai][bj][m][0], v1 = acc[ai][bj][m][1];
                    u32x4 w; w.x = cvtpk(v0[0], v0[1]); w.y = cvtpk(v0[2], v0[3]); w.z = cvtpk(v1[0], v1[1]); w.w = cvtpk(v1[2], v1[3]);
                    *(u32x4*)(rowp + bj * 128) = w; } }
    } };
struct SchedG2 { int G, c;
    __device__ __forceinline__ bool next(int i, Unit& u) const { const int L = i * G + c; if (L >= 256) return false;
        int pm, pn; pg8::static_unit(L, 32, 8, pm, pn); u.am = pm; u.bn = pn; u.acol = 0; u.ex = 0; return true; } };
struct EpiG2 { static constexpr bool PERM = false;
    const float* x; const float* g1; float* out; float* sumsq;
    __device__ __forceinline__ void operator()(const f32x4 (&acc)[2][2][4][2], const Unit& u, int wr, int wc, int fr, int fq) const {
        const int row0 = u.am * 256 + wr * 64 + fr, col0 = u.bn * 256 + wc * 32 + 4 * fq;
        f32x4 gv[2][2];
#pragma unroll
        for (int bj = 0; bj < 2; ++bj)
#pragma unroll
            for (int n = 0; n < 2; ++n) gv[bj][n] = *(const f32x4*)(g1 + col0 + bj * 128 + n * 16);
#pragma unroll
        for (int ai = 0; ai < 2; ++ai)
#pragma unroll
            for (int m = 0; m < 4; ++m) { const int row = row0 + ai * 128 + m * 16; const size_t off = (size_t)row * 2048 + col0; float ss = 0.f;
#pragma unroll
                for (int bj = 0; bj < 2; ++bj)
#pragma unroll
                    for (int n = 0; n < 2; ++n) { const f32x4 xv = *(const f32x4*)(x + off + bj * 128 + n * 16); const f32x4 h = xv + gv[bj][n] * acc[ai][bj][m][n];
                        *(f32x4*)(out + off + bj * 128 + n * 16) = h; ss += (h[0] * h[0] + h[1] * h[1]) + (h[2] * h[2] + h[3] * h[3]); }
                ss += __shfl_xor(ss, 16); ss += __shfl_xor(ss, 32);
                if (fq == 0) sumsq[(size_t)row * 32 + u.bn * 4 + wc] = ss; }
    } };
struct SchedMoE { int G, c, NN, btpe; const LAS int* tab;
    __device__ __forceinline__ bool next(int i, Unit& u) const { const int L = i * G + c; const int nt = tab[0]; if (L >= nt * NN) return false;
        const int tau = L / NN, pn = L - tau * NN; const int e = tab[1 + tau]; u.am = tau; u.bn = e * btpe + pn; u.acol = 0; u.ex = pn; return true; } };
struct EpiUp { static constexpr bool PERM = true;
    bf16_t* H;
    __device__ __forceinline__ void operator()(const f32x4 (&acc)[2][2][4][2], const Unit& u, int wr, int wc, int fr, int fq) const {
        const int row0 = u.am * 256 + wr * 64 + fr; const int col0 = u.ex * 128 + wc * 16 + 4 * fq;
#pragma unroll
        for (int ai = 0; ai < 2; ++ai)
#pragma unroll
            for (int m = 0; m < 4; ++m) { bf16_t* rowp = H + (size_t)(row0 + ai * 128 + m * 16) * 512 + col0;
#pragma unroll
                for (int bj = 0; bj < 2; ++bj) { const f32x4 v0 = acc[ai][bj][m][0], v1 = acc[ai][bj][m][1];
                    u32x2 w; w.x = cvtpk(siluf(v0[0]) * v0[1], siluf(v0[2]) * v0[3]); w.y = cvtpk(siluf(v1[0]) * v1[1], siluf(v1[2]) * v1[3]);
                    *(u32x2*)(rowp + bj * 64) = w; } }
    } };
struct EpiDown { static constexpr bool PERM = true;
    bf16_t* Y;
    __device__ __forceinline__ void operator()(const f32x4 (&acc)[2][2][4][2], const Unit& u, int wr, int wc, int fr, int fq) const {
        const int row0 = u.am * 256 + wr * 64 + fr; const int col0 = u.ex * 256 + wc * 32 + 8 * fq;
#pragma unroll
        for (int ai = 0; ai < 2; ++ai)
#pragma unroll
            for (int m = 0; m < 4; ++m) { bf16_t* rowp = Y + (size_t)(row0 + ai * 128 + m * 16) * 2048 + col0;
#pragma unroll
                for (int bj = 0; bj < 2; ++bj) { const f32x4 v0 = acc[ai][bj][m][0], v1 = acc[ai][bj][m][1];
                    u32x4 w; w.x = cvtpk(v0[0], v0[1]); w.y = cvtpk(v0[2], v0[3]); w.z = cvtpk(v1[0], v1[1]); w.w = cvtpk(v1[2], v1[3]);
                    *(u32x4*)(rowp + bj * 128) = w; } }
    } };
__device__ __forceinline__ void p0_adaln(const Params& P, LAS unsigned char* lds) {
    const int tid = otid();
    LAS float* sc = (LAS float*)lds; LAS float* scc = sc + 2048; LAS float* red = scc + 2048; LAS float* red2 = red + 42 * 48;
    const float* c = P.in[I_C]; const float* cc = P.in[I_CCTX]; const float* wmod = P.in[I_WMOD]; const float* bmod = P.in[I_BMOD];
    float* mod = (float*)(P.ws + WS_MOD); float* modc = mod + 16384;
    for (int i = tid; i < 2048; i += 512) { sc[i] = siluf(c[i]); scc[i] = siluf(cc[i]); }
    __syncthreads();
    for (int cb = blockIdx.x; cb < 256; cb += gridDim.x) {
        const int n0 = 48 * cb; const bool has_ctx = n0 < 4096;
        if (tid < 504) { const int col4 = tid % 12, rg = tid / 12;
            const f32x4* wp = (const f32x4*)(wmod + n0) + col4;
            f32x4 a = {0.f, 0.f, 0.f, 0.f}, a2 = {0.f, 0.f, 0.f, 0.f};
#pragma unroll 7
            for (int k = rg; k < 2048; k += 42) { const f32x4 w = wp[(size_t)k * 3072]; a += w * sc[k]; if (has_ctx) a2 += w * scc[k]; }
            *(LAS f32x4*)(red + rg * 48 + col4 * 4) = a; *(LAS f32x4*)(red2 + rg * 48 + col4 * 4) = a2; }
        __syncthreads();
        if (tid < 48) { float s = 0.f; for (int r = 0; r < 42; ++r) s += red[r * 48 + tid]; mod[n0 + tid] = s + bmod[n0 + tid]; }
        else if (has_ctx && tid >= 64 && tid < 112) { const int t = tid - 64; if (n0 + t < 4096) { float s = 0.f; for (int r = 0; r < 42; ++r) s += red2[r * 48 + t]; modc[n0 + t] = s + bmod[n0 + t]; } }
        __syncthreads();
    }
}
__device__ __forceinline__ void transpose_item(const float* W, int K, int N, bf16_t* WT, int row_off, int rmul, LAS float* scr, int item, int lane, const float* nscale = nullptr) {
    const int nblk = (N + 31) >> 5, kb = item / nblk, nb = item - kb * nblk, k0 = 64 * kb, n0 = 32 * nb;
    const int nn = n0 + (lane & 31); const bool ok = nn < N; const float scl = (nscale && ok) ? nscale[nn] : 1.0f;
#pragma unroll 8
    for (int i = 0; i < 32; ++i) { const int kk = 2 * i + (lane >> 5); scr[kk * 33 + (lane & 31)] = ok ? W[(size_t)(k0 + kk) * N + nn] * scl : 0.f; }
    LDS_WAIT(); asm volatile("" ::: "memory");
    const int cch = lane & 7;
#pragma unroll
    for (int j = 0; j < 4; ++j) { const int n = (lane >> 3) + 8 * j; const LAS float* s = scr + (8 * cch) * 33 + n;
        u32x4 o; o.x = cvtpk(s[0 * 33], s[1 * 33]); o.y = cvtpk(s[2 * 33], s[3 * 33]); o.z = cvtpk(s[4 * 33], s[5 * 33]); o.w = cvtpk(s[6 * 33], s[7 * 33]);
        *(u32x4*)(WT + (size_t)(row_off + (n0 + n) * rmul) * K + k0 + 8 * cch) = o; }
    LDS_WAIT(); asm volatile("" ::: "memory");
}
__device__ __forceinline__ void p0_transposes(const Params& P, LAS unsigned char* lds, int lo_item, int hi_item) {
    const int tid = otid(), lane = tid & 63, wave = __builtin_amdgcn_readfirstlane(tid >> 6);
    LAS float* scr = (LAS float*)(lds + 32768 + wave * 8704);
    const int gw = blockIdx.x * 8 + wave, NGW = gridDim.x * 8;
    constexpr int I_IN = 32 * 161, I_OUT = 32 * 64, I_PL = 4 * 32, I_E13 = 32 * 16, I_E2 = 8 * 64;
    constexpr int B_OUT = I_IN, B_PL = B_OUT + I_OUT, B_W1 = B_PL + I_PL, B_W3 = B_W1 + 32 * I_E13, B_W2 = B_W3 + 32 * I_E13, B_END = B_W2 + 32 * I_E2;
    if (hi_item > B_END) hi_item = B_END;
    for (int it = lo_item + gw; it < hi_item; it += NGW) {
        if (it < B_OUT) transpose_item(P.in[I_WIN], 2048, INC, (bf16_t*)(P.ws + WS_WINT), 0, 1, scr, it, lane);
        else if (it < B_PL) transpose_item(P.in[I_WOUT], 2048, 2048, (bf16_t*)(P.ws + WS_WOUTT), 0, 1, scr, it - B_OUT, lane);
        else if (it < B_W1) { const int r = it - B_PL, g = r >> 5; transpose_item(P.in[I_WPOOL] + (size_t)g * 65536, 256, 256, (bf16_t*)(P.ws + WS_WPOOLT) + (size_t)g * 65536, 0, 1, scr, r & 31, lane, P.in[I_PSC] + g * 256); }
        else if (it < B_W3) { const int r = it - B_W1, e = r / I_E13; transpose_item(P.in[I_W1] + (size_t)e * 2048 * 512, 2048, 512, (bf16_t*)(P.ws + WS_W13T) + (size_t)e * 1024 * 2048, 0, 2, scr, r - e * I_E13, lane); }
        else if (it < B_W2) { const int r = it - B_W3, e = r / I_E13; transpose_item(P.in[I_W3] + (size_t)e * 2048 * 512, 2048, 512, (bf16_t*)(P.ws + WS_W13T) + (size_t)e * 1024 * 2048, 1, 2, scr, r - e * I_E13, lane); }
        else { const int r = it - B_W2, e = r / I_E2; transpose_item(P.in[I_W2] + (size_t)e * 512 * 2048, 512, 2048, (bf16_t*)(P.ws + WS_W2T) + (size_t)e * 2048 * 512, 0, 1, scr, r - e * I_E2, lane); }
    }
}
constexpr int TR_ITEMS_EARLY = 32 * 161 + 32 * 64 + 4 * 32;
constexpr int TR_ITEMS_ALL = TR_ITEMS_EARLY + 64 * 512 + 32 * 512;
__device__ __forceinline__ void p0_zero_pad(const Params& P) {
    u32x4* z = (u32x4*)((bf16_t*)(P.ws + WS_WINT) + (size_t)5152 * 2048); const int n = (NPAD - 5152) * 2048 / 8;
    for (int i = blockIdx.x * 512 + threadIdx.x; i < n; i += gridDim.x * 512) z[i] = (u32x4){0u, 0u, 0u, 0u};
}
__device__ __forceinline__ void p1_xn(const Params& P) {
    const int tid = otid(), lane = tid & 63, wave = tid >> 6;
    const int gw = blockIdx.x * 8 + wave, NGW = gridDim.x * 8;
    const float* mod = (const float*)(P.ws + WS_MOD); const float* modc = mod + 16384; const float* g = P.in[I_N1G];
    bf16_t* XN = (bf16_t*)(P.ws + WS_XN);
    for (int pass = 0; pass < 2; ++pass) {
        const float* sh = pass == 0 ? mod : modc; const float* scl = pass == 0 ? mod + 2048 : modc + 2048;
        const float* src = pass == 0 ? P.in[I_X] : P.in[I_CTX]; const int nrows = pass == 0 ? SEQ : CTXL; const int rbase = pass == 0 ? 0 : SEQ;
        if (gw >= nrows) continue;
        f32x4 a[8], s[8];
#pragma unroll
        for (int j = 0; j < 8; ++j) { const int d0 = 4 * lane + 256 * j; const f32x4 gg = *(const f32x4*)(g + d0), sv = *(const f32x4*)(scl + d0); a[j] = gg * (sv + 1.0f); s[j] = *(const f32x4*)(sh + d0); }
        for (int r = gw; r < nrows; r += NGW) {
            const f32x4* xr = (const f32x4*)(src + (size_t)r * D) + lane; f32x4 v[8]; float ss = 0.f;
#pragma unroll
            for (int j = 0; j < 8; ++j) { v[j] = xr[64 * j]; ss += (v[j][0] * v[j][0] + v[j][1] * v[j][1]) + (v[j][2] * v[j][2] + v[j][3] * v[j][3]); }
            const float rstd = 1.0f / sqrtf(wave_sum(ss) * (1.0f / D) + EPSF);
            u32x2* o = (u32x2*)(XN + (size_t)(rbase + r) * D) + lane;
#pragma unroll
            for (int j = 0; j < 8; ++j) { const f32x4 y = v[j] * rstd * a[j] + s[j]; u32x2 w; w.x = cvtpk(y[0], y[1]); w.y = cvtpk(y[2], y[3]); o[64 * j] = w; }
        }
    }
}
__device__ __forceinline__ void p3_qk_task(const Params& P, int isk, int j, int h) {
    const int tid = otid(), o = tid >> 6, f4 = tid & 63;
    const int t0 = 64 * j, seq_lo = j < 128 ? 0 : SEQ, seq_hi = j < 128 ? SEQ : MTOT;
    const bf16_t* U = (const bf16_t*)(P.ws + (isk ? WS_UK : WS_UQ)); const float* wc = P.in[isk ? I_WCK : I_WCQ];
    const int f0 = h * 256 + 4 * f4;
    const f32x4 w0 = *(const f32x4*)(wc + f0), w1 = *(const f32x4*)(wc + 1024 + f0), w2 = *(const f32x4*)(wc + 2048 + f0);
    const float osc = isk ? 1.0f : 0.0625f;
    u32x2 raw[10];
#pragma unroll
    for (int i = 0; i < 10; ++i) { const int t = t0 + 8 * o - 1 + i; raw[i] = (t >= seq_lo && t < seq_hi) ? *(const u32x2*)(U + (size_t)t * 1024 + f0) : (u32x2){0u, 0u}; }
    float outv[8][4];
#pragma unroll
    for (int i = 0; i < 8; ++i) {
        const f32x4 a = {bflo(raw[i].x), bfhi(raw[i].x), bflo(raw[i].y), bfhi(raw[i].y)}, b = {bflo(raw[i + 1].x), bfhi(raw[i + 1].x), bflo(raw[i + 1].y), bfhi(raw[i + 1].y)},
                    c = {bflo(raw[i + 2].x), bfhi(raw[i + 2].x), bflo(raw[i + 2].y), bfhi(raw[i + 2].y)};
        const f32x4 s = a * w0 + b * w1 + c * w2;
#pragma unroll
        for (int e = 0; e < 4; ++e) outv[i][e] = siluf(s[e]) * osc;
    }
    bf16_t* R = (bf16_t*)(P.ws + (isk ? WS_KC : WS_QC));
#pragma unroll
    for (int i = 0; i < 8; ++i) { u32x2 w; w.x = cvtpk(outv[i][0], outv[i][1]); w.y = cvtpk(outv[i][2], outv[i][3]); *(u32x2*)(R + (size_t)(t0 + 8 * o + i) * 1024 + f0) = w; }
    if (isk) { bf16_t* KT = (bf16_t*)(P.ws + WS_KT);
#pragma unroll
        for (int e = 0; e < 4; ++e) { u32x4 w; w.x = cvtpk(outv[0][e], outv[1][e]); w.y = cvtpk(outv[2][e], outv[3][e]); w.z = cvtpk(outv[4][e], outv[5][e]); w.w = cvtpk(outv[6][e], outv[7][e]);
            *(u32x4*)(KT + (size_t)(f0 + e) * MTOT + t0 + 8 * o) = w; } }
}
__device__ __forceinline__ void p3_v_task(const Params& P, LAS unsigned char* lds, int j, int h) {
    const int tid = otid(), lane = tid & 63, wave = tid >> 6, o = tid >> 6, f4 = tid & 63;
    const int t0 = 64 * j; LAS float* wkl = (LAS float*)lds;
    __syncthreads();
    if (wave < 2) { const int d = wave; const float* G = (const float*)(P.ws + WS_GATES) + (size_t)(t0 + lane) * 16;
        const float ig = G[(2 * d) * 4 + h], fg = G[(2 * d + 1) * 4 + h];
        float b = logsigmoidf_(fg);
        if (d == 0) {
#pragma unroll
            for (int s = 1; s < 64; s <<= 1) { const float t = __shfl_up(b, s); if (lane >= s) b += t; }
        } else {
#pragma unroll
            for (int s = 1; s < 64; s <<= 1) { const float t = __shfl_down(b, s); if (lane + s < 64) b += t; }
        }
        const float gtot = __shfl(b, d == 0 ? 63 : 0); const float e = ig - b; const float em = wave_max(e);
        const size_t ix = (size_t)(d * 4 + h) * MTOT + t0 + lane;
        ((float*)(P.ws + WS_E))[ix] = e; ((float*)(P.ws + WS_BC))[ix] = b;
        if (lane == 0) { float* gc = (float*)(P.ws + WS_GC); gc[(d * 4 + h) * 132 + j] = gtot; gc[2048 + (d * 4 + h) * 132 + j] = em; }
        wkl[d * 64 + lane] = __expf(e - em);
    }
    __syncthreads();
    const bf16_t* U = (const bf16_t*)(P.ws + WS_UV); const int f0 = h * 256 + 4 * f4;
    float v[8][4];
#pragma unroll
    for (int i = 0; i < 8; ++i) { const u32x2 r = *(const u32x2*)(U + (size_t)(t0 + 8 * o + i) * 1024 + f0); v[i][0] = bflo(r.x); v[i][1] = bfhi(r.x); v[i][2] = bflo(r.y); v[i][3] = bfhi(r.y); }
    bf16_t* VT = (bf16_t*)(P.ws + WS_VT); bf16_t* VSF = (bf16_t*)(P.ws + WS_VSF); bf16_t* VSB = (bf16_t*)(P.ws + WS_VSB);
    float sf[8], sb[8];
#pragma unroll
    for (int i = 0; i < 8; ++i) { sf[i] = wkl[8 * o + i]; sb[i] = wkl[64 + 8 * o + i]; }
#pragma unroll
    for (int e = 0; e < 4; ++e) { const size_t off = (size_t)(h * 272 + 4 * f4 + e) * MTOT + t0 + 8 * o; u32x4 w;
        w.x = cvtpk(v[0][e], v[1][e]); w.y = cvtpk(v[2][e], v[3][e]); w.z = cvtpk(v[4][e], v[5][e]); w.w = cvtpk(v[6][e], v[7][e]); *(u32x4*)(VT + off) = w;
        w.x = cvtpk(v[0][e] * sf[0], v[1][e] * sf[1]); w.y = cvtpk(v[2][e] * sf[2], v[3][e] * sf[3]); w.z = cvtpk(v[4][e] * sf[4], v[5][e] * sf[5]); w.w = cvtpk(v[6][e] * sf[6], v[7][e] * sf[7]); *(u32x4*)(VSF + off) = w;
        w.x = cvtpk(v[0][e] * sb[0], v[1][e] * sb[1]); w.y = cvtpk(v[2][e] * sb[2], v[3][e] * sb[3]); w.z = cvtpk(v[4][e] * sb[4], v[5][e] * sb[5]); w.w = cvtpk(v[6][e] * sb[6], v[7][e] * sb[7]); *(u32x4*)(VSB + off) = w; }
    if (tid < 128) {
        const int rr = tid >> 3, oc = tid & 7; const size_t off = (size_t)(h * 272 + 256 + rr) * MTOT + t0 + 8 * oc; u32x4 w1 = {0u, 0u, 0u, 0u}, wf = w1, wb = w1;
        if (rr == 0) { w1 = (u32x4){0x3f803f80u, 0x3f803f80u, 0x3f803f80u, 0x3f803f80u};
            wf.x = cvtpk(wkl[8 * oc], wkl[8 * oc + 1]); wf.y = cvtpk(wkl[8 * oc + 2], wkl[8 * oc + 3]); wf.z = cvtpk(wkl[8 * oc + 4], wkl[8 * oc + 5]); wf.w = cvtpk(wkl[8 * oc + 6], wkl[8 * oc + 7]);
            wb.x = cvtpk(wkl[64 + 8 * oc], wkl[64 + 8 * oc + 1]); wb.y = cvtpk(wkl[64 + 8 * oc + 2], wkl[64 + 8 * oc + 3]); wb.z = cvtpk(wkl[64 + 8 * oc + 4], wkl[64 + 8 * oc + 5]); wb.w = cvtpk(wkl[64 + 8 * oc + 6], wkl[64 + 8 * oc + 7]); }
        *(u32x4*)(VT + off) = w1; *(u32x4*)(VSF + off) = wf; *(u32x4*)(VSB + off) = wb; }
}
__device__ __forceinline__ void p3_pool_task(const Params& P, LAS unsigned char* lds, int r, int gi) {
    const int tid = otid(), chunk = tid & 31, cb = tid >> 5; const int win = 2 << gi, hw = win >> 1;
    const int rlo = max(r - hw, 0), rhi = min(r - hw + win, 128);
    const bf16_t* U = (const bf16_t*)(P.ws + WS_UP) + gi * 256 + 8 * chunk; LAS float* vs = (LAS float*)lds;
    __syncthreads();
    float own[4][8];
#pragma unroll
    for (int i = 0; i < 4; ++i) { const int c = cb + 16 * i; float a[8];
#pragma unroll
        for (int e = 0; e < 8; ++e) a[e] = 0.f;
        for (int rr = rlo; rr < rhi; ++rr) { const u32x4 w = *(const u32x4*)(U + (size_t)(rr * 64 + c) * 1024);
            const float x[8] = {bflo(w.x), bfhi(w.x), bflo(w.y), bfhi(w.y), bflo(w.z), bfhi(w.z), bflo(w.w), bfhi(w.w)};
#pragma unroll
            for (int e = 0; e < 8; ++e) a[e] += x[e];
            if (rr == r) {
#pragma unroll
                for (int e = 0; e < 8; ++e) own[i][e] = x[e]; } }
        *(LAS f32x4*)(vs + c * 256 + 8 * chunk) = (f32x4){a[0], a[1], a[2], a[3]}; *(LAS f32x4*)(vs + c * 256 + 8 * chunk + 4) = (f32x4){a[4], a[5], a[6], a[7]}; }
    __syncthreads();
    bf16_t* Dp = (bf16_t*)(P.ws + WS_DP) + gi * 256 + 8 * chunk;
#pragma unroll
    for (int i = 0; i < 4; ++i) { const int c = cb + 16 * i; const int clo = max(c - hw, 0), chi = min(c - hw + win, 64);
        f32x4 s0 = {0.f, 0.f, 0.f, 0.f}, s1 = s0;
        for (int cc = clo; cc < chi; ++cc) { s0 += *(const LAS f32x4*)(vs + cc * 256 + 8 * chunk); s1 += *(const LAS f32x4*)(vs + cc * 256 + 8 * chunk + 4); }
        const float inv = 1.0f / (float)((rhi - rlo) * (chi - clo));
        u32x4 w; w.x = cvtpk(s0[0] * inv - own[i][0], s0[1] * inv - own[i][1]); w.y = cvtpk(s0[2] * inv - own[i][2], s0[3] * inv - own[i][3]);
        w.z = cvtpk(s1[0] * inv - own[i][4], s1[1] * inv - own[i][5]); w.w = cvtpk(s1[2] * inv - own[i][6], s1[3] * inv - own[i][7]);
        *(u32x4*)(Dp + (size_t)(r * 64 + c) * 1024) = w; }
}
__device__ __forceinline__ void p3_all(const Params& P, LAS unsigned char* lds) {
    for (int t = blockIdx.x; t < 2080; t += gridDim.x) {
        if (t < 512) p3_qk_task(P, 0, t >> 2, t & 3);
        else if (t < 1040) p3_qk_task(P, 1, (t - 512) >> 2, (t - 512) & 3);
        else if (t < 1568) p3_v_task(P, lds, (t - 1040) >> 2, (t - 1040) & 3);
        else p3_pool_task(P, lds, (t - 1568) >> 2, (t - 1568) & 3);
    }
}
__device__ __forceinline__ int step_chunk(int d, int j) { return d == 0 ? (j < 4 ? 128 + j : j - 4) : (j < 4 ? 131 - j : 131 - j); }
__device__ __forceinline__ void p4_state(const Params& P, LAS unsigned char* lds, int sb) {
    const int tid = otid(), lane = tid & 63, wave = __builtin_amdgcn_readfirstlane(tid >> 6);
    const int hd = sb / 18, h = hd >> 1, d = hd & 1;
    LAS float* tg = (LAS float*)lds; LAS float* te = tg + 132; LAS float* tdec = te + 132; LAS float* tsf = tdec + 132;
    const float* gc = (const float*)(P.ws + WS_GC);
    if (tid < 132) { const int ci = step_chunk(d, tid); tg[tid] = gc[(d * 4 + h) * 132 + ci]; te[tid] = gc[2048 + (d * 4 + h) * 132 + ci]; }
    __syncthreads();
    if (tid == 0) { float m = 0.f; float* mst = (float*)(P.ws + WS_GC) + 4096 + (d * 4 + h) * 132; const bool wr = (sb % 18) == 0;
        for (int j = 0; j < 132; ++j) { const float em = te[j], Mf = fmaxf(m, em); tdec[j] = __expf(m - Mf); tsf[j] = __expf(em - Mf); if (wr) mst[step_chunk(d, j)] = m; m = tg[j] + Mf; } }
    __syncthreads();
    const int wt = sb * 8 + wave, rem = wt % 144, kt = rem / 9, vg = rem % 9; const int ntile = vg < 8 ? 2 : 1, vt0 = vg < 8 ? 2 * vg : 16;
    const int fr = lane & 15, fq = lane >> 4;
    const bf16_t* KT = (const bf16_t*)(P.ws + WS_KT) + (size_t)(h * 256 + kt * 16 + fr) * MTOT + 8 * fq;
    const bf16_t* VS = (const bf16_t*)(P.ws + (d == 0 ? WS_VSF : WS_VSB)) + (size_t)(h * 272 + vt0 * 16 + fr) * MTOT + 8 * fq;
    bf16_t* CST = (bf16_t*)(P.ws + WS_CST); float* NST = (float*)(P.ws + WS_NST);
    f32x4 C0 = {0.f, 0.f, 0.f, 0.f}, C1 = C0;
    bf16x8 a[2], b0[2], b1[2], na[2], nb0[2], nb1[2];
    { const int tc = 64 * step_chunk(d, 0);
#pragma unroll
      for (int ks = 0; ks < 2; ++ks) { a[ks] = *(const bf16x8*)(KT + tc + 32 * ks); b0[ks] = *(const bf16x8*)(VS + tc + 32 * ks); b1[ks] = ntile == 2 ? *(const bf16x8*)(VS + (size_t)16 * MTOT + tc + 32 * ks) : b0[ks]; } }
    for (int j = 0; j < 132; ++j) {
        if (j + 1 < 132) { const int tc = 64 * step_chunk(d, j + 1);
#pragma unroll
            for (int ks = 0; ks < 2; ++ks) { na[ks] = *(const bf16x8*)(KT + tc + 32 * ks); nb0[ks] = *(const bf16x8*)(VS + tc + 32 * ks); nb1[ks] = ntile == 2 ? *(const bf16x8*)(VS + (size_t)16 * MTOT + tc + 32 * ks) : nb0[ks]; } }
        const int ci = step_chunk(d, j);
        if (ci < 128) {
            if (vt0 < 16) { bf16_t* cp = CST + ((((size_t)ci * 4 + h) * 2 + d) * 256 + vt0 * 16 + fr) * 256 + kt * 16 + 4 * fq;
                u32x2 w; w.x = cvtpk(C0[0], C0[1]); w.y = cvtpk(C0[2], C0[3]); *(u32x2*)cp = w;
                w.x = cvtpk(C1[0], C1[1]); w.y = cvtpk(C1[2], C1[3]); *(u32x2*)(cp + 16 * 256) = w;
            } else if (fr == 0) { *(f32x4*)(NST + (((size_t)ci * 4 + h) * 2 + d) * 256 + kt * 16 + 4 * fq) = C0; }
        }
        f32x4 D0 = {0.f, 0.f, 0.f, 0.f}, D1 = D0;
#pragma unroll
        for (int ks = 0; ks < 2; ++ks) { D0 = __builtin_amdgcn_mfma_f32_16x16x32_bf16(a[ks], b0[ks], D0, 0, 0, 0); D1 = __builtin_amdgcn_mfma_f32_16x16x32_bf16(a[ks], b1[ks], D1, 0, 0, 0); }
        const float dec = tdec[j], sf = tsf[j];
        C0 = C0 * dec + D0 * sf; C1 = C1 * dec + D1 * sf;
#pragma unroll
        for (int ks = 0; ks < 2; ++ks) { a[ks] = na[ks]; b0[ks] = nb0[ks]; b1[ks] = nb1[ks]; }
    }
}
constexpr int O_QS = 0, O_KS = 33792, O_VT = 67584, O_WS = 106752, O_SC = 125184, O_DEN = 127232, O_RED = 127744, O_END = 131840;
__device__ __forceinline__ void p5_task(const Params& P, LAS unsigned char* lds, int c, int h) {
    const int tid = otid(), lane = tid & 63, wave = __builtin_amdgcn_readfirstlane(tid >> 6), fr = lane & 15, fq = lane >> 4;
    const int t0 = 64 * c;
    LAS float* Es = (LAS float*)(lds + O_SC); LAS float* Ms = Es + 128; LAS float* Wi = Ms + 128; LAS float* Fl = Wi + 128; LAS float* dens = (LAS float*)(lds + O_DEN); LAS float* red = (LAS float*)(lds + O_RED);
    __syncthreads();
    { const bf16_t* Q = (const bf16_t*)(P.ws + WS_QC) + (size_t)t0 * 1024 + h * 256; const bf16_t* Kc = (const bf16_t*)(P.ws + WS_KC) + (size_t)t0 * 1024 + h * 256;
#pragma unroll
      for (int i = 0; i < 4; ++i) { const int idx = tid + 512 * i, r = idx >> 5, ch = idx & 31;
          const u32x4 qv = *(const u32x4*)(Q + (size_t)r * 1024 + 8 * ch), kv = *(const u32x4*)(Kc + (size_t)r * 1024 + 8 * ch);
          *(LAS u32x4*)(lds + O_QS + r * 528 + 16 * ch) = qv; *(LAS u32x4*)(lds + O_KS + r * 528 + 16 * ch) = kv; }
      const bf16_t* VT = (const bf16_t*)(P.ws + WS_VT) + (size_t)(h * 272) * MTOT + t0;
      for (int idx = tid; idx < 272 * 8; idx += 512) { const int r = idx >> 3, ch = idx & 7; *(LAS u32x4*)(lds + O_VT + r * 144 + 16 * ch) = *(const u32x4*)(VT + (size_t)r * MTOT + 8 * ch); } }
    if (wave < 2) { const int d = wave; const size_t ix = (size_t)(d * 4 + h) * MTOT + t0 + lane;
        const float e = ((const float*)(P.ws + WS_E))[ix], b = ((const float*)(P.ws + WS_BC))[ix]; const float m = ((const float*)(P.ws + WS_GC))[4096 + (d * 4 + h) * 132 + c];
        float pm = e;
        if (d == 0) {
#pragma unroll
            for (int s = 1; s < 64; s <<= 1) { const float t = __shfl_up(pm, s); if (lane >= s) pm = fmaxf(pm, t); }
        } else {
#pragma unroll
            for (int s = 1; s < 64; s <<= 1) { const float t = __shfl_down(pm, s); if (lane + s < 64) pm = fmaxf(pm, t); }
        }
        const float Mt = fmaxf(m, pm);
        Es[d * 64 + lane] = e; Ms[d * 64 + lane] = Mt; Wi[d * 64 + lane] = __expf(m - Mt); Fl[d * 64 + lane] = __expf(-(b + Mt)); }
    __syncthreads();
    { const int st = wave >> 1, tt0 = 2 * (wave & 1); f32x4 S0 = {0.f, 0.f, 0.f, 0.f}, S1 = S0;
#pragma unroll
      for (int ks = 0; ks < 8; ++ks) { const bf16x8 ak = *(const LAS bf16x8*)(lds + O_KS + (16 * st + fr) * 528 + 64 * ks + 16 * fq);
          const bf16x8 bq0 = *(const LAS bf16x8*)(lds + O_QS + (16 * tt0 + fr) * 528 + 64 * ks + 16 * fq), bq1 = *(const LAS bf16x8*)(lds + O_QS + (16 * tt0 + 16 + fr) * 528 + 64 * ks + 16 * fq);
          S0 = __builtin_amdgcn_mfma_f32_16x16x32_bf16(ak, bq0, S0, 0, 0, 0); S1 = __builtin_amdgcn_mfma_f32_16x16x32_bf16(ak, bq1, S1, 0, 0, 0); }
      const int s0 = 16 * st + 4 * fq;
#pragma unroll
      for (int d = 0; d < 2; ++d) { const f32x4 ev = *(const LAS f32x4*)(Es + d * 64 + s0);
#pragma unroll
          for (int q = 0; q < 2; ++q) { const int t = 16 * (tt0 + q) + fr; const float Mt = Ms[d * 64 + t]; const f32x4 S = q == 0 ? S0 : S1; float w[4];
#pragma unroll
              for (int i = 0; i < 4; ++i) { const int s = s0 + i; const bool on = d == 0 ? (s <= t) : (s >= t); w[i] = on ? __expf(ev[i] - Mt) * S[i] : 0.f; }
              u32x2 pk; pk.x = cvtpk(w[0], w[1]); pk.y = cvtpk(w[2], w[3]); *(LAS u32x2*)(lds + O_WS + (d * 64 + t) * 144 + 2 * s0) = pk; } } }
    __syncthreads();
    f32x4 acc[2][2][4];
    const bf16_t* CST = (const bf16_t*)(P.ws + WS_CST);
#pragma unroll
    for (int d = 0; d < 2; ++d) {
        const bf16_t* Cp = CST + ((((size_t)c * 4 + h) * 2 + d) * 256 + 32 * wave + fr) * 256 + 8 * fq;
        bf16x8 ca[2][8];
#pragma unroll
        for (int v = 0; v < 2; ++v)
#pragma unroll
            for (int ks = 0; ks < 8; ++ks) ca[v][ks] = *(const bf16x8*)(Cp + (size_t)v * 16 * 256 + 32 * ks);
#pragma unroll
        for (int v = 0; v < 2; ++v)
#pragma unroll
            for (int tt = 0; tt < 4; ++tt) acc[d][v][tt] = (f32x4){0.f, 0.f, 0.f, 0.f};
#pragma unroll
        for (int ks = 0; ks < 8; ++ks) {
#pragma unroll
            for (int tt = 0; tt < 4; ++tt) { const bf16x8 bq = *(const LAS bf16x8*)(lds + O_QS + (16 * tt + fr) * 528 + 64 * ks + 16 * fq);
                acc[d][0][tt] = __builtin_amdgcn_mfma_f32_16x16x32_bf16(ca[0][ks], bq, acc[d][0][tt], 0, 0, 0); acc[d][1][tt] = __builtin_amdgcn_mfma_f32_16x16x32_bf16(ca[1][ks], bq, acc[d][1][tt], 0, 0, 0); } }
#pragma unroll
        for (int tt = 0; tt < 4; ++tt) { const float wi = Wi[d * 64 + 16 * tt + fr]; acc[d][0][tt] *= wi; acc[d][1][tt] *= wi; }
#pragma unroll
        for (int ks = 0; ks < 2; ++ks) { const bf16x8 va0 = *(const LAS bf16x8*)(lds + O_VT + (32 * wave + fr) * 144 + 64 * ks + 16 * fq), va1 = *(const LAS bf16x8*)(lds + O_VT + (32 * wave + 16 + fr) * 144 + 64 * ks + 16 * fq);
#pragma unroll
            for (int tt = 0; tt < 4; ++tt) { const bf16x8 bw = *(const LAS bf16x8*)(lds + O_WS + (d * 64 + 16 * tt + fr) * 144 + 64 * ks + 16 * fq);
                acc[d][0][tt] = __builtin_amdgcn_mfma_f32_16x16x32_bf16(va0, bw, acc[d][0][tt], 0, 0, 0); acc[d][1][tt] = __builtin_amdgcn_mfma_f32_16x16x32_bf16(va1, bw, acc[d][1][tt], 0, 0, 0); } }
    }
    { const int tt = wave & 3, d = wave >> 2; f32x4 dn = {0.f, 0.f, 0.f, 0.f};
      const float* np = (const float*)(P.ws + WS_NST) + (((size_t)c * 4 + h) * 2 + d) * 256 + 8 * fq;
#pragma unroll
      for (int ks = 0; ks < 8; ++ks) { bf16x8 an = {0, 0, 0, 0, 0, 0, 0, 0};
          if (fr == 0) { const f32x4 n0 = *(const f32x4*)(np + 32 * ks), n1 = *(const f32x4*)(np + 32 * ks + 4); u32x4 w; w.x = cvtpk(n0[0], n0[1]); w.y = cvtpk(n0[2], n0[3]); w.z = cvtpk(n1[0], n1[1]); w.w = cvtpk(n1[2], n1[3]); an = __builtin_bit_cast(bf16x8, w); }
          const bf16x8 bq = *(const LAS bf16x8*)(lds + O_QS + (16 * tt + fr) * 528 + 64 * ks + 16 * fq);
          dn = __builtin_amdgcn_mfma_f32_16x16x32_bf16(an, bq, dn, 0, 0, 0); }
      dn *= Wi[d * 64 + 16 * tt + fr];
#pragma unroll
      for (int ks = 0; ks < 2; ++ks) { const bf16x8 va = *(const LAS bf16x8*)(lds + O_VT + (256 + fr) * 144 + 64 * ks + 16 * fq); const bf16x8 bw = *(const LAS bf16x8*)(lds + O_WS + (d * 64 + 16 * tt + fr) * 144 + 64 * ks + 16 * fq);
          dn = __builtin_amdgcn_mfma_f32_16x16x32_bf16(va, bw, dn, 0, 0, 0); }
      if (fq == 0) dens[d * 64 + 16 * tt + fr] = dn[0]; }
    __syncthreads();
    float hv[2][4][4];
#pragma unroll
    for (int tt = 0; tt < 4; ++tt) { const int t = 16 * tt + fr; const float rf = 1.0f / fmaxf(fabsf(dens[t]), Fl[t]), rb = 1.0f / fmaxf(fabsf(dens[64 + t]), Fl[64 + t]);
        float s = 0.f, s2 = 0.f;
#pragma unroll
        for (int v = 0; v < 2; ++v)
#pragma unroll
            for (int i = 0; i < 4; ++i) { const float x = acc[0][v][tt][i] * rf + acc[1][v][tt][i] * rb; hv[v][tt][i] = x; s += x; s2 += x * x; }
        s += __shfl_xor(s, 16); s += __shfl_xor(s, 32); s2 += __shfl_xor(s2, 16); s2 += __shfl_xor(s2, 32);
        if (fq == 0) { red[(wave * 64 + t) * 2] = s; red[(wave * 64 + t) * 2 + 1] = s2; } }
    __syncthreads();
    { const float* hg = P.in[I_HNG] + h * 256; const bf16_t* UO = (const bf16_t*)(P.ws + WS_UO); bf16_t* A2 = (bf16_t*)(P.ws + WS_A2);
#pragma unroll
      for (int tt = 0; tt < 4; ++tt) { const int t = 16 * tt + fr; float s = 0.f, s2 = 0.f;
#pragma unroll
          for (int w = 0; w < 8; ++w) { s += red[(w * 64 + t) * 2]; s2 += red[(w * 64 + t) * 2 + 1]; }
          const float mu = s * (1.0f / 256.0f), var = fmaxf(s2 * (1.0f / 256.0f) - mu * mu, 0.f), rstd = 1.0f / sqrtf(var + EPSF);
#pragma unroll
          for (int v = 0; v < 2; ++v) { const int vf = 32 * wave + 16 * v + 4 * fq; const f32x4 g = *(const f32x4*)(hg + vf);
              const u32x2 ow = *(const u32x2*)(UO + (size_t)(t0 + t) * 1024 + h * 256 + vf); const float o[4] = {bflo(ow.x), bfhi(ow.x), bflo(ow.y), bfhi(ow.y)}; float r[4];
#pragma unroll
              for (int i = 0; i < 4; ++i) r[i] = (hv[v][tt][i] - mu) * rstd * g[i] * sigmoidf_(o[i]);
              u32x2 pk; pk.x = cvtpk(r[0], r[1]); pk.y = cvtpk(r[2], r[3]); *(u32x2*)(A2 + (size_t)(t0 + t) * 2048 + 1024 + h * 256 + vf) = pk; } } }
}
#define XB_TMO      128
#define XB_XCNT(j)  (256  + 64 * (j))
#define XB_XSUB(j)  (1280 + 64 * (j))
#define XB_XGEN(j)  (2304 + 64 * (j))
#define XB_TOP      3328
#define XB_TOPGEN   3392
#define XCD_BAR_WORDS 3456
#define XB_SPIN_CAP (1u << 18)
__device__ __forceinline__ unsigned xb_ld(unsigned* p)              { return __hip_atomic_load(p, __ATOMIC_RELAXED, __HIP_MEMORY_SCOPE_AGENT); }
__device__ __forceinline__ unsigned xb_add(unsigned* p, unsigned v) { return __hip_atomic_fetch_add(p, v, __ATOMIC_RELAXED, __HIP_MEMORY_SCOPE_AGENT); }
__device__ __forceinline__ unsigned xb_xcc_id() { return (unsigned)__builtin_amdgcn_s_getreg((3 << 11) | 20) & 0xFu; }
#define XB_SPIN(cond, bar) do { unsigned _sp = 0; while (cond) { __builtin_amdgcn_s_sleep(1); \
    if ((++_sp & 255u) == 0u) { if (xb_ld(&(bar)[XB_TMO])) break; if (_sp > XB_SPIN_CAP) { atomicAdd(&(bar)[XB_TMO], 1u); break; } } } } while (0)
struct XcdBarrier { unsigned* bar; unsigned x; volatile LAS unsigned* st; };
__device__ __forceinline__ XcdBarrier xcd_barrier_post(unsigned* bar, volatile LAS unsigned* st) {
    XcdBarrier b; b.bar = bar; b.x = xb_xcc_id(); b.st = st;
    if (threadIdx.x == 0) (void)xb_add(&bar[XB_XCNT(b.x)], 1u);
    return b;
}
__device__ __forceinline__ void xcd_barrier_complete(unsigned* bar, unsigned x, unsigned& nloc, unsigned& nx) {
    const unsigned G = gridDim.x * gridDim.y * gridDim.z;
    unsigned sum, cnt, mine, sp = 0u;
    for (;;) {
        sum = 0u; cnt = 0u; mine = 0u;
#pragma unroll
        for (unsigned j = 0; j < 16; ++j) { const unsigned c = xb_ld(&bar[XB_XCNT(j)]); sum += c; cnt += (c > 0u) ? 1u : 0u; mine = (j == x) ? c : mine; }
        if (sum == G) break;
        __builtin_amdgcn_s_sleep(1);
        if ((++sp & 255u) == 0u) { if (xb_ld(&bar[XB_TMO])) break; if (sp > XB_SPIN_CAP) { atomicAdd(&bar[XB_TMO], 1u); break; } }
    }
    nloc = mine > 0u ? mine : 1u; nx = cnt > 0u ? cnt : 1u;
}
__device__ __forceinline__ void xcd_barrier(const XcdBarrier& b) {
    asm volatile("s_waitcnt vmcnt(0)" ::: "memory");
    __syncthreads();
    if (threadIdx.x == 0) {
        unsigned* bar = b.bar;
        __builtin_amdgcn_s_waitcnt(0);
        unsigned nloc = b.st[0], nx = b.st[1];
        if (nloc == 0u) { xcd_barrier_complete(bar, b.x, nloc, nx); b.st[0] = nloc; b.st[1] = nx; }
        const unsigned old = xb_add(&bar[XB_XSUB(b.x)], 1u);
        const unsigned gen = old / nloc;
        if (old + 1u == (gen + 1u) * nloc) {
            __builtin_amdgcn_fence(__ATOMIC_RELEASE, "agent");
            asm volatile("s_waitcnt vmcnt(0)" ::: "memory");
            const unsigned og = xb_add(&bar[XB_TOP], 1u);
            const unsigned tg = og / nx;
            if (og + 1u == (tg + 1u) * nx) xb_add(&bar[XB_TOPGEN], 1u);
            else XB_SPIN(xb_ld(&bar[XB_TOPGEN]) == tg, bar);
            __builtin_amdgcn_fence(__ATOMIC_ACQUIRE, "agent");
            xb_add(&bar[XB_XGEN(b.x)], 1u);
            asm volatile("s_waitcnt vmcnt(0)" ::: "memory");
        } else {
            XB_SPIN(xb_ld(&bar[XB_XGEN(b.x)]) == gen, bar);
            __builtin_amdgcn_fence(__ATOMIC_ACQUIRE, "agent");
            asm volatile("s_waitcnt vmcnt(0)" ::: "memory");
        }
    }
    __syncthreads();
}
__device__ __forceinline__ void p7a_route(const Params& P) {
    const int tid = otid(), lane = tid & 63, wave = tid >> 6; const int gw = blockIdx.x * 8 + wave, NGW = gridDim.x * 8;
    const float* mod = (const float*)(P.ws + WS_MOD); const float* g = P.in[I_N2G]; const float* sumsq = (const float*)(P.ws + WS_SUMSQ);
    const float* wg = P.in[I_WGRP]; const float* wr = P.in[I_WRT]; const float* bg = P.in[I_BGRP]; const float* br = P.in[I_BRT];
    int* cnt = (int*)(P.ws + WS_CTL) + 1024; int* eid = (int*)(P.ws + WS_ROUTE); float* wtok = (float*)(P.ws + WS_ROUTE + 65536); int* spos = (int*)(P.ws + WS_ROUTE + 131072); int* perm = (int*)(P.ws + WS_PERM);
    for (int r = gw; r < SEQ; r += NGW) {
        float ss = lane < 32 ? sumsq[(size_t)r * 32 + lane] : 0.f; ss = wave_sum(ss);
        const float rstd = 1.0f / sqrtf(ss * (1.0f / D) + EPSF);
        const f32x4* hr = (const f32x4*)(P.out + (size_t)r * D) + lane;
        float lg[4], le[32];
#pragma unroll
        for (int i = 0; i < 4; ++i) lg[i] = 0.f;
#pragma unroll
        for (int i = 0; i < 32; ++i) le[i] = 0.f;
#pragma unroll 2
        for (int j = 0; j < 8; ++j) { const int d0 = 4 * lane + 256 * j; const f32x4 hv = hr[64 * j]; const f32x4 gg = *(const f32x4*)(g + d0), sc = *(const f32x4*)(mod + 8192 + d0), sh = *(const f32x4*)(mod + 6144 + d0);
            const f32x4 y = hv * rstd * gg * (sc + 1.0f) + sh;
#pragma unroll
            for (int e = 0; e < 4; ++e) { const float yv = y[e]; const f32x4 w4 = *(const f32x4*)(wg + (size_t)(d0 + e) * 4);
                lg[0] += yv * w4[0]; lg[1] += yv * w4[1]; lg[2] += yv * w4[2]; lg[3] += yv * w4[3];
                const f32x4* wrr = (const f32x4*)(wr + (size_t)(d0 + e) * 32);
#pragma unroll
                for (int q = 0; q < 8; ++q) { const f32x4 w = wrr[q]; le[4 * q] += yv * w[0]; le[4 * q + 1] += yv * w[1]; le[4 * q + 2] += yv * w[2]; le[4 * q + 3] += yv * w[3]; } } }
#pragma unroll
        for (int i = 0; i < 4; ++i) lg[i] = wave_sum(lg[i]) + bg[i];
#pragma unroll
        for (int i = 0; i < 32; ++i) le[i] = wave_sum(le[i]) + br[i];
        int gs = 0; float gm = lg[0];
#pragma unroll
        for (int i = 1; i < 4; ++i) if (lg[i] > gm) { gm = lg[i]; gs = i; }
        float gsum = 0.f;
#pragma unroll
        for (int i = 0; i < 4; ++i) gsum += __expf(lg[i] - gm);
        const float pg = 1.0f / gsum;
        float sl[8];
#pragma unroll
        for (int i = 0; i < 8; ++i) sl[i] = gs == 0 ? le[i] : gs == 1 ? le[8 + i] : gs == 2 ? le[16 + i] : le[24 + i];
        int i1 = 0; float m1 = sl[0];
#pragma unroll
        for (int i = 1; i < 8; ++i) if (sl[i] > m1) { m1 = sl[i]; i1 = i; }
        int i2 = -1; float m2 = -3.0e38f;
#pragma unroll
        for (int i = 0; i < 8; ++i) if (i != i1 && sl[i] > m2) { m2 = sl[i]; i2 = i; }
        const float p2 = __expf(m2 - m1); const float w1 = pg / (1.0f + p2), w2 = pg * p2 / (1.0f + p2);
        if (lane == 0) { const int e1 = gs * 8 + i1, e2 = gs * 8 + i2;
            const int s1 = atomicAdd(cnt + e1, 1), s2 = atomicAdd(cnt + e2, 1);
            perm[e1 * 8192 + s1] = r; perm[e2 * 8192 + s2] = r;
            eid[2 * r] = e1; eid[2 * r + 1] = e2; wtok[2 * r] = w1; wtok[2 * r + 1] = w2; spos[2 * r] = s1; spos[2 * r + 1] = s2; }
    }
}
__device__ __forceinline__ void moe_tables(const Params& P, LAS int* tab) {
    __syncthreads();
    if (threadIdx.x == 0) { const int* cnt = (const int*)(P.ws + WS_CTL) + 1024; int tt = 0;
        for (int e = 0; e < NEXP; ++e) { const int c = __hip_atomic_load(cnt + e, __ATOMIC_RELAXED, __HIP_MEMORY_SCOPE_AGENT); const int nt = (c + 255) >> 8; tab[128 + e] = tt; for (int i = 0; i < nt; ++i) tab[1 + tt + i] = e; tt += nt; }
        tab[0] = tt; }
    __syncthreads();
}
__device__ __forceinline__ void p7b_scatter(const Params& P, const LAS int* tab) {
    const int tid = otid(), lane = tid & 63, wave = tid >> 6; const int gw = blockIdx.x * 8 + wave, NGW = gridDim.x * 8;
    const float* mod = (const float*)(P.ws + WS_MOD); const float* g = P.in[I_N2G]; const float* sumsq = (const float*)(P.ws + WS_SUMSQ);
    const int* eid = (const int*)(P.ws + WS_ROUTE); const int* spos = (const int*)(P.ws + WS_ROUTE + 131072); bf16_t* FNS = (bf16_t*)(P.ws + WS_FNS);
    for (int r = gw; r < SEQ; r += NGW) {
        float ss = lane < 32 ? sumsq[(size_t)r * 32 + lane] : 0.f; ss = wave_sum(ss);
        const float rstd = 1.0f / sqrtf(ss * (1.0f / D) + EPSF);
        const int e1 = eid[2 * r], e2 = eid[2 * r + 1]; const size_t sl1 = (size_t)tab[128 + e1] * 256 + spos[2 * r], sl2 = (size_t)tab[128 + e2] * 256 + spos[2 * r + 1];
        const f32x4* hr = (const f32x4*)(P.out + (size_t)r * D) + lane; u32x2* o1 = (u32x2*)(FNS + sl1 * D) + lane; u32x2* o2 = (u32x2*)(FNS + sl2 * D) + lane;
#pragma unroll
        for (int j = 0; j < 8; ++j) { const int d0 = 4 * lane + 256 * j; const f32x4 hv = hr[64 * j]; const f32x4 gg = *(const f32x4*)(g + d0), sc = *(const f32x4*)(mod + 8192 + d0), sh = *(const f32x4*)(mod + 6144 + d0);
            const f32x4 y = hv * rstd * gg * (sc + 1.0f) + sh; u32x2 w; w.x = cvtpk(y[0], y[1]); w.y = cvtpk(y[2], y[3]); o1[64 * j] = w; o2[64 * j] = w; }
    }
}
__device__ __forceinline__ void p10_final(const Params& P, const LAS int* tab) {
    const int tid = otid(), lane = tid & 63, wave = tid >> 6; const int gw = blockIdx.x * 8 + wave, NGW = gridDim.x * 8;
    const float* mod = (const float*)(P.ws + WS_MOD); const float* fg = P.in[I_FG];
    const int* eid = (const int*)(P.ws + WS_ROUTE); const float* wtok = (const float*)(P.ws + WS_ROUTE + 65536); const int* spos = (const int*)(P.ws + WS_ROUTE + 131072); const bf16_t* Y = (const bf16_t*)(P.ws + WS_Y);
    for (int r = gw; r < SEQ; r += NGW) {
        const int e1 = eid[2 * r], e2 = eid[2 * r + 1]; const size_t sl1 = (size_t)tab[128 + e1] * 256 + spos[2 * r], sl2 = (size_t)tab[128 + e2] * 256 + spos[2 * r + 1];
        const float w1 = wtok[2 * r], w2 = wtok[2 * r + 1];
        f32x4* hr = (f32x4*)(P.out + (size_t)r * D) + lane; const u32x2* y1 = (const u32x2*)(Y + sl1 * D) + lane; const u32x2* y2 = (const u32x2*)(Y + sl2 * D) + lane;
        f32x4 v[8]; float ss = 0.f;
#pragma unroll
        for (int j = 0; j < 8; ++j) { const int d0 = 4 * lane + 256 * j; const f32x4 hv = hr[64 * j]; const f32x4 g2 = *(const f32x4*)(mod + 10240 + d0); const u32x2 a = y1[64 * j], b = y2[64 * j];
            const f32x4 ya = {bflo(a.x), bfhi(a.x), bflo(a.y), bfhi(a.y)}, yb = {bflo(b.x), bfhi(b.x), bflo(b.y), bfhi(b.y)};
            v[j] = hv + g2 * (ya * w1 + yb * w2); ss += (v[j][0] * v[j][0] + v[j][1] * v[j][1]) + (v[j][2] * v[j][2] + v[j][3] * v[j][3]); }
        const float rstd = 1.0f / sqrtf(wave_sum(ss) * (1.0f / D) + EPSF);
#pragma unroll
        for (int j = 0; j < 8; ++j) { const int d0 = 4 * lane + 256 * j; hr[64 * j] = v[j] * rstd * *(const f32x4*)(fg + d0); }
    }
}
__device__ __forceinline__ void p10_plain(const Params& P, const float* src) {
    const int tid = otid(), lane = tid & 63, wave = tid >> 6; const int gw = blockIdx.x * 8 + wave, NGW = gridDim.x * 8; const float* fg = P.in[I_FG];
    for (int r = gw; r < SEQ; r += NGW) { const f32x4* sr = (const f32x4*)(src + (size_t)r * D) + lane; f32x4* hr = (f32x4*)(P.out + (size_t)r * D) + lane; f32x4 v[8]; float ss = 0.f;
#pragma unroll
        for (int j = 0; j < 8; ++j) { v[j] = sr[64 * j]; ss += (v[j][0] * v[j][0] + v[j][1] * v[j][1]) + (v[j][2] * v[j][2] + v[j][3] * v[j][3]); }
        const float rstd = 1.0f / sqrtf(wave_sum(ss) * (1.0f / D) + EPSF);
#pragma unroll
        for (int j = 0; j < 8; ++j) hr[64 * j] = v[j] * rstd * *(const f32x4*)(fg + 4 * lane + 256 * j); }
}
#ifndef STAGE
#define STAGE 4
#endif
#ifndef N_LAUNCHES
#define N_LAUNCHES 1
#endif
constexpr int NPHASE = 12;
__global__ void __launch_bounds__(512, 2) mk_fwd(Params P) {
    extern __shared__ __attribute__((aligned(16))) unsigned char lds_raw[];
    LAS unsigned char* lds = (LAS unsigned char*)lds_raw;
    LAS int* tab = (LAS int*)(lds + LDSCTL_OFF + 4096);
    const int lo = P.ph_lo, hi = P.ph_hi; const int G = gridDim.x, bx = blockIdx.x;
#ifndef ONLYP
#define ONLYP -1
#endif
#define IN(k) ((ONLYP < 0 || ONLYP == (k)) && lo <= (k) && (k) < hi)
#if N_LAUNCHES == 2
#define SEAM(k) do { if ((k) + 1 < hi) { xcd_barrier(xbar); } } while (0)
    { volatile LAS unsigned* st = (volatile LAS unsigned*)(lds + LDS_BYTES - 64); if (threadIdx.x < 2) st[threadIdx.x] = 0u; __syncthreads(); }
    XcdBarrier xbar = xcd_barrier_post((unsigned*)(P.ws + WS_CTL) + 4096, (volatile LAS unsigned*)(lds + LDS_BYTES - 64));
#else
#define SEAM(k) do { if ((k) + 1 < hi) { cg::this_grid().sync(); } } while (0)
#endif
    if (IN(0)) {
#if STAGE >= 2
        p0_adaln(P, lds); p0_transposes(P, lds, 0, STAGE >= 4 ? TR_ITEMS_ALL : TR_ITEMS_EARLY); p0_zero_pad(P);
#endif
        SEAM(0); }
    if (IN(1)) {
#if STAGE >= 2
        p1_xn(P);
#endif
        SEAM(1); }
    if (IN(2)) {
#if STAGE >= 2
        pg8::Gemm g{(const bf16_t*)(P.ws + WS_XN), (const bf16_t*)(P.ws + WS_WINT), 2048, 2048, 2048}; SchedG1 S{G, bx}; EpiG1 E{P.ws, P.in[I_GB]};
        pg8::gemm_phase<EpiG1, SchedG1>(lds, g, S, E);
#endif
        SEAM(2); }
    if (IN(3)) {
#if STAGE >= 2
        p3_all(P, lds);
#endif
        SEAM(3); }
    if (IN(4)) {
#if STAGE >= 2
        const int NSB = STAGE >= 3 ? 144 : 0;
        if (bx < NSB) { p4_state(P, lds, bx); }
        else { pg8::Gemm g{(const bf16_t*)(P.ws + WS_DP), (const bf16_t*)(P.ws + WS_WPOOLT), 1024, 256, 256}; SchedPool S{G - NSB, bx - NSB}; EpiPool E{(bf16_t*)(P.ws + WS_A2)};
            pg8::gemm_phase<EpiPool, SchedPool>(lds, g, S, E); }
#endif
        SEAM(4); }
    if (IN(5)) {
#if STAGE >= 3
        for (int t = bx; t < 512; t += G) p5_task(P, lds, t >> 2, t & 3);
#elif STAGE == 2
        { bf16_t* A2 = (bf16_t*)(P.ws + WS_A2); for (int i = bx * 512 + threadIdx.x; i < SEQ * 128; i += G * 512) { const int r = i >> 7, c8 = i & 127; *(u32x4*)(A2 + (size_t)r * 2048 + 1024 + 8 * c8) = (u32x4){0u, 0u, 0u, 0u}; } }
#endif
        SEAM(5); }
    if (IN(6)) {
#if STAGE >= 2
        pg8::Gemm g{(const bf16_t*)(P.ws + WS_A2), (const bf16_t*)(P.ws + WS_WOUTT), 2048, 2048, 2048}; SchedG2 S{G, bx};
        EpiG2 E{P.in[I_X], (const float*)(P.ws + WS_MOD) + 4096, P.out, (float*)(P.ws + WS_SUMSQ)};
        pg8::gemm_phase<EpiG2, SchedG2>(lds, g, S, E);
#endif
        SEAM(6); }
    if (IN(7)) {
#if STAGE >= 4
        p7a_route(P);
#endif
        SEAM(7); }
    if (IN(8)) {
#if STAGE >= 4
        moe_tables(P, tab); p7b_scatter(P, tab);
#endif
        SEAM(8); }
    if (IN(9)) {
#if STAGE >= 4
        if (lo == 9) moe_tables(P, tab);
        pg8::Gemm g{(const bf16_t*)(P.ws + WS_FNS), (const bf16_t*)(P.ws + WS_W13T), 2048, 2048, 2048}; SchedMoE S{G, bx, 4, 4, tab}; EpiUp E{(bf16_t*)(P.ws + WS_H)};
        pg8::gemm_phase<EpiUp, SchedMoE>(lds, g, S, E);
#endif
        SEAM(9); }
    if (IN(10)) {
#if STAGE >= 4
        if (lo == 10) moe_tables(P, tab);
        pg8::Gemm g{(const bf16_t*)(P.ws + WS_H), (const bf16_t*)(P.ws + WS_W2T), 512, 512, 512}; SchedMoE S{G, bx, 8, 8, tab}; EpiDown E{(bf16_t*)(P.ws + WS_Y)};
        pg8::gemm_phase<EpiDown, SchedMoE>(lds, g, S, E);
#endif
        SEAM(10); }
    if (IN(11)) {
#if STAGE >= 4
        if (lo == 11) moe_tables(P, tab);
        p10_final(P, tab);
#elif STAGE >= 2
        p10_plain(P, P.out);
#else
        p10_plain(P, P.in[I_X]);
#endif
    }
#undef IN
#undef SEAM
}

extern "C" void kernel_launch(void* const* d_in, const int* in_sizes, int n_in, void* d_out, int out_size, void* d_ws, size_t ws_size, hipStream_t stream) {
    static int grid = 0;
    if (grid == 0) {
        if (n_in != 24 || out_size != SEQ * D || ws_size < WS_END) { fprintf(stderr, "kernel_launch: unexpected shapes (n_in %d, out %d, ws %zu < %zu)\n", n_in, out_size, ws_size, (size_t)WS_END); grid = -1; return; }
        int dev = 0, cus = 0, per_cu = 0;
        if (hipGetDevice(&dev) != hipSuccess || hipDeviceGetAttribute(&cus, hipDeviceAttributeMultiprocessorCount, dev) != hipSuccess) { grid = -1; return; }
        if (hipFuncSetAttribute((const void*)mk_fwd, hipFuncAttributeMaxDynamicSharedMemorySize, LDS_BYTES) != hipSuccess) { fprintf(stderr, "kernel_launch: hipFuncSetAttribute failed\n"); grid = -1; return; }
        if (hipOccupancyMaxActiveBlocksPerMultiprocessor(&per_cu, (const void*)mk_fwd, 512, LDS_BYTES) != hipSuccess || per_cu < 1) { fprintf(stderr, "kernel_launch: occupancy query says %d\n", per_cu); per_cu = 1; }
        (void)hipGetLastError();
        grid = cus;
        if (grid < 160) { fprintf(stderr, "kernel_launch: %d CUs is too few for this kernel's phase split\n", grid); grid = -1; return; }
    }
    if (grid < 0) return;
    (void)hipMemsetAsync((char*)d_ws + WS_CTL, 0, 1 * MiB, stream);
    Params p{};
    for (int i = 0; i < 24; ++i) p.in[i] = (const float*)d_in[i];
    p.out = (float*)d_out; p.ws = (unsigned char*)d_ws;
#if N_LAUNCHES == 2
    p.ph_lo = 0; p.ph_hi = NPHASE;
    hipLaunchKernelGGL(mk_fwd, dim3(grid), dim3(512), LDS_BYTES, stream, p);
#elif N_LAUNCHES == 1
    p.ph_lo = 0; p.ph_hi = NPHASE;
    void* args[] = {&p};
    hipError_t e = hipLaunchCooperativeKernel((const void*)mk_fwd, dim3(grid), dim3(512), args, LDS_BYTES, stream);
    if (e != hipSuccess) fprintf(stderr, "cooperative launch failed: %s (grid %d)\n", hipGetErrorString(e), grid);
#else
    for (int k = 0; k < NPHASE; ++k) { p.ph_lo = k; p.ph_hi = k + 1; hipLaunchKernelGGL(mk_fwd, dim3(grid), dim3(512), LDS_BYTES, stream, p);
#ifdef REP_PHASE
        if (k == REP_PHASE) hipLaunchKernelGGL(mk_fwd, dim3(grid), dim3(512), LDS_BYTES, stream, p);
#endif
    }
#endif
}
```

```cpp
#define STAGE 4
#define N_LAUNCHES 2
#include <hip/hip_runtime.h>
#include <hip/hip_cooperative_groups.h>
#include <cstdio>
#include <cstdint>
namespace cg = cooperative_groups;

#define LAS __attribute__((address_space(3)))
#define GAS __attribute__((address_space(1)))
typedef unsigned short bf16_t;
typedef short bf16x8 __attribute__((ext_vector_type(8)));
typedef float f32x4 __attribute__((ext_vector_type(4)));
typedef float f32x2 __attribute__((ext_vector_type(2)));
typedef unsigned u32x4 __attribute__((ext_vector_type(4)));
typedef unsigned u32x2 __attribute__((ext_vector_type(2)));
typedef __bf16 bf16x2_t __attribute__((ext_vector_type(2)));

#ifndef PATPROBE
#define PATPROBE 0
#endif
constexpr int D = 2048, SEQ = 8192, CTXL = 256, MTOT = SEQ + CTXL;
constexpr int INC = 5136, NPAD = 5376;
constexpr int NCH = SEQ / 64, NCHT = MTOT / 64;
constexpr int NEXP = 32, DEXP = 512;
constexpr float EPSF = 1e-6f;

constexpr size_t MiB = 1u << 20;
constexpr size_t WS_CTL = 0;
constexpr size_t WS_MOD = 1 * MiB;
constexpr size_t WS_GATES = 2 * MiB;
constexpr size_t WS_E = 3 * MiB;
constexpr size_t WS_BC = 3 * MiB + 288 * 1024;
constexpr size_t WS_GC = 3 * MiB + 576 * 1024;
constexpr size_t WS_NST = 4 * MiB;
constexpr size_t WS_SUMSQ = 5 * MiB;
constexpr size_t WS_ROUTE = 6 * MiB;
constexpr size_t WS_WRP = 7 * MiB;
constexpr size_t WS_WPOOLS = 8 * MiB;
constexpr size_t WS_WOUTT = 9 * MiB;
constexpr size_t WS_WINT = 17 * MiB;
constexpr size_t WS_W13T = 38 * MiB;
constexpr size_t WS_W2T = 166 * MiB;
constexpr size_t WS_XN = 230 * MiB;
constexpr size_t WS_UP = 263 * MiB;
constexpr size_t WS_UQ = 279 * MiB;
constexpr size_t WS_A2 = 230 * MiB;
constexpr size_t WS_UO = 295 * MiB;
constexpr size_t WS_UK = 311 * MiB;
constexpr size_t WS_UV = 328 * MiB;
constexpr size_t WS_QC = 345 * MiB;
constexpr size_t WS_KC = 361 * MiB;
constexpr size_t WS_KT = 378 * MiB;
constexpr size_t WS_VT = 395 * MiB;
constexpr size_t WS_VSF = 413 * MiB;
constexpr size_t WS_VSB = 431 * MiB;
constexpr size_t WS_CST = 449 * MiB;
constexpr size_t WS_Y = 449 * MiB;
constexpr size_t WS_H = 545 * MiB;
constexpr size_t WS_FNS = 295 * MiB;
constexpr size_t WS_END = 577 * MiB;
constexpr int MAXSLOT = 24576;

constexpr int RING_BYTES = 131072;
constexpr int LDSCTL_OFF = RING_BYTES;
constexpr int LDS_BYTES = 147456;

__device__ __forceinline__ float bf2f(unsigned short b) { return __uint_as_float((unsigned)b << 16); }
__device__ __forceinline__ unsigned cvtpk(float lo, float hi) { f32x2 v = {lo, hi}; bf16x2_t b = __builtin_convertvector(v, bf16x2_t); return __builtin_bit_cast(unsigned, b); }
__device__ __forceinline__ float bflo(unsigned w) { return __uint_as_float(w << 16); }
__device__ __forceinline__ float bfhi(unsigned w) { return __uint_as_float(w & 0xffff0000u); }
__device__ __forceinline__ float siluf(float x) { return x / (1.0f + __expf(-x)); }
__device__ __forceinline__ float sigmoidf_(float x) { return 1.0f / (1.0f + __expf(-x)); }
__device__ __forceinline__ float logsigmoidf_(float x) { return fminf(x, 0.f) - log1pf(__expf(-fabsf(x))); }
__device__ __forceinline__ float wave_sum(float v) {
#pragma unroll
    for (int o = 1; o < 64; o <<= 1) v += __shfl_xor(v, o);
    return v;
}
__device__ __forceinline__ float wave_max(float v) {
#pragma unroll
    for (int o = 1; o < 64; o <<= 1) v = fmaxf(v, __shfl_xor(v, o));
    return v;
}
__device__ __forceinline__ int otid() { int t = threadIdx.x; asm volatile("" : "+v"(t)); return t; }
#define LDS_WAIT() asm volatile("s_waitcnt lgkmcnt(0)" ::: "memory")
#define VM_WAIT() asm volatile("s_waitcnt vmcnt(0)" ::: "memory")

struct Params { const float* in[24]; float* out; unsigned char* ws; int ph_lo, ph_hi; };
enum { I_X = 0, I_C, I_CTX, I_CCTX, I_WMOD, I_BMOD, I_N1G, I_WIN, I_WCQ, I_WCK, I_GB, I_HNG, I_WPOOL, I_PSC, I_WOUT, I_N2G, I_WGRP, I_BGRP, I_WRT, I_BRT, I_W1, I_W3, I_W2, I_FG };
namespace pg8 {
constexpr int BM = 256, BK = 64, HALF = 128, HTB = HALF * BK * 2, STAGE_BYTES = 8 * HTB, NXCD = 8, WGM = 8;
__host__ __device__ __forceinline__ int lds_byte(int r, int c) { const int st = (r >> 4) * 2 + (c >> 5), rr = r & 15, cc = c & 31, ob = rr * 64 + cc * 2; return st * 1024 + (ob ^ (((ob >> 9) & 1) << 5)); }
__host__ __device__ __forceinline__ void stage_rc(int b, int& R, int& C) { const int st = b / 1024, sb = b % 1024, swz = sb ^ (((sb >> 9) & 1) << 5); R = (st >> 1) * 16 + swz / 64; C = (st & 1) * 32 + (swz % 64) / 2; }
__host__ __device__ __forceinline__ int perm32(int rho) { const int n = rho >> 4, i = rho & 15; return 8 * (i >> 2) + 4 * n + (i & 3); }

struct Unit { int am, bn, acol, ex; };
struct Gemm { const bf16_t* A; const bf16_t* Bt; int lda, ldb, K; };

__device__ __forceinline__ void static_unit(int L, int nM, int nN, int& pm, int& pn) {
    const int nwg = nM * nN; int wgid = L; { const int q = nwg / NXCD, r = nwg % NXCD, xcd = wgid % NXCD, off = wgid / NXCD; wgid = (xcd < r ? xcd * (q + 1) : r * (q + 1) + (xcd - r) * q) + off; }
    const int nig = WGM * nN, gid = wgid / nig, fm = gid * WGM, gsz = (nM - fm) < WGM ? (nM - fm) : WGM;
    pm = fm + ((wgid % nig) % gsz); pn = (wgid % nig) / gsz;
}

template <class Epi, class Sched>
__device__ __forceinline__ void gemm_phase(LAS unsigned char* lds, const Gemm g, const Sched& S, const Epi& E) {
    const int tid = otid(), wid = __builtin_amdgcn_readfirstlane(tid >> 6), lane = tid & 63, wr = wid >> 2, wc = wid & 3, fr = lane & 15, fq = lane >> 4;
    const int K = g.K, nt = K / BK;
    unsigned voffA[2], voffB[2];
#pragma unroll
    for (int i = 0; i < 2; ++i) { int R, C; stage_rc(tid * 16 + i * 8192, R, C); const int Rb = Epi::PERM ? ((R & ~31) + perm32(R & 31)) : R;
        voffA[i] = (unsigned)(R * g.lda + C) * 2u; voffB[i] = (unsigned)(Rb * g.ldb + C) * 2u; }
    const size_t kstep = (size_t)(BK * 2);
    const size_t hstepA = (size_t)HALF * g.lda * 2, hstepB = (size_t)HALF * g.ldb * 2;
    const size_t tstepA = 2 * hstepA, tstepB = 2 * hstepB;
    const unsigned ldsw = (unsigned)wid * 1024u;
    const int aoff = lds_byte(wr * 64 + fr, fq * 8), boff = lds_byte(wc * 32 + fr, fq * 8);
#define PG8_SA(b, h) (((b) * 2 + (h)) * HTB)
#define PG8_SB(b, h) ((4 + (b) * 2 + (h)) * HTB)
#define PG8_STAGE(bufoff, gbase, voff) do { _Pragma("unroll") for (int _i = 0; _i < 2; ++_i) \
        __builtin_amdgcn_global_load_lds((const unsigned*)((const char*)(gbase) + (voff)[_i]), (LAS unsigned*)(lds + (bufoff) + ldsw + _i * 8192), 16, 0, 0); } while (0)
#define PG8_LDA(dst, b, h) do { _Pragma("unroll") for (int m = 0; m < 4; ++m) _Pragma("unroll") for (int k = 0; k < 2; ++k) dst[m][k] = *(const LAS bf16x8*)(lds + PG8_SA(b, h) + aoff + m * 2048 + k * 1024); } while (0)
#define PG8_LDB(dst, b, h) do { _Pragma("unroll") for (int n = 0; n < 2; ++n) _Pragma("unroll") for (int k = 0; k < 2; ++k) dst[n][k] = *(const LAS bf16x8*)(lds + PG8_SB(b, h) + boff + n * 2048 + k * 1024); } while (0)
#define PG8_MMA(ai, bj, At, Bt) do { __builtin_amdgcn_s_setprio(1); _Pragma("unroll") for (int m = 0; m < 4; ++m) _Pragma("unroll") for (int n = 0; n < 2; ++n) _Pragma("unroll") for (int k = 0; k < 2; ++k) \
        acc[ai][bj][m][n] = __builtin_amdgcn_mfma_f32_16x16x32_bf16(Bt[n][k], At[m][k], acc[ai][bj][m][n], 0, 0, 0); __builtin_amdgcn_s_setprio(0); } while (0)
#define PG8_WAIT_V(n) asm volatile("s_waitcnt vmcnt(" #n ")" ::: "memory")
#define PG8_WAIT_L(n) asm volatile("s_waitcnt lgkmcnt(" #n ")" ::: "memory")
#define PG8_BAR __builtin_amdgcn_s_barrier()
#define PG8_SCHED __builtin_amdgcn_sched_barrier(0)
    Unit cur, nxt; int ui = 0;
    if (!S.next(0, cur)) return;
    f32x4 acc[2][2][4][2];
#pragma unroll
    for (int a = 0; a < 2; ++a)
#pragma unroll
        for (int b = 0; b < 2; ++b)
#pragma unroll
            for (int m = 0; m < 4; ++m)
#pragma unroll
                for (int n = 0; n < 2; ++n) acc[a][b][m][n] = (f32x4){0.f, 0.f, 0.f, 0.f};
    bf16x8 At[4][2], B0[2][2], B1[2][2];
    const char* cA = (const char*)g.A + (size_t)cur.am * tstepA + (size_t)cur.acol * 2; const char* cB = (const char*)g.Bt + (size_t)cur.bn * tstepB;
    PG8_STAGE(PG8_SB(0, 0), cB, voffB); PG8_STAGE(PG8_SB(0, 1), cB + hstepB, voffB); PG8_STAGE(PG8_SA(0, 0), cA, voffA); PG8_STAGE(PG8_SA(0, 1), cA + hstepA, voffA);
    if (wr == 1) PG8_BAR;
    PG8_WAIT_V(2); PG8_BAR;
    PG8_STAGE(PG8_SB(1, 0), cB + kstep, voffB); PG8_STAGE(PG8_SA(1, 0), cA + kstep, voffA); PG8_STAGE(PG8_SB(1, 1), cB + hstepB + kstep, voffB);
    PG8_WAIT_V(6); PG8_BAR;
    for (;;) {
        const bool has_next = S.next(ui + 1, nxt);
        const char* nA = has_next ? (const char*)g.A + (size_t)nxt.am * tstepA + (size_t)nxt.acol * 2 : cA; const char* nB = has_next ? (const char*)g.Bt + (size_t)nxt.bn * tstepB : cB;
#pragma unroll 1
        for (int t = 0; t < nt; t += 2) {
            const bool last = (t == nt - 2);
            const char* a1 = cA + (size_t)(t + 1) * kstep;
            const char* a2 = last ? nA : cA + (size_t)(t + 2) * kstep; const char* b2 = last ? nB : cB + (size_t)(t + 2) * kstep;
            const char* a3 = a2 + kstep; const char* b3 = b2 + kstep;
            PG8_LDB(B0, 0, 0); PG8_LDB(B1, 0, 1); PG8_SCHED; PG8_LDA(At, 0, 0); PG8_STAGE(PG8_SA(1, 1), a1 + hstepA, voffA);
            PG8_WAIT_V(8); PG8_WAIT_L(0); PG8_BAR; PG8_MMA(0, 0, At, B0); PG8_MMA(0, 1, At, B1); PG8_BAR; PG8_SCHED;
            PG8_LDA(At, 0, 1); PG8_STAGE(PG8_SB(0, 0), b2, voffB); PG8_STAGE(PG8_SB(0, 1), b2 + hstepB, voffB); PG8_STAGE(PG8_SA(0, 0), a2, voffA);
            PG8_WAIT_V(8); PG8_WAIT_L(0); PG8_BAR; PG8_MMA(1, 0, At, B0); PG8_MMA(1, 1, At, B1); PG8_BAR; PG8_SCHED;
            PG8_LDB(B0, 1, 0); PG8_LDB(B1, 1, 1); PG8_SCHED; PG8_LDA(At, 1, 0); PG8_STAGE(PG8_SA(0, 1), a2 + hstepA, voffA);
            PG8_WAIT_V(8); PG8_WAIT_L(0); PG8_BAR; PG8_MMA(0, 0, At, B0); PG8_MMA(0, 1, At, B1); PG8_BAR; PG8_SCHED;
            PG8_LDA(At, 1, 1); PG8_STAGE(PG8_SB(1, 0), b3, voffB); PG8_STAGE(PG8_SB(1, 1), b3 + hstepB, voffB); PG8_STAGE(PG8_SA(1, 0), a3, voffA);
            PG8_WAIT_V(8); PG8_WAIT_L(0); PG8_BAR; PG8_MMA(1, 0, At, B0); PG8_MMA(1, 1, At, B1); PG8_BAR; PG8_SCHED;
        }
        if (wr == 0) PG8_BAR;
        E(acc, cur, wr, wc, fr, fq);
        if (!has_next) break;
#pragma unroll
        for (int a = 0; a < 2; ++a)
#pragma unroll
            for (int b = 0; b < 2; ++b)
#pragma unroll
                for (int m = 0; m < 4; ++m)
#pragma unroll
                    for (int n = 0; n < 2; ++n) acc[a][b][m][n] = (f32x4){0.f, 0.f, 0.f, 0.f};
        cur = nxt; cA = nA; cB = nB; ++ui;
        if (wr == 1) PG8_BAR;
    }
    PG8_WAIT_V(0);
    PG8_BAR;
#undef PG8_SA
#undef PG8_SB
#undef PG8_STAGE
#undef PG8_LDA
#undef PG8_LDB
#undef PG8_MMA
#undef PG8_WAIT_V
#undef PG8_WAIT_L
#undef PG8_BAR
#undef PG8_SCHED
}
}
using pg8::Unit;
struct SchedG1 { int G, c;
    __device__ __forceinline__ bool next(int i, Unit& u) const { const int L = i * G + c; if (L >= 681) return false;
        if (L < 672) { int pm, pn; pg8::static_unit(L, 32, 21, pm, pn); u.am = pm; u.bn = pn; } else { u.am = 32; u.bn = 12 + (L - 672); }
        u.acol = 0; u.ex = 0; return true; } };
struct EpiG1 { static constexpr bool PERM = true;
    unsigned char* ws; const float* gate_bias;
    __device__ __forceinline__ void operator()(const f32x4 (&acc)[2][2][4][2], const Unit& u, int wr, int wc, int fr, int fq) const {
        const int row0 = u.am * 256 + wr * 64 + fr; const int seg = u.bn >> 2;
        if (seg < 5) {
            const size_t so = seg == 0 ? WS_UP : seg == 1 ? WS_UQ : seg == 2 ? WS_UO : seg == 3 ? WS_UK : WS_UV;
            bf16_t* base = (bf16_t*)(ws + so); const int col0 = (u.bn & 3) * 256 + wc * 32 + 8 * fq;
#pragma unroll
            for (int ai = 0; ai < 2; ++ai)
#pragma unroll
                for (int m = 0; m < 4; ++m) { bf16_t* rowp = base + (size_t)(row0 + ai * 128 + m * 16) * 1024 + col0;
#pragma unroll
                    for (int bj = 0; bj < 2; ++bj) { const f32x4 v0 = acc[ai][bj][m][0], v1 = acc[ai][bj][m][1];
                        u32x4 w; w.x = cvtpk(v0[0], v0[1]); w.y = cvtpk(v0[2], v0[3]); w.z = cvtpk(v1[0], v1[1]); w.w = cvtpk(v1[2], v1[3]);
                        *(u32x4*)(rowp + bj * 128) = w; } }
        } else {
            if (wc == 0 && fq < 2) { float* G = (float*)(ws + WS_GATES);
                const f32x4 b0 = *(const f32x4*)(gate_bias + 8 * fq), b1 = *(const f32x4*)(gate_bias + 8 * fq + 4);
#pragma unroll
                for (int ai = 0; ai < 2; ++ai)
#pragma unroll
                    for (int m = 0; m < 4; ++m) { float* rowp = G + (size_t)(row0 + ai * 128 + m * 16) * 16 + 8 * fq;
                        *(f32x4*)(rowp) = acc[ai][0][m][0] + b0; *(f32x4*)(rowp + 4) = acc[ai][0][m][1] + b1; } }
        }
    } };
struct SchedWeff { int G, c;
    __device__ __forceinline__ bool next(int i, Unit& u) const { if (c < 0) return false; const int L = i * G + c; if (L >= 32) return false;
        u.am = L >> 2; u.bn = L & 3; u.acol = (L & 3) * 256; u.ex = 0; return true; } };
struct EpiWeff { static constexpr bool PERM = true;
    bf16_t* W;
    __device__ __forceinline__ void operator()(const f32x4 (&acc)[2][2][4][2], const Unit& u, int wr, int wc, int fr, int fq) const {
        const int row0 = u.am * 256 + wr * 64 + fr; const int col0 = u.bn * 256 + wc * 32 + 8 * fq;
#pragma unroll
        for (int ai = 0; ai < 2; ++ai)
#pragma unroll
            for (int m = 0; m < 4; ++m) { bf16_t* rowp = W + (size_t)(row0 + ai * 128 + m * 16) * 2048 + col0;
#pragma unroll
                for (int bj = 0; bj < 2; ++bj) { const f32x4 v0 = acc[ai][bj][m][0], v1 = acc[ai][bj][m][1];
                    u32x4 w; w.x = cvtpk(v0[0], v0[1]); w.y = cvtpk(v0[2], v0[3]); w.z = cvtpk(v1[0], v1[1]); w.w = cvtpk(v1[2], v1[3]);
                    *(u32x4*)(rowp + bj * 128) = w; } }
    } };
struct SchedG2 { int G, c;
    __device__ __forceinline__ bool next(int i, Unit& u) const { const int L = i * G + c; if (L >= 256) return false;
        int pm, pn; pg8::static_unit(L, 32, 8, pm, pn); u.am = pm; u.bn = pn; u.acol = 0; u.ex = 0; return true; } };
struct EpiG2 { static constexpr bool PERM = false;
    const float* x; const float* g1; float* out; float* sumsq;
    __device__ __forceinline__ void operator()(const f32x4 (&acc)[2][2][4][2], const Unit& u, int wr, int wc, int fr, int fq) const {
        const int row0 = u.am * 256 + wr * 64 + fr, col0 = u.bn * 256 + wc * 32 + 4 * fq;
        f32x4 gv[2][2];
#pragma unroll
        for (int bj = 0; bj < 2; ++bj)
#pragma unroll
            for (int n = 0; n < 2; ++n) gv[bj][n] = *(const f32x4*)(g1 + col0 + bj * 128 + n * 16);
#pragma unroll
        for (int ai = 0; ai < 2; ++ai)
#pragma unroll
            for (int m = 0; m < 4; ++m) { const int row = row0 + ai * 128 + m * 16; const size_t off = (size_t)row * 2048 + col0; float ss = 0.f;
#pragma unroll
                for (int bj = 0; bj < 2; ++bj)
#pragma unroll
                    for (int n = 0; n < 2; ++n) { const f32x4 xv = *(const f32x4*)(x + off + bj * 128 + n * 16); const f32x4 h = xv + gv[bj][n] * acc[ai][bj][m][n];
                        *(f32x4*)(out + off + bj * 128 + n * 16) = h; ss += (h[0] * h[0] + h[1] * h[1]) + (h[2] * h[2] + h[3] * h[3]); }
                ss += __shfl_xor(ss, 16); ss += __shfl_xor(ss, 32);
                if (fq == 0) sumsq[(size_t)row * 32 + u.bn * 4 + wc] = ss; }
    } };
struct SchedMoE { int G, c, NN, btpe; const LAS int* tab;
    __device__ __forceinline__ bool next(int i, Unit& u) const { const int L = i * G + c; const int nt = tab[0]; if (L >= nt * NN) return false;
        const int tau = L / NN, pn = L - tau * NN; const int e = tab[1 + tau]; u.am = tau; u.bn = e * btpe + pn; u.acol = 0; u.ex = pn; return true; } };
struct EpiUp { static constexpr bool PERM = true;
    bf16_t* H;
    __device__ __forceinline__ void operator()(const f32x4 (&acc)[2][2][4][2], const Unit& u, int wr, int wc, int fr, int fq) const {
        const int row0 = u.am * 256 + wr * 64 + fr; const int col0 = u.ex * 128 + wc * 16 + 4 * fq;
#pragma unroll
        for (int ai = 0; ai < 2; ++ai)
#pragma unroll
            for (int m = 0; m < 4; ++m) { bf16_t* rowp = H + (size_t)(row0 + ai * 128 + m * 16) * 512 + col0;
#pragma unroll
                for (int bj = 0; bj < 2; ++bj) { const f32x4 v0 = acc[ai][bj][m][0], v1 = acc[ai][bj][m][1];
                    u32x2 w; w.x = cvtpk(siluf(v0[0]) * v0[1], siluf(v0[2]) * v0[3]); w.y = cvtpk(siluf(v1[0]) * v1[1], siluf(v1[2]) * v1[3]);
                    *(u32x2*)(rowp + bj * 64) = w; } }
    } };
struct EpiDown { static constexpr bool PERM = true;
    bf16_t* Y;
    __device__ __forceinline__ void operator()(const f32x4 (&acc)[2][2][4][2], const Unit& u, int wr, int wc, int fr, int fq) const {
        const int row0 = u.am * 256 + wr * 64 + fr; const int col0 = u.ex * 256 + wc * 32 + 8 * fq;
#pragma unroll
        for (int ai = 0; ai < 2; ++ai)
#pragma unroll
            for (int m = 0; m < 4; ++m) { bf16_t* rowp = Y + (size_t)(row0 + ai * 128 + m * 16) * 2048 + col0;
#pragma unroll
                for (int bj = 0; bj < 2; ++bj) { const f32x4 v0 = acc[ai][bj][m][0], v1 = acc[ai][bj][m][1];
                    u32x4 w; w.x = cvtpk(v0[0], v0[1]); w.y = cvtpk(v0[2], v0[3]); w.z = cvtpk(v1[0], v1[1]); w.w = cvtpk(v1[2], v1[3]);
                    *(u32x4*)(rowp + bj * 128) = w; } }
    } };
__device__ __forceinline__ void p0_adaln(const Params& P, LAS unsigned char* lds) {
    const int tid = otid();
    LAS float* sc = (LAS float*)lds; LAS float* scc = sc + 2048; LAS float* red = scc + 2048; LAS float* red2 = red + 42 * 48;
    const float* c = P.in[I_C]; const float* cc = P.in[I_CCTX]; const float* wmod = P.in[I_WMOD]; const float* bmod = P.in[I_BMOD];
    float* mod = (float*)(P.ws + WS_MOD); float* modc = mod + 16384;
    for (int i = tid; i < 2048; i += 512) { sc[i] = siluf(c[i]); scc[i] = siluf(cc[i]); }
    __syncthreads();
    for (int cb = blockIdx.x; cb < 256; cb += gridDim.x) {
        const int n0 = 48 * cb; const bool has_ctx = n0 < 4096;
        if (tid < 504) { const int col4 = tid % 12, rg = tid / 12;
            const f32x4* wp = (const f32x4*)(wmod + n0) + col4;
            f32x4 a = {0.f, 0.f, 0.f, 0.f}, a2 = {0.f, 0.f, 0.f, 0.f};
#pragma unroll 7
            for (int k = rg; k < 2048; k += 42) { const f32x4 w = wp[(size_t)k * 3072]; a += w * sc[k]; if (has_ctx) a2 += w * scc[k]; }
            *(LAS f32x4*)(red + rg * 48 + col4 * 4) = a; *(LAS f32x4*)(red2 + rg * 48 + col4 * 4) = a2; }
        __syncthreads();
        if (tid < 48) { float s = 0.f; for (int r = 0; r < 42; ++r) s += red[r * 48 + tid]; mod[n0 + tid] = s + bmod[n0 + tid]; }
        else if (has_ctx && tid >= 64 && tid < 112) { const int t = tid - 64; if (n0 + t < 4096) { float s = 0.f; for (int r = 0; r < 42; ++r) s += red2[r * 48 + t]; modc[n0 + t] = s + bmod[n0 + t]; } }
        __syncthreads();
    }
}
__device__ __forceinline__ void transpose_item(const float* W, int K, int N, bf16_t* WT, int row_off, int rmul, LAS float* scr, int item, int lane, const float* nscale = nullptr) {
    const int nblk = (N + 31) >> 5, kb = item / nblk, nb = item - kb * nblk, k0 = 64 * kb, n0 = 32 * nb;
    const int c4 = lane & 7, nn = n0 + 4 * c4; const bool ok = nn < N;
    f32x4 scl = {1.f, 1.f, 1.f, 1.f}; if (nscale && ok) scl = *(const f32x4*)(nscale + nn);
    f32x4 v[8];
#pragma unroll
    for (int i = 0; i < 8; ++i) { const int kk = 8 * i + (lane >> 3); v[i] = ok ? *(const f32x4*)(W + (size_t)(k0 + kk) * N + nn) : (f32x4){0.f, 0.f, 0.f, 0.f}; }
#pragma unroll
    for (int i = 0; i < 8; ++i) { const int kk = 8 * i + (lane >> 3); const f32x4 x = v[i] * scl; LAS float* d = scr + kk * 33 + 4 * c4; d[0] = x[0]; d[1] = x[1]; d[2] = x[2]; d[3] = x[3]; }
    LDS_WAIT(); asm volatile("" ::: "memory");
    const int cch = lane & 7;
#pragma unroll
    for (int j = 0; j < 4; ++j) { const int n = (lane >> 3) + 8 * j; const LAS float* s = scr + (8 * cch) * 33 + n;
        u32x4 o; o.x = cvtpk(s[0 * 33], s[1 * 33]); o.y = cvtpk(s[2 * 33], s[3 * 33]); o.z = cvtpk(s[4 * 33], s[5 * 33]); o.w = cvtpk(s[6 * 33], s[7 * 33]);
        *(u32x4*)(WT + (size_t)(row_off + (n0 + n) * rmul) * K + k0 + 8 * cch) = o; }
    LDS_WAIT(); asm volatile("" ::: "memory");
}
__device__ __forceinline__ void p0_transposes(const Params& P, LAS unsigned char* lds, int lo_item, int hi_item) {
    const int tid = otid(), lane = tid & 63, wave = __builtin_amdgcn_readfirstlane(tid >> 6);
    LAS float* scr = (LAS float*)(lds + 32768 + wave * 8704);
    const int gw = blockIdx.x * 8 + wave, NGW = gridDim.x * 8;
    constexpr int I_IN = 32 * 161, I_OUT = 32 * 64, I_PL = 4 * 32, I_E13 = 32 * 16, I_E2 = 8 * 64;
    constexpr int B_OUT = I_IN, B_PL = B_OUT + I_OUT, B_W1 = B_PL + I_PL, B_W3 = B_W1 + 32 * I_E13, B_W2 = B_W3 + 32 * I_E13, B_END = B_W2 + 32 * I_E2;
    if (hi_item > B_END) hi_item = B_END;
    for (int it = lo_item + gw; it < hi_item; it += NGW) {
        if (it < B_OUT) transpose_item(P.in[I_WIN], 2048, INC, (bf16_t*)(P.ws + WS_WINT), 0, 1, scr, it, lane);
        else if (it < B_PL) transpose_item(P.in[I_WOUT], 2048, 2048, (bf16_t*)(P.ws + WS_WOUTT), 0, 1, scr, it - B_OUT, lane);
        else if (it < B_W1) { }
        else if (it < B_W3) { const int r = it - B_W1, e = r / I_E13; transpose_item(P.in[I_W1] + (size_t)e * 2048 * 512, 2048, 512, (bf16_t*)(P.ws + WS_W13T) + (size_t)e * 1024 * 2048, 0, 2, scr, r - e * I_E13, lane); }
        else if (it < B_W2) { const int r = it - B_W3, e = r / I_E13; transpose_item(P.in[I_W3] + (size_t)e * 2048 * 512, 2048, 512, (bf16_t*)(P.ws + WS_W13T) + (size_t)e * 1024 * 2048, 1, 2, scr, r - e * I_E13, lane); }
        else { const int r = it - B_W2, e = r / I_E2; transpose_item(P.in[I_W2] + (size_t)e * 512 * 2048, 512, 2048, (bf16_t*)(P.ws + WS_W2T) + (size_t)e * 2048 * 512, 0, 1, scr, r - e * I_E2, lane); }
    }
}
constexpr int TR_ITEMS_EARLY = 32 * 161 + 32 * 64 + 4 * 32;
constexpr int TR_ITEMS_ALL = TR_ITEMS_EARLY + 64 * 512 + 32 * 512;
__device__ __forceinline__ void p0_wpool_scaled(const Params& P) {
    const float* wp = P.in[I_WPOOL]; const float* ps = P.in[I_PSC]; u32x2* o = (u32x2*)(P.ws + WS_WPOOLS);
    for (int i = blockIdx.x * 512 + threadIdx.x; i < 65536; i += gridDim.x * 512) { const f32x4 w = *(const f32x4*)(wp + (size_t)4 * i); const int g = i >> 14, d0 = (4 * i) & 255; const f32x4 sc = *(const f32x4*)(ps + g * 256 + d0);
        const f32x4 y = w * sc; u32x2 r; r.x = cvtpk(y[0], y[1]); r.y = cvtpk(y[2], y[3]); o[i] = r; }
}
__device__ __forceinline__ void p0_zero_pad(const Params& P) {
    u32x4* z = (u32x4*)((bf16_t*)(P.ws + WS_WINT) + (size_t)5152 * 2048); const int n = (NPAD - 5152) * 2048 / 8;
    for (int i = blockIdx.x * 512 + threadIdx.x; i < n; i += gridDim.x * 512) z[i] = (u32x4){0u, 0u, 0u, 0u};
}
__device__ __forceinline__ void p1_router_prep(const Params& P) {
    const int tid = otid(), lane = tid & 63, wave = tid >> 6;
    const float* mod = (const float*)(P.ws + WS_MOD); const float* g = P.in[I_N2G]; const float* wg = P.in[I_WGRP]; const float* wr = P.in[I_WRT];
    float* WRP = (float*)(P.ws + WS_WRP); float* BRP = (float*)(P.ws + WS_WRP + 448 * 1024);
    for (int idx = blockIdx.x * 512 + tid; idx < 2048 * 48; idx += gridDim.x * 512) { const int k = idx / 48, c = idx - 48 * k;
        const float w = c < 32 ? wr[k * 32 + c] : c < 36 ? wg[k * 4 + c - 32] : 0.f;
        WRP[(size_t)((k >> 2) * 48 + c) * 4 + (k & 3)] = w * g[k] * (1.0f + mod[8192 + k]); }
    if (wave == 0) for (int c = blockIdx.x; c < 48; c += gridDim.x) { float s = 0.f;
        if (c < 36) { for (int k = lane; k < 2048; k += 64) s += mod[6144 + k] * (c < 32 ? wr[k * 32 + c] : wg[k * 4 + c - 32]); s = wave_sum(s) + (c < 32 ? P.in[I_BRT][c] : P.in[I_BGRP][c - 32]); }
        if (lane == 0) BRP[c] = s; }
}
__device__ __forceinline__ void p1_xn(const Params& P, int nwg) {
    const int tid = otid(), lane = tid & 63, wave = tid >> 6;
    const int gw = blockIdx.x * 8 + wave, NGW = nwg * 8;
    const float* mod = (const float*)(P.ws + WS_MOD); const float* modc = mod + 16384; const float* g = P.in[I_N1G];
    bf16_t* XN = (bf16_t*)(P.ws + WS_XN);
    for (int pass = 0; pass < 2; ++pass) {
        const float* sh = pass == 0 ? mod : modc; const float* scl = pass == 0 ? mod + 2048 : modc + 2048;
        const float* src = pass == 0 ? P.in[I_X] : P.in[I_CTX]; const int nrows = pass == 0 ? SEQ : CTXL; const int rbase = pass == 0 ? 0 : SEQ;
        if (gw >= nrows) continue;
        f32x4 a[8], s[8];
#pragma unroll
        for (int j = 0; j < 8; ++j) { const int d0 = 4 * lane + 256 * j; const f32x4 gg = *(const f32x4*)(g + d0), sv = *(const f32x4*)(scl + d0); a[j] = gg * (sv + 1.0f); s[j] = *(const f32x4*)(sh + d0); }
        for (int r = gw; r < nrows; r += NGW) {
            const f32x4* xr = (const f32x4*)(src + (size_t)r * D) + lane; f32x4 v[8]; float ss = 0.f;
#pragma unroll
            for (int j = 0; j < 8; ++j) { v[j] = xr[64 * j]; ss += (v[j][0] * v[j][0] + v[j][1] * v[j][1]) + (v[j][2] * v[j][2] + v[j][3] * v[j][3]); }
            const float rstd = 1.0f / sqrtf(wave_sum(ss) * (1.0f / D) + EPSF);
            u32x2* o = (u32x2*)(XN + (size_t)(rbase + r) * D) + lane;
#pragma unroll
            for (int j = 0; j < 8; ++j) { const f32x4 y = v[j] * rstd * a[j] + s[j]; u32x2 w; w.x = cvtpk(y[0], y[1]); w.y = cvtpk(y[2], y[3]); o[64 * j] = w; }
        }
    }
}
__device__ __forceinline__ void p3_qk_task(const Params& P, int isk, int j, int h) {
    const int tid = otid(), o = tid >> 6, f4 = tid & 63;
    const int t0 = 64 * j, seq_lo = j < 128 ? 0 : SEQ, seq_hi = j < 128 ? SEQ : MTOT;
    const bf16_t* U = (const bf16_t*)(P.ws + (isk ? WS_UK : WS_UQ)); const float* wc = P.in[isk ? I_WCK : I_WCQ];
    const int f0 = h * 256 + 4 * f4;
    const f32x4 w0 = *(const f32x4*)(wc + f0), w1 = *(const f32x4*)(wc + 1024 + f0), w2 = *(const f32x4*)(wc + 2048 + f0);
    const float osc = isk ? 1.0f : 0.0625f;
    u32x2 raw[10];
#pragma unroll
    for (int i = 0; i < 10; ++i) { const int t = t0 + 8 * o - 1 + i; raw[i] = (t >= seq_lo && t < seq_hi) ? *(const u32x2*)(U + (size_t)t * 1024 + f0) : (u32x2){0u, 0u}; }
    float outv[8][4];
#pragma unroll
    for (int i = 0; i < 8; ++i) {
        const f32x4 a = {bflo(raw[i].x), bfhi(raw[i].x), bflo(raw[i].y), bfhi(raw[i].y)}, b = {bflo(raw[i + 1].x), bfhi(raw[i + 1].x), bflo(raw[i + 1].y), bfhi(raw[i + 1].y)},
                    c = {bflo(raw[i + 2].x), bfhi(raw[i + 2].x), bflo(raw[i + 2].y), bfhi(raw[i + 2].y)};
        const f32x4 s = a * w0 + b * w1 + c * w2;
#pragma unroll
        for (int e = 0; e < 4; ++e) outv[i][e] = siluf(s[e]) * osc;
    }
    bf16_t* R = (bf16_t*)(P.ws + (isk ? WS_KC : WS_QC));
#pragma unroll
    for (int i = 0; i < 8; ++i) { u32x2 w; w.x = cvtpk(outv[i][0], outv[i][1]); w.y = cvtpk(outv[i][2], outv[i][3]); *(u32x2*)(R + (size_t)(t0 + 8 * o + i) * 1024 + f0) = w; }
    if (isk) { bf16_t* KT = (bf16_t*)(P.ws + WS_KT);
#pragma unroll
        for (int e = 0; e < 4; ++e) { u32x4 w; w.x = cvtpk(outv[0][e], outv[1][e]); w.y = cvtpk(outv[2][e], outv[3][e]); w.z = cvtpk(outv[4][e], outv[5][e]); w.w = cvtpk(outv[6][e], outv[7][e]);
            *(u32x4*)(KT + ((size_t)(h * 132 + j) * 256 + 4 * f4 + e) * 64 + 8 * o) = w; } }
}
__device__ __forceinline__ void p3_v_task(const Params& P, LAS unsigned char* lds, int j, int h) {
    const int tid = otid(), lane = tid & 63, wave = tid >> 6, o = tid >> 6, f4 = tid & 63;
    const int t0 = 64 * j; LAS float* wkl = (LAS float*)lds;
    __syncthreads();
    if (wave < 2) { const int d = wave; const float* G = (const float*)(P.ws + WS_GATES) + (size_t)(t0 + lane) * 16;
        const float ig = G[(2 * d) * 4 + h], fg = G[(2 * d + 1) * 4 + h];
        float b = logsigmoidf_(fg);
        if (d == 0) {
#pragma unroll
            for (int s = 1; s < 64; s <<= 1) { const float t = __shfl_up(b, s); if (lane >= s) b += t; }
        } else {
#pragma unroll
            for (int s = 1; s < 64; s <<= 1) { const float t = __shfl_down(b, s); if (lane + s < 64) b += t; }
        }
        const float gtot = __shfl(b, d == 0 ? 63 : 0); const float e = ig - b; const float em = wave_max(e);
        const size_t ix = (size_t)(d * 4 + h) * MTOT + t0 + lane;
        ((float*)(P.ws + WS_E))[ix] = e; ((float*)(P.ws + WS_BC))[ix] = b;
        if (lane == 0) { float* gc = (float*)(P.ws + WS_GC); gc[(d * 4 + h) * 132 + j] = gtot; gc[2048 + (d * 4 + h) * 132 + j] = em; }
        wkl[d * 64 + lane] = __expf(e - em);
    }
    __syncthreads();
    const bf16_t* U = (const bf16_t*)(P.ws + WS_UV); const int f0 = h * 256 + 4 * f4;
    float v[8][4];
#pragma unroll
    for (int i = 0; i < 8; ++i) { const u32x2 r = *(const u32x2*)(U + (size_t)(t0 + 8 * o + i) * 1024 + f0); v[i][0] = bflo(r.x); v[i][1] = bfhi(r.x); v[i][2] = bflo(r.y); v[i][3] = bfhi(r.y); }
    bf16_t* VT = (bf16_t*)(P.ws + WS_VT); bf16_t* VSF = (bf16_t*)(P.ws + WS_VSF); bf16_t* VSB = (bf16_t*)(P.ws + WS_VSB);
    float sf[8], sb[8];
#pragma unroll
    for (int i = 0; i < 8; ++i) { sf[i] = wkl[8 * o + i]; sb[i] = wkl[64 + 8 * o + i]; }
#pragma unroll
    for (int e = 0; e < 4; ++e) { const size_t off = ((size_t)(h * 132 + j) * 272 + 4 * f4 + e) * 64 + 8 * o; u32x4 w;
        w.x = cvtpk(v[0][e], v[1][e]); w.y = cvtpk(v[2][e], v[3][e]); w.z = cvtpk(v[4][e], v[5][e]); w.w = cvtpk(v[6][e], v[7][e]); *(u32x4*)(VT + off) = w;
        w.x = cvtpk(v[0][e] * sf[0], v[1][e] * sf[1]); w.y = cvtpk(v[2][e] * sf[2], v[3][e] * sf[3]); w.z = cvtpk(v[4][e] * sf[4], v[5][e] * sf[5]); w.w = cvtpk(v[6][e] * sf[6], v[7][e] * sf[7]); *(u32x4*)(VSF + off) = w;
        w.x = cvtpk(v[0][e] * sb[0], v[1][e] * sb[1]); w.y = cvtpk(v[2][e] * sb[2], v[3][e] * sb[3]); w.z = cvtpk(v[4][e] * sb[4], v[5][e] * sb[5]); w.w = cvtpk(v[6][e] * sb[6], v[7][e] * sb[7]); *(u32x4*)(VSB + off) = w; }
    if (tid < 128) {
        const int rr = tid >> 3, oc = tid & 7; const size_t off = ((size_t)(h * 132 + j) * 272 + 256 + rr) * 64 + 8 * oc; u32x4 w1 = {0u, 0u, 0u, 0u}, wf = w1, wb = w1;
        if (rr == 0) { w1 = (u32x4){0x3f803f80u, 0x3f803f80u, 0x3f803f80u, 0x3f803f80u};
            wf.x = cvtpk(wkl[8 * oc], wkl[8 * oc + 1]); wf.y = cvtpk(wkl[8 * oc + 2], wkl[8 * oc + 3]); wf.z = cvtpk(wkl[8 * oc + 4], wkl[8 * oc + 5]); wf.w = cvtpk(wkl[8 * oc + 6], wkl[8 * oc + 7]);
            wb.x = cvtpk(wkl[64 + 8 * oc], wkl[64 + 8 * oc + 1]); wb.y = cvtpk(wkl[64 + 8 * oc + 2], wkl[64 + 8 * oc + 3]); wb.z = cvtpk(wkl[64 + 8 * oc + 4], wkl[64 + 8 * oc + 5]); wb.w = cvtpk(wkl[64 + 8 * oc + 6], wkl[64 + 8 * oc + 7]); }
        *(u32x4*)(VT + off) = w1; *(u32x4*)(VSF + off) = wf; *(u32x4*)(VSB + off) = wb; }
}
__device__ __forceinline__ void p3_pool_task(const Params& P, LAS unsigned char* lds, int r, int gi) {
    const int tid = otid(), chunk = tid & 31, cb = tid >> 5; const int win = 2 << gi, hw = win >> 1;
    const int rlo = max(r - hw, 0), rhi = min(r - hw + win, 128);
    const bf16_t* U = (const bf16_t*)(P.ws + WS_UP) + gi * 256 + 8 * chunk; LAS float* vs = (LAS float*)lds;
    __syncthreads();
    float own[4][8];
#pragma unroll
    for (int i = 0; i < 4; ++i) { const int c = cb + 16 * i; float a[8];
#pragma unroll
        for (int e = 0; e < 8; ++e) a[e] = 0.f;
        for (int rr = rlo; rr < rhi; ++rr) { const u32x4 w = *(const u32x4*)(U + (size_t)(rr * 64 + c) * 1024);
            const float x[8] = {bflo(w.x), bfhi(w.x), bflo(w.y), bfhi(w.y), bflo(w.z), bfhi(w.z), bflo(w.w), bfhi(w.w)};
#pragma unroll
            for (int e = 0; e < 8; ++e) a[e] += x[e];
            if (rr == r) {
#pragma unroll
                for (int e = 0; e < 8; ++e) own[i][e] = x[e]; } }
        *(LAS f32x4*)(vs + c * 256 + 8 * chunk) = (f32x4){a[0], a[1], a[2], a[3]}; *(LAS f32x4*)(vs + c * 256 + 8 * chunk + 4) = (f32x4){a[4], a[5], a[6], a[7]}; }
    __syncthreads();
    bf16_t* Dp = (bf16_t*)(P.ws + WS_A2) + gi * 256 + 8 * chunk;
#pragma unroll
    for (int i = 0; i < 4; ++i) { const int c = cb + 16 * i; const int clo = max(c - hw, 0), chi = min(c - hw + win, 64);
        f32x4 s0 = {0.f, 0.f, 0.f, 0.f}, s1 = s0;
        for (int cc = clo; cc < chi; ++cc) { s0 += *(const LAS f32x4*)(vs + cc * 256 + 8 * chunk); s1 += *(const LAS f32x4*)(vs + cc * 256 + 8 * chunk + 4); }
        const float inv = 1.0f / (float)((rhi - rlo) * (chi - clo));
        u32x4 w; w.x = cvtpk(s0[0] * inv - own[i][0], s0[1] * inv - own[i][1]); w.y = cvtpk(s0[2] * inv - own[i][2], s0[3] * inv - own[i][3]);
        w.z = cvtpk(s1[0] * inv - own[i][4], s1[1] * inv - own[i][5]); w.w = cvtpk(s1[2] * inv - own[i][6], s1[3] * inv - own[i][7]);
        *(u32x4*)(Dp + (size_t)(r * 64 + c) * 2048) = w; }
}
__device__ __forceinline__ void p3_all(const Params& P, LAS unsigned char* lds) {
    for (int t = blockIdx.x; t < 2080; t += gridDim.x) {
        if (t < 512) p3_qk_task(P, 0, t >> 2, t & 3);
        else if (t < 1040) p3_qk_task(P, 1, (t - 512) >> 2, (t - 512) & 3);
        else if (t < 1568) p3_v_task(P, lds, (t - 1040) >> 2, (t - 1040) & 3);
        else p3_pool_task(P, lds, (t - 1568) >> 2, (t - 1568) & 3);
    }
}
__device__ __forceinline__ int step_chunk(int d, int j) { return d == 0 ? (j < 4 ? 128 + j : j - 4) : (j < 4 ? 131 - j : 131 - j); }
__device__ __forceinline__ void p4_state(const Params& P, LAS unsigned char* lds, int sb, bool dry = false) {
    const int tid = otid(), lane = tid & 63, wave = __builtin_amdgcn_readfirstlane(tid >> 6);
    const int hd = sb & 7, h = hd >> 1, d = hd & 1, lb = sb >> 3;
    LAS float* tg = (LAS float*)(lds + 81920); LAS float* te = tg + 132; LAS float* tm = te + 132; LAS float* tdec = tm + 132; LAS float* tsf = tdec + 132;
    const float* gc = (const float*)(P.ws + WS_GC);
    if (tid < 132) { const int ci = step_chunk(d, tid); tg[tid] = gc[(d * 4 + h) * 132 + ci]; te[tid] = gc[2048 + (d * 4 + h) * 132 + ci]; }
    __syncthreads();
    if (tid == 0) { float m = 0.f;
#pragma unroll 4
        for (int j = 0; j < 132; ++j) { tm[j] = m; m = tg[j] + fmaxf(m, te[j]); } }
    __syncthreads();
    if (tid < 132) { const float m = tm[tid], em = te[tid], Mf = fmaxf(m, em); tdec[tid] = __expf(m - Mf); tsf[tid] = __expf(em - Mf);
        if (lb == 0 && !dry) ((float*)(P.ws + WS_GC))[4096 + (d * 4 + h) * 132 + step_chunk(d, tid)] = m; }
    __syncthreads();
    const int task = lb + 32 * wave; if (wave >= 3 || task >= 72) return;
    const int kq = task / 9, vq = task - 9 * kq; const bool two = vq < 8; const int vt0 = two ? 2 * vq : 16;
    const int fr = lane & 15, fq = lane >> 4;
    const bf16_t* KT = (const bf16_t*)(P.ws + WS_KT) + ((size_t)(h * 132) * 256 + kq * 32) * 64 + lane * 8;
    const bf16_t* VS = (const bf16_t*)(P.ws + (d == 0 ? WS_VSF : WS_VSB)) + ((size_t)(h * 132) * 272 + vt0 * 16) * 64 + lane * 8;
    const int vs1 = two ? 16 * 64 : 0;
    LAS unsigned char* wb = lds + wave * 9216;
    const int wofs = (lane >> 3) * 144 + 16 * (lane & 7), rofs = fr * 144 + 16 * fq;
    bf16_t* CST = (bf16_t*)(P.ws + WS_CST); float* NST = (float*)(P.ws + WS_NST);
    f32x4 C[2][2];
#pragma unroll
    for (int a = 0; a < 2; ++a)
#pragma unroll
        for (int b = 0; b < 2; ++b) C[a][b] = (f32x4){0.f, 0.f, 0.f, 0.f};
    u32x4 rg[4][8];
#define P4_LOAD(slot, jj) do { const size_t cj_ = (size_t)step_chunk(d, (jj)); const bf16_t* kp_ = KT + cj_ * (256 * 64); const bf16_t* vp_ = VS + cj_ * (272 * 64); \
        rg[slot][0] = *(const u32x4*)(kp_); rg[slot][1] = *(const u32x4*)(kp_ + 512); rg[slot][2] = *(const u32x4*)(kp_ + 1024); rg[slot][3] = *(const u32x4*)(kp_ + 1536); \
        rg[slot][4] = *(const u32x4*)(vp_); rg[slot][5] = *(const u32x4*)(vp_ + 512); rg[slot][6] = *(const u32x4*)(vp_ + vs1); rg[slot][7] = *(const u32x4*)(vp_ + vs1 + 512); } while (0)
    P4_LOAD(0, 0); P4_LOAD(1, 1); P4_LOAD(2, 2);
    for (int j0 = 0; j0 < 132; j0 += 4) {
#pragma unroll
        for (int u = 0; u < 4; ++u) { const int j = j0 + u;
            if (j + 3 < 132) P4_LOAD((u + 3) & 3, j + 3);
#pragma unroll
            for (int i = 0; i < 8; ++i) *(LAS u32x4*)(wb + (i >> 1) * 2304 + (i & 1) * 1152 + wofs) = rg[u][i];
            const int ci = step_chunk(d, j);
            if (ci < 128 && !dry) {
                const size_t rb = (((size_t)ci * 4 + h) * 2 + d) * 256;
                if (two) {
#pragma unroll
                    for (int a = 0; a < 2; ++a)
#pragma unroll
                        for (int b = 0; b < 2; ++b) { u32x2 w; w.x = cvtpk(C[a][b][0], C[a][b][1]); w.y = cvtpk(C[a][b][2], C[a][b][3]); *(u32x2*)(CST + (rb + (vt0 + b) * 16 + fr) * 256 + kq * 32 + 16 * a + 4 * fq) = w; }
                } else if (fr == 0) {
#pragma unroll
                    for (int a = 0; a < 2; ++a) *(f32x4*)(NST + rb + kq * 32 + 16 * a + 4 * fq) = C[a][0]; }
            }
            const float dec = tdec[j], sf = tsf[j];
            bf16x8 fa[2][2], fb[2][2];
#pragma unroll
            for (int t = 0; t < 2; ++t)
#pragma unroll
                for (int ks = 0; ks < 2; ++ks) { fa[t][ks] = *(const LAS bf16x8*)(wb + t * 2304 + rofs + 64 * ks); fb[t][ks] = *(const LAS bf16x8*)(wb + (2 + t) * 2304 + rofs + 64 * ks); }
#pragma unroll
            for (int a = 0; a < 2; ++a)
#pragma unroll
                for (int b = 0; b < 2; ++b) { f32x4 Dt = {0.f, 0.f, 0.f, 0.f};
#pragma unroll
                    for (int ks = 0; ks < 2; ++ks) Dt = __builtin_amdgcn_mfma_f32_16x16x32_bf16(fa[a][ks], fb[b][ks], Dt, 0, 0, 0);
                    C[a][b] = C[a][b] * dec + Dt * sf; }
        }
    }
#undef P4_LOAD
}
constexpr int O_QS = 0, O_KS = 33792, O_VT = 67584, O_WS = 106752, O_SC = 125184, O_DEN = 127232, O_RED = 127744, O_END = 131840;
__device__ __forceinline__ void p5_task(const Params& P, LAS unsigned char* lds, int c, int h) {
    const int tid = otid(), lane = tid & 63, wave = __builtin_amdgcn_readfirstlane(tid >> 6), fr = lane & 15, fq = lane >> 4;
    const int t0 = 64 * c;
    LAS float* Es = (LAS float*)(lds + O_SC); LAS float* Ms = Es + 128; LAS float* Wi = Ms + 128; LAS float* Fl = Wi + 128; LAS float* dens = (LAS float*)(lds + O_DEN); LAS float* red = (LAS float*)(lds + O_RED);
    __syncthreads();
    { const bf16_t* Q = (const bf16_t*)(P.ws + WS_QC) + (size_t)t0 * 1024 + h * 256; const bf16_t* Kc = (const bf16_t*)(P.ws + WS_KC) + (size_t)t0 * 1024 + h * 256;
#pragma unroll
      for (int i = 0; i < 4; ++i) { const int idx = tid + 512 * i, r = idx >> 5, ch = idx & 31;
          const u32x4 qv = *(const u32x4*)(Q + (size_t)r * 1024 + 8 * ch), kv = *(const u32x4*)(Kc + (size_t)r * 1024 + 8 * ch);
          *(LAS u32x4*)(lds + O_QS + r * 528 + 16 * ch) = qv; *(LAS u32x4*)(lds + O_KS + r * 528 + 16 * ch) = kv; }
      const bf16_t* VT = (const bf16_t*)(P.ws + WS_VT) + (size_t)(h * 132 + c) * (272 * 64);
      for (int idx = tid; idx < 272 * 8; idx += 512) { const int r = idx >> 3, ch = idx & 7; *(LAS u32x4*)(lds + O_VT + r * 144 + 16 * ch) = *(const u32x4*)(VT + (size_t)r * 64 + 8 * ch); } }
    if (wave < 2) { const int d = wave; const size_t ix = (size_t)(d * 4 + h) * MTOT + t0 + lane;
        const float e = ((const float*)(P.ws + WS_E))[ix], b = ((const float*)(P.ws + WS_BC))[ix]; const float m = ((const float*)(P.ws + WS_GC))[4096 + (d * 4 + h) * 132 + c];
        float pm = e;
        if (d == 0) {
#pragma unroll
            for (int s = 1; s < 64; s <<= 1) { const float t = __shfl_up(pm, s); if (lane >= s) pm = fmaxf(pm, t); }
        } else {
#pragma unroll
            for (int s = 1; s < 64; s <<= 1) { const float t = __shfl_down(pm, s); if (lane + s < 64) pm = fmaxf(pm, t); }
        }
        const float Mt = fmaxf(m, pm);
        Es[d * 64 + lane] = e; Ms[d * 64 + lane] = Mt; Wi[d * 64 + lane] = __expf(m - Mt); Fl[d * 64 + lane] = __expf(-(b + Mt)); }
    __syncthreads();
    { const int st = wave >> 1, tt0 = 2 * (wave & 1); f32x4 S0 = {0.f, 0.f, 0.f, 0.f}, S1 = S0;
#pragma unroll
      for (int ks = 0; ks < 8; ++ks) { const bf16x8 ak = *(const LAS bf16x8*)(lds + O_KS + (16 * st + fr) * 528 + 64 * ks + 16 * fq);
          const bf16x8 bq0 = *(const LAS bf16x8*)(lds + O_QS + (16 * tt0 + fr) * 528 + 64 * ks + 16 * fq), bq1 = *(const LAS bf16x8*)(lds + O_QS + (16 * tt0 + 16 + fr) * 528 + 64 * ks + 16 * fq);
          S0 = __builtin_amdgcn_mfma_f32_16x16x32_bf16(ak, bq0, S0, 0, 0, 0); S1 = __builtin_amdgcn_mfma_f32_16x16x32_bf16(ak, bq1, S1, 0, 0, 0); }
      const int s0 = 16 * st + 4 * fq;
#pragma unroll
      for (int d = 0; d < 2; ++d) { const f32x4 ev = *(const LAS f32x4*)(Es + d * 64 + s0);
#pragma unroll
          for (int q = 0; q < 2; ++q) { const int t = 16 * (tt0 + q) + fr; const float Mt = Ms[d * 64 + t]; const f32x4 S = q == 0 ? S0 : S1; float w[4];
#pragma unroll
              for (int i = 0; i < 4; ++i) { const int s = s0 + i; const bool on = d == 0 ? (s <= t) : (s >= t); w[i] = on ? __expf(ev[i] - Mt) * S[i] : 0.f; }
              u32x2 pk; pk.x = cvtpk(w[0], w[1]); pk.y = cvtpk(w[2], w[3]); *(LAS u32x2*)(lds + O_WS + (d * 64 + t) * 144 + 2 * s0) = pk; } } }
    __syncthreads();
    f32x4 acc[2][2][4];
    const bf16_t* CST = (const bf16_t*)(P.ws + WS_CST);
#pragma unroll
    for (int d = 0; d < 2; ++d) {
        const bf16_t* Cp = CST + ((((size_t)c * 4 + h) * 2 + d) * 256 + 32 * wave + fr) * 256 + 8 * fq;
        bf16x8 ca[2][8];
#pragma unroll
        for (int v = 0; v < 2; ++v)
#pragma unroll
            for (int ks = 0; ks < 8; ++ks) ca[v][ks] = *(const bf16x8*)(Cp + (size_t)v * 16 * 256 + 32 * ks);
#pragma unroll
        for (int v = 0; v < 2; ++v)
#pragma unroll
            for (int tt = 0; tt < 4; ++tt) acc[d][v][tt] = (f32x4){0.f, 0.f, 0.f, 0.f};
#pragma unroll
        for (int ks = 0; ks < 8; ++ks) {
#pragma unroll
            for (int tt = 0; tt < 4; ++tt) { const bf16x8 bq = *(const LAS bf16x8*)(lds + O_QS + (16 * tt + fr) * 528 + 64 * ks + 16 * fq);
                acc[d][0][tt] = __builtin_amdgcn_mfma_f32_16x16x32_bf16(ca[0][ks], bq, acc[d][0][tt], 0, 0, 0); acc[d][1][tt] = __builtin_amdgcn_mfma_f32_16x16x32_bf16(ca[1][ks], bq, acc[d][1][tt], 0, 0, 0); } }
#pragma unroll
        for (int tt = 0; tt < 4; ++tt) { const float wi = Wi[d * 64 + 16 * tt + fr]; acc[d][0][tt] *= wi; acc[d][1][tt] *= wi; }
#pragma unroll
        for (int ks = 0; ks < 2; ++ks) { const bf16x8 va0 = *(const LAS bf16x8*)(lds + O_VT + (32 * wave + fr) * 144 + 64 * ks + 16 * fq), va1 = *(const LAS bf16x8*)(lds + O_VT + (32 * wave + 16 + fr) * 144 + 64 * ks + 16 * fq);
#pragma unroll
            for (int tt = 0; tt < 4; ++tt) { const bf16x8 bw = *(const LAS bf16x8*)(lds + O_WS + (d * 64 + 16 * tt + fr) * 144 + 64 * ks + 16 * fq);
                acc[d][0][tt] = __builtin_amdgcn_mfma_f32_16x16x32_bf16(va0, bw, acc[d][0][tt], 0, 0, 0); acc[d][1][tt] = __builtin_amdgcn_mfma_f32_16x16x32_bf16(va1, bw, acc[d][1][tt], 0, 0, 0); } }
    }
    { const int tt = wave & 3, d = wave >> 2; f32x4 dn = {0.f, 0.f, 0.f, 0.f};
      const float* np = (const float*)(P.ws + WS_NST) + (((size_t)c * 4 + h) * 2 + d) * 256 + 8 * fq;
#pragma unroll
      for (int ks = 0; ks < 8; ++ks) { bf16x8 an = {0, 0, 0, 0, 0, 0, 0, 0};
          if (fr == 0) { const f32x4 n0 = *(const f32x4*)(np + 32 * ks), n1 = *(const f32x4*)(np + 32 * ks + 4); u32x4 w; w.x = cvtpk(n0[0], n0[1]); w.y = cvtpk(n0[2], n0[3]); w.z = cvtpk(n1[0], n1[1]); w.w = cvtpk(n1[2], n1[3]); an = __builtin_bit_cast(bf16x8, w); }
          const bf16x8 bq = *(const LAS bf16x8*)(lds + O_QS + (16 * tt + fr) * 528 + 64 * ks + 16 * fq);
          dn = __builtin_amdgcn_mfma_f32_16x16x32_bf16(an, bq, dn, 0, 0, 0); }
      dn *= Wi[d * 64 + 16 * tt + fr];
#pragma unroll
      for (int ks = 0; ks < 2; ++ks) { const bf16x8 va = *(const LAS bf16x8*)(lds + O_VT + (256 + fr) * 144 + 64 * ks + 16 * fq); const bf16x8 bw = *(const LAS bf16x8*)(lds + O_WS + (d * 64 + 16 * tt + fr) * 144 + 64 * ks + 16 * fq);
          dn = __builtin_amdgcn_mfma_f32_16x16x32_bf16(va, bw, dn, 0, 0, 0); }
      if (fq == 0) dens[d * 64 + 16 * tt + fr] = dn[0]; }
    __syncthreads();
    float hv[2][4][4];
#pragma unroll
    for (int tt = 0; tt < 4; ++tt) { const int t = 16 * tt + fr; const float rf = 1.0f / fmaxf(fabsf(dens[t]), Fl[t]), rb = 1.0f / fmaxf(fabsf(dens[64 + t]), Fl[64 + t]);
        float s = 0.f, s2 = 0.f;
#pragma unroll
        for (int v = 0; v < 2; ++v)
#pragma unroll
            for (int i = 0; i < 4; ++i) { const float x = acc[0][v][tt][i] * rf + acc[1][v][tt][i] * rb; hv[v][tt][i] = x; s += x; s2 += x * x; }
        s += __shfl_xor(s, 16); s += __shfl_xor(s, 32); s2 += __shfl_xor(s2, 16); s2 += __shfl_xor(s2, 32);
        if (fq == 0) { red[(wave * 64 + t) * 2] = s; red[(wave * 64 + t) * 2 + 1] = s2; } }
    __syncthreads();
    { const float* hg = P.in[I_HNG] + h * 256; const bf16_t* UO = (const bf16_t*)(P.ws + WS_UO); bf16_t* A2 = (bf16_t*)(P.ws + WS_A2);
#pragma unroll
      for (int tt = 0; tt < 4; ++tt) { const int t = 16 * tt + fr; float s = 0.f, s2 = 0.f;
#pragma unroll
          for (int w = 0; w < 8; ++w) { s += red[(w * 64 + t) * 2]; s2 += red[(w * 64 + t) * 2 + 1]; }
          const float mu = s * (1.0f / 256.0f), var = fmaxf(s2 * (1.0f / 256.0f) - mu * mu, 0.f), rstd = 1.0f / sqrtf(var + EPSF);
#pragma unroll
          for (int v = 0; v < 2; ++v) { const int vf = 32 * wave + 16 * v + 4 * fq; const f32x4 g = *(const f32x4*)(hg + vf);
              const u32x2 ow = *(const u32x2*)(UO + (size_t)(t0 + t) * 1024 + h * 256 + vf); const float o[4] = {bflo(ow.x), bfhi(ow.x), bflo(ow.y), bfhi(ow.y)}; float r[4];
#pragma unroll
              for (int i = 0; i < 4; ++i) r[i] = (hv[v][tt][i] - mu) * rstd * g[i] * sigmoidf_(o[i]);
              u32x2 pk; pk.x = cvtpk(r[0], r[1]); pk.y = cvtpk(r[2], r[3]); *(u32x2*)(A2 + (size_t)(t0 + t) * 2048 + 1024 + h * 256 + vf) = pk; } } }
}
#define XB_TMO      128
#define XB_XCNT(j)  (256  + 64 * (j))
#define XB_XSUB(j)  (1280 + 64 * (j))
#define XB_XGEN(j)  (2304 + 64 * (j))
#define XB_TOP      3328
#define XB_TOPGEN   3392
#define XCD_BAR_WORDS 3456
#define XB_SPIN_CAP (1u << 18)
__device__ __forceinline__ unsigned xb_ld(unsigned* p)              { return __hip_atomic_load(p, __ATOMIC_RELAXED, __HIP_MEMORY_SCOPE_AGENT); }
__device__ __forceinline__ unsigned xb_add(unsigned* p, unsigned v) { return __hip_atomic_fetch_add(p, v, __ATOMIC_RELAXED, __HIP_MEMORY_SCOPE_AGENT); }
__device__ __forceinline__ unsigned xb_xcc_id() { return (unsigned)__builtin_amdgcn_s_getreg((3 << 11) | 20) & 0xFu; }
#define XB_SPIN(cond, bar) do { unsigned _sp = 0; while (cond) { __builtin_amdgcn_s_sleep(1); \
    if ((++_sp & 255u) == 0u) { if (xb_ld(&(bar)[XB_TMO])) break; if (_sp > XB_SPIN_CAP) { atomicAdd(&(bar)[XB_TMO], 1u); break; } } } } while (0)
struct XcdBarrier { unsigned* bar; unsigned x; volatile LAS unsigned* st; };
__device__ __forceinline__ XcdBarrier xcd_barrier_post(unsigned* bar, volatile LAS unsigned* st) {
    XcdBarrier b; b.bar = bar; b.x = xb_xcc_id(); b.st = st;
    if (threadIdx.x == 0) (void)xb_add(&bar[XB_XCNT(b.x)], 1u);
    return b;
}
__device__ __forceinline__ void xcd_barrier_complete(unsigned* bar, unsigned x, unsigned& nloc, unsigned& nx) {
    const unsigned G = gridDim.x * gridDim.y * gridDim.z;
    unsigned sum, cnt, mine, sp = 0u;
    for (;;) {
        sum = 0u; cnt = 0u; mine = 0u;
#pragma unroll
        for (unsigned j = 0; j < 16; ++j) { const unsigned c = xb_ld(&bar[XB_XCNT(j)]); sum += c; cnt += (c > 0u) ? 1u : 0u; mine = (j == x) ? c : mine; }
        if (sum == G) break;
        __builtin_amdgcn_s_sleep(1);
        if ((++sp & 255u) == 0u) { if (xb_ld(&bar[XB_TMO])) break; if (sp > XB_SPIN_CAP) { atomicAdd(&bar[XB_TMO], 1u); break; } }
    }
    nloc = mine > 0u ? mine : 1u; nx = cnt > 0u ? cnt : 1u;
}
__device__ __forceinline__ void xcd_barrier(const XcdBarrier& b) {
    asm volatile("s_waitcnt vmcnt(0)" ::: "memory");
    __syncthreads();
    if (threadIdx.x == 0) {
        unsigned* bar = b.bar;
        __builtin_amdgcn_s_waitcnt(0);
        unsigned nloc = b.st[0], nx = b.st[1];
        if (nloc == 0u) { xcd_barrier_complete(bar, b.x, nloc, nx); b.st[0] = nloc; b.st[1] = nx; }
        const unsigned old = xb_add(&bar[XB_XSUB(b.x)], 1u);
        const unsigned gen = old / nloc;
        if (old + 1u == (gen + 1u) * nloc) {
            __builtin_amdgcn_fence(__ATOMIC_RELEASE, "agent");
            asm volatile("s_waitcnt vmcnt(0)" ::: "memory");
            const unsigned og = xb_add(&bar[XB_TOP], 1u);
            const unsigned tg = og / nx;
            if (og + 1u == (tg + 1u) * nx) xb_add(&bar[XB_TOPGEN], 1u);
            else XB_SPIN(xb_ld(&bar[XB_TOPGEN]) == tg, bar);
            __builtin_amdgcn_fence(__ATOMIC_ACQUIRE, "agent");
            xb_add(&bar[XB_XGEN(b.x)], 1u);
            asm volatile("s_waitcnt vmcnt(0)" ::: "memory");
        } else {
            XB_SPIN(xb_ld(&bar[XB_XGEN(b.x)]) == gen, bar);
            __builtin_amdgcn_fence(__ATOMIC_ACQUIRE, "agent");
            asm volatile("s_waitcnt vmcnt(0)" ::: "memory");
        }
    }
    __syncthreads();
}
__device__ __forceinline__ void p7a_route(const Params& P, LAS unsigned char* lds, bool dry = false) {
    const int tid = otid(), lane = tid & 63, wave = __builtin_amdgcn_readfirstlane(tid >> 6), fr = lane & 15, fq = lane >> 4;
    const float* sumsq = (const float*)(P.ws + WS_SUMSQ); const float* BRP = (const float*)(P.ws + WS_WRP + 448 * 1024);
    int* cnt = (int*)(P.ws + WS_CTL) + (dry ? 2048 : 1024); const size_t ro = dry ? 262144 : 0; int* eid = (int*)(P.ws + WS_ROUTE + ro); float* wtok = (float*)(P.ws + WS_ROUTE + ro + 65536); int* spos = (int*)(P.ws + WS_ROUTE + ro + 131072);
    LAS float* part = (LAS float*)lds; LAS float* lgs = part + 8 * 32 * 48;
    for (int rb = blockIdx.x; rb < SEQ / 32; rb += gridDim.x) {
        const int row0 = 32 * rb;
        f32x4 acc[2][3];
#pragma unroll
        for (int a = 0; a < 2; ++a)
#pragma unroll
            for (int c = 0; c < 3; ++c) acc[a][c] = (f32x4){0.f, 0.f, 0.f, 0.f};
        const float* hb = P.out + (size_t)(row0 + fr) * D + 256 * wave + 4 * fq;
        const f32x4* wp = (const f32x4*)(P.ws + WS_WRP) + (size_t)(64 * wave + fq) * 48 + fr;
#pragma unroll 4
        for (int j = 0; j < 16; ++j) { const f32x4 a0 = *(const f32x4*)(hb + 16 * j), a1 = *(const f32x4*)(hb + (size_t)16 * D + 16 * j);
            f32x4 b[3];
#pragma unroll
            for (int c = 0; c < 3; ++c) b[c] = wp[(size_t)(4 * j) * 48 + 16 * c];
#pragma unroll
            for (int i = 0; i < 4; ++i)
#pragma unroll
                for (int c = 0; c < 3; ++c) { acc[0][c] = __builtin_amdgcn_mfma_f32_16x16x4f32(a0[i], b[c][i], acc[0][c], 0, 0, 0); acc[1][c] = __builtin_amdgcn_mfma_f32_16x16x4f32(a1[i], b[c][i], acc[1][c], 0, 0, 0); } }
        __syncthreads();
#pragma unroll
        for (int a = 0; a < 2; ++a)
#pragma unroll
            for (int c = 0; c < 3; ++c)
#pragma unroll
                for (int i = 0; i < 4; ++i) part[(wave * 32 + 16 * a + 4 * fq + i) * 48 + 16 * c + fr] = acc[a][c][i];
        __syncthreads();
        { const int row = tid >> 4, pc = tid & 15;
#pragma unroll
          for (int c = 0; c < 3; ++c) { float s = 0.f;
#pragma unroll
              for (int w = 0; w < 8; ++w) s += part[(w * 32 + row) * 48 + 16 * c + pc];
              lgs[row * 48 + 16 * c + pc] = s; } }
        __syncthreads();
        if (tid < 32) { const int r = row0 + tid; float ss = 0.f;
#pragma unroll
            for (int q = 0; q < 8; ++q) { const f32x4 v = *(const f32x4*)(sumsq + (size_t)r * 32 + 4 * q); ss += (v[0] + v[1]) + (v[2] + v[3]); }
            const float rstd = 1.0f / sqrtf(ss * (1.0f / D) + EPSF);
            float lg[4];
#pragma unroll
            for (int i = 0; i < 4; ++i) lg[i] = lgs[tid * 48 + 32 + i] * rstd + BRP[32 + i];
            int gs = 0; float gm = lg[0];
#pragma unroll
            for (int i = 1; i < 4; ++i) if (lg[i] > gm) { gm = lg[i]; gs = i; }
            float gsum = 0.f;
#pragma unroll
            for (int i = 0; i < 4; ++i) gsum += __expf(lg[i] - gm);
            const float pg = 1.0f / gsum;
            float sl[8];
#pragma unroll
            for (int i = 0; i < 8; ++i) sl[i] = lgs[tid * 48 + gs * 8 + i] * rstd + BRP[gs * 8 + i];
            int i1 = 0; float m1 = sl[0];
#pragma unroll
            for (int i = 1; i < 8; ++i) if (sl[i] > m1) { m1 = sl[i]; i1 = i; }
            int i2 = i1 == 0 ? 1 : 0; float m2 = sl[i2];
#pragma unroll
            for (int i = 0; i < 8; ++i) if (i != i1 && sl[i] > m2) { m2 = sl[i]; i2 = i; }
            const float p2 = __expf(m2 - m1); const float w1 = pg / (1.0f + p2), w2 = pg * p2 / (1.0f + p2);
            const int e1 = gs * 8 + i1, e2 = gs * 8 + i2;
            const int s1 = atomicAdd(cnt + e1, 1), s2 = atomicAdd(cnt + e2, 1);
            eid[2 * r] = e1; eid[2 * r + 1] = e2; wtok[2 * r] = w1; wtok[2 * r + 1] = w2; spos[2 * r] = s1; spos[2 * r + 1] = s2; }
    }
}
__device__ __forceinline__ void moe_tables(const Params& P, LAS int* tab) {
    __syncthreads();
    if (threadIdx.x == 0) { const int* cnt = (const int*)(P.ws + WS_CTL) + 1024; int tt = 0;
        for (int e = 0; e < NEXP; ++e) { const int c = __hip_atomic_load(cnt + e, __ATOMIC_RELAXED, __HIP_MEMORY_SCOPE_AGENT); const int nt = (c + 255) >> 8; tab[128 + e] = tt; for (int i = 0; i < nt; ++i) tab[1 + tt + i] = e; tt += nt; }
        tab[0] = tt; }
    __syncthreads();
}
__device__ __forceinline__ void p7b_scatter(const Params& P, const LAS int* tab) {
    const int tid = otid(), lane = tid & 63, wave = tid >> 6; const int gw = blockIdx.x * 8 + wave, NGW = gridDim.x * 8;
    const float* mod = (const float*)(P.ws + WS_MOD); const float* g = P.in[I_N2G]; const float* sumsq = (const float*)(P.ws + WS_SUMSQ);
    const int* eid = (const int*)(P.ws + WS_ROUTE); const int* spos = (const int*)(P.ws + WS_ROUTE + 131072); bf16_t* FNS = (bf16_t*)(P.ws + WS_FNS);
    for (int r = gw; r < SEQ; r += NGW) {
        float ss = lane < 32 ? sumsq[(size_t)r * 32 + lane] : 0.f; ss = wave_sum(ss);
        const float rstd = 1.0f / sqrtf(ss * (1.0f / D) + EPSF);
        const int e1 = eid[2 * r], e2 = eid[2 * r + 1]; const size_t sl1 = (size_t)tab[128 + e1] * 256 + spos[2 * r], sl2 = (size_t)tab[128 + e2] * 256 + spos[2 * r + 1];
        const f32x4* hr = (const f32x4*)(P.out + (size_t)r * D) + lane; u32x2* o1 = (u32x2*)(FNS + sl1 * D) + lane; u32x2* o2 = (u32x2*)(FNS + sl2 * D) + lane;
#pragma unroll
        for (int j = 0; j < 8; ++j) { const int d0 = 4 * lane + 256 * j; const f32x4 hv = hr[64 * j]; const f32x4 gg = *(const f32x4*)(g + d0), sc = *(const f32x4*)(mod + 8192 + d0), sh = *(const f32x4*)(mod + 6144 + d0);
            const f32x4 y = hv * rstd * gg * (sc + 1.0f) + sh; u32x2 w; w.x = cvtpk(y[0], y[1]); w.y = cvtpk(y[2], y[3]); o1[64 * j] = w; o2[64 * j] = w; }
    }
}
__device__ __forceinline__ void p10_final(const Params& P, const LAS int* tab, bool dry = false) {
    const int tid = otid(), lane = tid & 63, wave = tid >> 6; const int gw = blockIdx.x * 8 + wave, NGW = gridDim.x * 8;
    const float* mod = (const float*)(P.ws + WS_MOD); const float* fg = P.in[I_FG];
    const int* eid = (const int*)(P.ws + WS_ROUTE); const float* wtok = (const float*)(P.ws + WS_ROUTE + 65536); const int* spos = (const int*)(P.ws + WS_ROUTE + 131072); const bf16_t* Y = (const bf16_t*)(P.ws + WS_Y);
    for (int r = gw; r < SEQ; r += NGW) {
        const int e1 = eid[2 * r], e2 = eid[2 * r + 1]; const size_t sl1 = (size_t)tab[128 + e1] * 256 + spos[2 * r], sl2 = (size_t)tab[128 + e2] * 256 + spos[2 * r + 1];
        const float w1 = wtok[2 * r], w2 = wtok[2 * r + 1];
        f32x4* hr = (f32x4*)(P.out + (size_t)r * D) + lane; f32x4* wrp = dry ? (f32x4*)((float*)(P.ws + WS_FNS) + (size_t)r * D) + lane : hr; const u32x2* y1 = (const u32x2*)(Y + sl1 * D) + lane; const u32x2* y2 = (const u32x2*)(Y + sl2 * D) + lane;
        f32x4 v[8]; float ss = 0.f;
#pragma unroll
        for (int j = 0; j < 8; ++j) { const int d0 = 4 * lane + 256 * j; const f32x4 hv = hr[64 * j]; const f32x4 g2 = *(const f32x4*)(mod + 10240 + d0); const u32x2 a = y1[64 * j], b = y2[64 * j];
            const f32x4 ya = {bflo(a.x), bfhi(a.x), bflo(a.y), bfhi(a.y)}, yb = {bflo(b.x), bfhi(b.x), bflo(b.y), bfhi(b.y)};
            v[j] = hv + g2 * (ya * w1 + yb * w2); ss += (v[j][0] * v[j][0] + v[j][1] * v[j][1]) + (v[j][2] * v[j][2] + v[j][3] * v[j][3]); }
        const float rstd = 1.0f / sqrtf(wave_sum(ss) * (1.0f / D) + EPSF);
#pragma unroll
        for (int j = 0; j < 8; ++j) { const int d0 = 4 * lane + 256 * j; wrp[64 * j] = v[j] * rstd * *(const f32x4*)(fg + d0); }
    }
}
__device__ __forceinline__ void p10_plain(const Params& P, const float* src) {
    const int tid = otid(), lane = tid & 63, wave = tid >> 6; const int gw = blockIdx.x * 8 + wave, NGW = gridDim.x * 8; const float* fg = P.in[I_FG];
    for (int r = gw; r < SEQ; r += NGW) { const f32x4* sr = (const f32x4*)(src + (size_t)r * D) + lane; f32x4* hr = (f32x4*)(P.out + (size_t)r * D) + lane; f32x4 v[8]; float ss = 0.f;
#pragma unroll
        for (int j = 0; j < 8; ++j) { v[j] = sr[64 * j]; ss += (v[j][0] * v[j][0] + v[j][1] * v[j][1]) + (v[j][2] * v[j][2] + v[j][3] * v[j][3]); }
        const float rstd = 1.0f / sqrtf(wave_sum(ss) * (1.0f / D) + EPSF);
#pragma unroll
        for (int j = 0; j < 8; ++j) hr[64 * j] = v[j] * rstd * *(const f32x4*)(fg + 4 * lane + 256 * j); }
}
#ifndef STAGE
#define STAGE 4
#endif
#ifndef N_LAUNCHES
#define N_LAUNCHES 1
#endif
constexpr int NPHASE = 12;
__global__ void __launch_bounds__(512, 2) mk_fwd(Params P) {
    extern __shared__ __attribute__((aligned(16))) unsigned char lds_raw[];
    LAS unsigned char* lds = (LAS unsigned char*)lds_raw;
    LAS int* tab = (LAS int*)(lds + LDSCTL_OFF + 4096);
    const int lo = P.ph_lo, hi = P.ph_hi; const int G = gridDim.x, bx = blockIdx.x;
#ifndef ONLYP
#define ONLYP -1
#endif
#define IN(k) ((ONLYP < 0 || ONLYP == (k)) && lo <= (k) && (k) < hi)
#ifndef P4SEL
#define P4SEL 0
#endif
#ifndef REP_PHASE
#define REP_PHASE -1
#endif
#define NREP(k) ((k) == REP_PHASE ? 2 : 1)
    { volatile LAS unsigned* st = (volatile LAS unsigned*)(lds + LDS_BYTES - 64); if (threadIdx.x < 2) st[threadIdx.x] = 0u; __syncthreads(); }
    XcdBarrier xbar = xcd_barrier_post((unsigned*)(P.ws + WS_CTL) + 4096, (volatile LAS unsigned*)(lds + LDS_BYTES - 64));
#if N_LAUNCHES == 2
#define SEAM(k) do { if ((k) + 1 < hi) { xcd_barrier(xbar); } } while (0)
#else
#define SEAM(k) do { if ((k) + 1 < hi) { cg::this_grid().sync(); } } while (0)
#endif
    if (IN(0)) { for (int rep_ = 0; rep_ < NREP(0); ++rep_) { if (rep_) xcd_barrier(xbar);
#if STAGE >= 2
        p0_adaln(P, lds); p0_transposes(P, lds, 0, STAGE >= 4 ? TR_ITEMS_ALL : TR_ITEMS_EARLY); p0_zero_pad(P); p0_wpool_scaled(P);
#endif
        } SEAM(0); }
    if (IN(1)) { for (int rep_ = 0; rep_ < NREP(1); ++rep_) { if (rep_) xcd_barrier(xbar);
#if STAGE >= 2
        p1_router_prep(P);
        if (bx < G - 32) p1_xn(P, G - 32);
        else { pg8::Gemm g{(const bf16_t*)(P.ws + WS_WOUTT), (const bf16_t*)(P.ws + WS_WPOOLS), 2048, 256, 256}; SchedWeff S{32, bx - (G - 32)}; EpiWeff E{(bf16_t*)(P.ws + WS_WOUTT)};
            pg8::gemm_phase<EpiWeff, SchedWeff>(lds, g, S, E); }
#endif
        } SEAM(1); }
    if (IN(2)) { for (int rep_ = 0; rep_ < NREP(2); ++rep_) { if (rep_) xcd_barrier(xbar);
#if STAGE >= 2
        pg8::Gemm g{(const bf16_t*)(P.ws + WS_XN), (const bf16_t*)(P.ws + WS_WINT), 2048, 2048, 2048}; SchedG1 S{G, bx}; EpiG1 E{P.ws, P.in[I_GB]};
        pg8::gemm_phase<EpiG1, SchedG1>(lds, g, S, E);
#endif
        } SEAM(2); }
    if (IN(3)) { for (int rep_ = 0; rep_ < NREP(3); ++rep_) { if (rep_) xcd_barrier(xbar);
#if STAGE >= 2
        p3_all(P, lds);
#endif
        } SEAM(3); }
    if (IN(4)) { for (int rep_ = 0; rep_ < NREP(4); ++rep_) { if (rep_) xcd_barrier(xbar);
#if STAGE >= 2
        if (STAGE >= 3) { p4_state(P, lds, bx, rep_ > 0); }
#endif
        } SEAM(4); }
    if (IN(5)) { for (int rep_ = 0; rep_ < NREP(5); ++rep_) { if (rep_) xcd_barrier(xbar);
#if STAGE >= 3
        for (int t = bx; t < 512; t += G) p5_task(P, lds, t >> 2, t & 3);
#elif STAGE == 2
        { bf16_t* A2 = (bf16_t*)(P.ws + WS_A2); for (int i = bx * 512 + threadIdx.x; i < SEQ * 128; i += G * 512) { const int r = i >> 7, c8 = i & 127; *(u32x4*)(A2 + (size_t)r * 2048 + 1024 + 8 * c8) = (u32x4){0u, 0u, 0u, 0u}; } }
#endif
        } SEAM(5); }
    if (IN(6)) { for (int rep_ = 0; rep_ < NREP(6); ++rep_) { if (rep_) xcd_barrier(xbar);
#if STAGE >= 2
        pg8::Gemm g{(const bf16_t*)(P.ws + WS_A2), (const bf16_t*)(P.ws + WS_WOUTT), 2048, 2048, 2048}; SchedG2 S{G, bx};
        EpiG2 E{P.in[I_X], (const float*)(P.ws + WS_MOD) + 4096, P.out, (float*)(P.ws + WS_SUMSQ)};
        pg8::gemm_phase<EpiG2, SchedG2>(lds, g, S, E);
#endif
        } SEAM(6); }
    if (IN(7)) { for (int rep_ = 0; rep_ < NREP(7); ++rep_) { if (rep_) xcd_barrier(xbar);
#if STAGE >= 4
        p7a_route(P, lds, rep_ == 0 && NREP(7) == 2);
#endif
        } SEAM(7); }
    if (IN(8)) { for (int rep_ = 0; rep_ < NREP(8); ++rep_) { if (rep_) xcd_barrier(xbar);
#if STAGE >= 4
        moe_tables(P, tab); p7b_scatter(P, tab);
#endif
        } SEAM(8); }
    if (IN(9)) { for (int rep_ = 0; rep_ < NREP(9); ++rep_) { if (rep_) xcd_barrier(xbar);
#if STAGE >= 4
        if (lo == 9) moe_tables(P, tab);
        pg8::Gemm g{(const bf16_t*)(P.ws + WS_FNS), (const bf16_t*)(P.ws + WS_W13T), 2048, 2048, 2048}; SchedMoE S{G, bx, 4, 4, tab}; EpiUp E{(bf16_t*)(P.ws + WS_H)};
        pg8::gemm_phase<EpiUp, SchedMoE>(lds, g, S, E);
#endif
        } SEAM(9); }
    if (IN(10)) { for (int rep_ = 0; rep_ < NREP(10); ++rep_) { if (rep_) xcd_barrier(xbar);
#if STAGE >= 4
        if (lo == 10) moe_tables(P, tab);
        pg8::Gemm g{(const bf16_t*)(P.ws + WS_H), (const bf16_t*)(P.ws + WS_W2T), 512, 512, 512}; SchedMoE S{G, bx, 8, 8, tab}; EpiDown E{(bf16_t*)(P.ws + WS_Y)};
        pg8::gemm_phase<EpiDown, SchedMoE>(lds, g, S, E);
#endif
        } SEAM(10); }
    if (IN(11)) { for (int rep_ = 0; rep_ < NREP(11); ++rep_) { if (rep_) xcd_barrier(xbar);
#if STAGE >= 4
        if (lo == 11) moe_tables(P, tab);
        p10_final(P, tab, rep_ == 0 && NREP(11) == 2);
#elif STAGE >= 2
        p10_plain(P, P.out);
#else
        p10_plain(P, P.in[I_X]);
#endif
    } }
#undef IN
#undef SEAM
}

extern "C" void kernel_launch(void* const* d_in, const int* in_sizes, int n_in, void* d_out, int out_size, void* d_ws, size_t ws_size, hipStream_t stream) {
    static int grid = 0;
    if (grid == 0) {
        if (n_in != 24 || out_size != SEQ * D || ws_size < WS_END) { fprintf(stderr, "kernel_launch: unexpected shapes (n_in %d, out %d, ws %zu < %zu)\n", n_in, out_size, ws_size, (size_t)WS_END); grid = -1; return; }
        int dev = 0, cus = 0, per_cu = 0;
        if (hipGetDevice(&dev) != hipSuccess || hipDeviceGetAttribute(&cus, hipDeviceAttributeMultiprocessorCount, dev) != hipSuccess) { grid = -1; return; }
        if (hipFuncSetAttribute((const void*)mk_fwd, hipFuncAttributeMaxDynamicSharedMemorySize, LDS_BYTES) != hipSuccess) { fprintf(stderr, "kernel_launch: hipFuncSetAttribute failed\n"); grid = -1; return; }
        if (hipOccupancyMaxActiveBlocksPerMultiprocessor(&per_cu, (const void*)mk_fwd, 512, LDS_BYTES) != hipSuccess || per_cu < 1) { fprintf(stderr, "kernel_launch: occupancy query says %d\n", per_cu); per_cu = 1; }
        (void)hipGetLastError();
        grid = cus;
        if (grid < 160) { fprintf(stderr, "kernel_launch: %d CUs is too few for this kernel's phase split\n", grid); grid = -1; return; }
    }
    if (grid < 0) return;
    (void)hipMemsetAsync((char*)d_ws + WS_CTL, 0, 1 * MiB, stream);
    Params p{};
    for (int i = 0; i < 24; ++i) p.in[i] = (const float*)d_in[i];
    p.out = (float*)d_out; p.ws = (unsigned char*)d_ws;
#if N_LAUNCHES == 2
    p.ph_lo = 0; p.ph_hi = NPHASE;
    hipLaunchKernelGGL(mk_fwd, dim3(grid), dim3(512), LDS_BYTES, stream, p);
#elif N_LAUNCHES == 1
    p.ph_lo = 0; p.ph_hi = NPHASE;
    void* args[] = {&p};
    hipError_t e = hipLaunchCooperativeKernel((const void*)mk_fwd, dim3(grid), dim3(512), args, LDS_BYTES, stream);
    if (e != hipSuccess) fprintf(stderr, "cooperative launch failed: %s (grid %d)\n", hipGetErrorString(e), grid);
#else
    for (int k = 0; k < NPHASE; ++k) { p.ph_lo = k; p.ph_hi = k + 1; hipLaunchKernelGGL(mk_fwd, dim3(grid), dim3(512), LDS_BYTES, stream, p);
#ifdef REP_PHASE
        if (k == REP_PHASE) hipLaunchKernelGGL(mk_fwd, dim3(grid), dim3(512), LDS_BYTES, stream, p);
#endif
    }
#endif
}
```

```cpp
#define STAGE 4
#define N_LAUNCHES 2
#include <hip/hip_runtime.h>
#include <hip/hip_cooperative_groups.h>
#include <cstdio>
#include <cstdint>
namespace cg = cooperative_groups;

#define LAS __attribute__((address_space(3)))
#define GAS __attribute__((address_space(1)))
typedef unsigned short bf16_t;
typedef short bf16x8 __attribute__((ext_vector_type(8)));
typedef float f32x4 __attribute__((ext_vector_type(4)));
typedef float f32x2 __attribute__((ext_vector_type(2)));
typedef unsigned u32x4 __attribute__((ext_vector_type(4)));
typedef unsigned u32x2 __attribute__((ext_vector_type(2)));
typedef __bf16 bf16x2_t __attribute__((ext_vector_type(2)));

#ifndef PATPROBE
#define PATPROBE 0
#endif
constexpr int D = 2048, SEQ = 8192, CTXL = 256, MTOT = SEQ + CTXL;
constexpr int INC = 5136, NPAD = 5376;
constexpr int NCH = SEQ / 64, NCHT = MTOT / 64;
constexpr int NEXP = 32, DEXP = 512;
constexpr float EPSF = 1e-6f;

constexpr size_t MiB = 1u << 20;
constexpr size_t WS_CTL = 0;
constexpr size_t WS_MOD = 1 * MiB;
constexpr size_t WS_GATES = 2 * MiB;
constexpr size_t WS_E = 3 * MiB;
constexpr size_t WS_BC = 3 * MiB + 288 * 1024;
constexpr size_t WS_GC = 3 * MiB + 576 * 1024;
constexpr size_t WS_NST = 4 * MiB;
constexpr size_t WS_SUMSQ = 5 * MiB;
constexpr size_t WS_ROUTE = 6 * MiB;
constexpr size_t WS_WRP = 7 * MiB;
constexpr size_t WS_WPOOLS = 8 * MiB;
constexpr size_t WS_WOUTT = 9 * MiB;
constexpr size_t WS_WINT = 17 * MiB;
constexpr size_t WS_W13T = 38 * MiB;
constexpr size_t WS_W2T = 166 * MiB;
constexpr size_t WS_XN = 230 * MiB;
constexpr size_t WS_UP = 263 * MiB;
constexpr size_t WS_UQ = 279 * MiB;
constexpr size_t WS_A2 = 230 * MiB;
constexpr size_t WS_UO = 295 * MiB;
constexpr size_t WS_UK = 311 * MiB;
constexpr size_t WS_UV = 328 * MiB;
constexpr size_t WS_QC = 345 * MiB;
constexpr size_t WS_KC = 361 * MiB;
constexpr size_t WS_KT = 378 * MiB;
constexpr size_t WS_VT = 395 * MiB;
constexpr size_t WS_VSF = 413 * MiB;
constexpr size_t WS_VSB = 431 * MiB;
constexpr size_t WS_CST = 449 * MiB;
constexpr size_t WS_Y = 449 * MiB;
constexpr size_t WS_H = 545 * MiB;
constexpr size_t WS_FNS = 295 * MiB;
constexpr size_t WS_FN = 295 * MiB;
constexpr size_t WS_PTOK = 4 * MiB;
constexpr size_t WS_END = 577 * MiB;
constexpr int MAXSLOT = 24576;

constexpr int RING_BYTES = 131072;
constexpr int LDSCTL_OFF = RING_BYTES;
constexpr int LDS_BYTES = 147456;

__device__ __forceinline__ float bf2f(unsigned short b) { return __uint_as_float((unsigned)b << 16); }
__device__ __forceinline__ unsigned cvtpk(float lo, float hi) { f32x2 v = {lo, hi}; bf16x2_t b = __builtin_convertvector(v, bf16x2_t); return __builtin_bit_cast(unsigned, b); }
__device__ __forceinline__ float bflo(unsigned w) { return __uint_as_float(w << 16); }
__device__ __forceinline__ float bfhi(unsigned w) { return __uint_as_float(w & 0xffff0000u); }
__device__ __forceinline__ float siluf(float x) { return x / (1.0f + __expf(-x)); }
__device__ __forceinline__ float sigmoidf_(float x) { return 1.0f / (1.0f + __expf(-x)); }
__device__ __forceinline__ float logsigmoidf_(float x) { return fminf(x, 0.f) - log1pf(__expf(-fabsf(x))); }
__device__ __forceinline__ float wave_sum(float v) {
#pragma unroll
    for (int o = 1; o < 64; o <<= 1) v += __shfl_xor(v, o);
    return v;
}
__device__ __forceinline__ float wave_max(float v) {
#pragma unroll
    for (int o = 1; o < 64; o <<= 1) v = fmaxf(v, __shfl_xor(v, o));
    return v;
}
__device__ __forceinline__ int otid() { int t = threadIdx.x; asm volatile("" : "+v"(t)); return t; }
#define LDS_WAIT() asm volatile("s_waitcnt lgkmcnt(0)" ::: "memory")
#define VM_WAIT() asm volatile("s_waitcnt vmcnt(0)" ::: "memory")

struct Params { const float* in[24]; float* out; unsigned char* ws; int ph_lo, ph_hi; };
enum { I_X = 0, I_C, I_CTX, I_CCTX, I_WMOD, I_BMOD, I_N1G, I_WIN, I_WCQ, I_WCK, I_GB, I_HNG, I_WPOOL, I_PSC, I_WOUT, I_N2G, I_WGRP, I_BGRP, I_WRT, I_BRT, I_W1, I_W3, I_W2, I_FG };
namespace pg8 {
constexpr int BM = 256, BK = 64, HALF = 128, HTB = HALF * BK * 2, STAGE_BYTES = 8 * HTB, NXCD = 8, WGM = 8;
__host__ __device__ __forceinline__ int lds_byte(int r, int c) { const int st = (r >> 4) * 2 + (c >> 5), rr = r & 15, cc = c & 31, ob = rr * 64 + cc * 2; return st * 1024 + (ob ^ (((ob >> 9) & 1) << 5)); }
__host__ __device__ __forceinline__ void stage_rc(int b, int& R, int& C) { const int st = b / 1024, sb = b % 1024, swz = sb ^ (((sb >> 9) & 1) << 5); R = (st >> 1) * 16 + swz / 64; C = (st & 1) * 32 + (swz % 64) / 2; }
__host__ __device__ __forceinline__ int perm32(int rho) { const int n = rho >> 4, i = rho & 15; return 8 * (i >> 2) + 4 * n + (i & 3); }

struct Unit { int am, bn, acol, ex; };
struct Gemm { const bf16_t* A; const bf16_t* Bt; int lda, ldb, K; };

__device__ __forceinline__ void static_unit(int L, int nM, int nN, int& pm, int& pn) {
    const int nwg = nM * nN; int wgid = L; { const int q = nwg / NXCD, r = nwg % NXCD, xcd = wgid % NXCD, off = wgid / NXCD; wgid = (xcd < r ? xcd * (q + 1) : r * (q + 1) + (xcd - r) * q) + off; }
    const int nig = WGM * nN, gid = wgid / nig, fm = gid * WGM, gsz = (nM - fm) < WGM ? (nM - fm) : WGM;
    pm = fm + ((wgid % nig) % gsz); pn = (wgid % nig) / gsz;
}

template <class Epi, class Sched>
__device__ __forceinline__ void gemm_phase(LAS unsigned char* lds, const Gemm g, const Sched& S, const Epi& E) {
    const int tid = otid(), wid = __builtin_amdgcn_readfirstlane(tid >> 6), lane = tid & 63, wr = wid >> 2, wc = wid & 3, fr = lane & 15, fq = lane >> 4;
    const int K = g.K, nt = K / BK;
    unsigned voffA[2], voffB[2];
#pragma unroll
    for (int i = 0; i < 2; ++i) { int R, C; stage_rc(tid * 16 + i * 8192, R, C); const int Rb = Epi::PERM ? ((R & ~31) + perm32(R & 31)) : R;
        voffA[i] = (unsigned)(R * g.lda + C) * 2u; voffB[i] = (unsigned)(Rb * g.ldb + C) * 2u; }
    const size_t kstep = (size_t)(BK * 2);
    const size_t hstepA = (size_t)HALF * g.lda * 2, hstepB = (size_t)HALF * g.ldb * 2;
    const size_t tstepA = 2 * hstepA, tstepB = 2 * hstepB;
    const unsigned ldsw = (unsigned)wid * 1024u;
    const int aoff = lds_byte(wr * 64 + fr, fq * 8), boff = lds_byte(wc * 32 + fr, fq * 8);
#define PG8_SA(b, h) (((b) * 2 + (h)) * HTB)
#define PG8_SB(b, h) ((4 + (b) * 2 + (h)) * HTB)
#define PG8_STAGE(bufoff, gbase, voff) do { _Pragma("unroll") for (int _i = 0; _i < 2; ++_i) \
        __builtin_amdgcn_global_load_lds((const unsigned*)((const char*)(gbase) + (voff)[_i]), (LAS unsigned*)(lds + (bufoff) + ldsw + _i * 8192), 16, 0, 0); } while (0)
#define PG8_STAGE_A(bufoff, gbase, hh, vv) do { if constexpr (Sched::GATHER) { PG8_STAGE(bufoff, gbase, (vv)[hh]); } else { PG8_STAGE(bufoff, (gbase) + (hh) * hstepA, voffA); } } while (0)
#define PG8_LDA(dst, b, h) do { _Pragma("unroll") for (int m = 0; m < 4; ++m) _Pragma("unroll") for (int k = 0; k < 2; ++k) dst[m][k] = *(const LAS bf16x8*)(lds + PG8_SA(b, h) + aoff + m * 2048 + k * 1024); } while (0)
#define PG8_LDB(dst, b, h) do { _Pragma("unroll") for (int n = 0; n < 2; ++n) _Pragma("unroll") for (int k = 0; k < 2; ++k) dst[n][k] = *(const LAS bf16x8*)(lds + PG8_SB(b, h) + boff + n * 2048 + k * 1024); } while (0)
#define PG8_MMA(ai, bj, At, Bt) do { __builtin_amdgcn_s_setprio(1); _Pragma("unroll") for (int m = 0; m < 4; ++m) _Pragma("unroll") for (int n = 0; n < 2; ++n) _Pragma("unroll") for (int k = 0; k < 2; ++k) \
        acc[ai][bj][m][n] = __builtin_amdgcn_mfma_f32_16x16x32_bf16(Bt[n][k], At[m][k], acc[ai][bj][m][n], 0, 0, 0); __builtin_amdgcn_s_setprio(0); } while (0)
#define PG8_WAIT_V(n) asm volatile("s_waitcnt vmcnt(" #n ")" ::: "memory")
#define PG8_WAIT_L(n) asm volatile("s_waitcnt lgkmcnt(" #n ")" ::: "memory")
#define PG8_BAR __builtin_amdgcn_s_barrier()
#define PG8_SCHED __builtin_amdgcn_sched_barrier(0)
    Unit cur, nxt; int ui = 0;
    if (!S.next(0, cur)) return;
    unsigned vaC[2][2], vaN[2][2];
    int gR[2], gC[2];
#pragma unroll
    for (int i = 0; i < 2; ++i) stage_rc(tid * 16 + i * 8192, gR[i], gC[i]);
    if constexpr (Sched::GATHER) {
#pragma unroll
        for (int hh = 0; hh < 2; ++hh)
#pragma unroll
            for (int i = 0; i < 2; ++i) vaC[hh][i] = (unsigned)(S.arow(cur, hh * HALF + gR[i]) * g.lda + gC[i]) * 2u;
    }
    f32x4 acc[2][2][4][2];
#pragma unroll
    for (int a = 0; a < 2; ++a)
#pragma unroll
        for (int b = 0; b < 2; ++b)
#pragma unroll
            for (int m = 0; m < 4; ++m)
#pragma unroll
                for (int n = 0; n < 2; ++n) acc[a][b][m][n] = (f32x4){0.f, 0.f, 0.f, 0.f};
    bf16x8 At[4][2], B0[2][2], B1[2][2];
    const char* cA = Sched::GATHER ? (const char*)g.A : (const char*)g.A + (size_t)cur.am * tstepA + (size_t)cur.acol * 2; const char* cB = (const char*)g.Bt + (size_t)cur.bn * tstepB;
    PG8_STAGE(PG8_SB(0, 0), cB, voffB); PG8_STAGE(PG8_SB(0, 1), cB + hstepB, voffB); PG8_STAGE_A(PG8_SA(0, 0), cA, 0, vaC); PG8_STAGE_A(PG8_SA(0, 1), cA, 1, vaC);
    if (wr == 1) PG8_BAR;
    PG8_WAIT_V(2); PG8_BAR;
    PG8_STAGE(PG8_SB(1, 0), cB + kstep, voffB); PG8_STAGE_A(PG8_SA(1, 0), cA + kstep, 0, vaC); PG8_STAGE(PG8_SB(1, 1), cB + hstepB + kstep, voffB);
    PG8_WAIT_V(6); PG8_BAR;
    for (;;) {
        const bool has_next = S.next(ui + 1, nxt);
        if constexpr (Sched::GATHER) {
#pragma unroll
            for (int hh = 0; hh < 2; ++hh)
#pragma unroll
                for (int i = 0; i < 2; ++i) vaN[hh][i] = has_next ? (unsigned)(S.arow(nxt, hh * HALF + gR[i]) * g.lda + gC[i]) * 2u : vaC[hh][i];
        }
        const char* nA = Sched::GATHER ? cA : (has_next ? (const char*)g.A + (size_t)nxt.am * tstepA + (size_t)nxt.acol * 2 : cA); const char* nB = has_next ? (const char*)g.Bt + (size_t)nxt.bn * tstepB : cB;
#pragma unroll 1
        for (int t = 0; t < nt; t += 2) {
            const bool last = (t == nt - 2);
            const char* a1 = cA + (size_t)(t + 1) * kstep;
            const char* a2 = last ? nA : cA + (size_t)(t + 2) * kstep; const char* b2 = last ? nB : cB + (size_t)(t + 2) * kstep;
            const char* a3 = a2 + kstep; const char* b3 = b2 + kstep;
            PG8_LDB(B0, 0, 0); PG8_LDB(B1, 0, 1); PG8_SCHED; PG8_LDA(At, 0, 0); PG8_STAGE_A(PG8_SA(1, 1), a1, 1, vaC);
            PG8_WAIT_V(8); PG8_WAIT_L(0); PG8_BAR; PG8_MMA(0, 0, At, B0); PG8_MMA(0, 1, At, B1); PG8_BAR; PG8_SCHED;
            PG8_LDA(At, 0, 1); PG8_STAGE(PG8_SB(0, 0), b2, voffB); PG8_STAGE(PG8_SB(0, 1), b2 + hstepB, voffB); if (last) { PG8_STAGE_A(PG8_SA(0, 0), a2, 0, vaN); } else { PG8_STAGE_A(PG8_SA(0, 0), a2, 0, vaC); }
            PG8_WAIT_V(8); PG8_WAIT_L(0); PG8_BAR; PG8_MMA(1, 0, At, B0); PG8_MMA(1, 1, At, B1); PG8_BAR; PG8_SCHED;
            PG8_LDB(B0, 1, 0); PG8_LDB(B1, 1, 1); PG8_SCHED; PG8_LDA(At, 1, 0); if (last) { PG8_STAGE_A(PG8_SA(0, 1), a2, 1, vaN); } else { PG8_STAGE_A(PG8_SA(0, 1), a2, 1, vaC); }
            PG8_WAIT_V(8); PG8_WAIT_L(0); PG8_BAR; PG8_MMA(0, 0, At, B0); PG8_MMA(0, 1, At, B1); PG8_BAR; PG8_SCHED;
            PG8_LDA(At, 1, 1); PG8_STAGE(PG8_SB(1, 0), b3, voffB); PG8_STAGE(PG8_SB(1, 1), b3 + hstepB, voffB); if (last) { PG8_STAGE_A(PG8_SA(1, 0), a3, 0, vaN); } else { PG8_STAGE_A(PG8_SA(1, 0), a3, 0, vaC); }
            PG8_WAIT_V(8); PG8_WAIT_L(0); PG8_BAR; PG8_MMA(1, 0, At, B0); PG8_MMA(1, 1, At, B1); PG8_BAR; PG8_SCHED;
        }
        if (wr == 0) PG8_BAR;
        E(acc, cur, wr, wc, fr, fq);
        if (!has_next) break;
#pragma unroll
        for (int a = 0; a < 2; ++a)
#pragma unroll
            for (int b = 0; b < 2; ++b)
#pragma unroll
                for (int m = 0; m < 4; ++m)
#pragma unroll
                    for (int n = 0; n < 2; ++n) acc[a][b][m][n] = (f32x4){0.f, 0.f, 0.f, 0.f};
        cur = nxt; cA = nA; cB = nB; ++ui;
        if constexpr (Sched::GATHER) {
#pragma unroll
            for (int hh = 0; hh < 2; ++hh)
#pragma unroll
                for (int i = 0; i < 2; ++i) vaC[hh][i] = vaN[hh][i];
        }
        if (wr == 1) PG8_BAR;
    }
    PG8_WAIT_V(0);
    PG8_BAR;
#undef PG8_SA
#undef PG8_SB
#undef PG8_STAGE
#undef PG8_STAGE_A
#undef PG8_LDA
#undef PG8_LDB
#undef PG8_MMA
#undef PG8_WAIT_V
#undef PG8_WAIT_L
#undef PG8_BAR
#undef PG8_SCHED
}
}
using pg8::Unit;
struct SchedG1 { static constexpr bool GATHER = false; int G, c;
    __device__ __forceinline__ bool next(int i, Unit& u) const { const int L = i * G + c; if (L >= 681) return false;
        if (L < 672) { int pm, pn; pg8::static_unit(L, 32, 21, pm, pn); u.am = pm; u.bn = pn; } else { u.am = 32; u.bn = 12 + (L - 672); }
        u.acol = 0; u.ex = 0; return true; } };
struct EpiG1 { static constexpr bool PERM = true;
    unsigned char* ws; const float* gate_bias;
    __device__ __forceinline__ void operator()(const f32x4 (&acc)[2][2][4][2], const Unit& u, int wr, int wc, int fr, int fq) const {
        const int row0 = u.am * 256 + wr * 64 + fr; const int seg = u.bn >> 2;
        if (seg < 5) {
            const size_t so = seg == 0 ? WS_UP : seg == 1 ? WS_UQ : seg == 2 ? WS_UO : seg == 3 ? WS_UK : WS_UV;
            bf16_t* base = (bf16_t*)(ws + so); const int col0 = (u.bn & 3) * 256 + wc * 32 + 8 * fq;
#pragma unroll
            for (int ai = 0; ai < 2; ++ai)
#pragma unroll
                for (int m = 0; m < 4; ++m) { bf16_t* rowp = base + (size_t)(row0 + ai * 128 + m * 16) * 1024 + col0;
#pragma unroll
                    for (int bj = 0; bj < 2; ++bj) { const f32x4 v0 = acc[ai][bj][m][0], v1 = acc[ai][bj][m][1];
                        u32x4 w; w.x = cvtpk(v0[0], v0[1]); w.y = cvtpk(v0[2], v0[3]); w.z = cvtpk(v1[0], v1[1]); w.w = cvtpk(v1[2], v1[3]);
                        *(u32x4*)(rowp + bj * 128) = w; } }
        } else {
            if (wc == 0 && fq < 2) { float* G = (float*)(ws + WS_GATES);
                const f32x4 b0 = *(const f32x4*)(gate_bias + 8 * fq), b1 = *(const f32x4*)(gate_bias + 8 * fq + 4);
#pragma unroll
                for (int ai = 0; ai < 2; ++ai)
#pragma unroll
                    for (int m = 0; m < 4; ++m) { float* rowp = G + (size_t)(row0 + ai * 128 + m * 16) * 16 + 8 * fq;
                        *(f32x4*)(rowp) = acc[ai][0][m][0] + b0; *(f32x4*)(rowp + 4) = acc[ai][0][m][1] + b1; } }
        }
    } };
struct SchedWeff { static constexpr bool GATHER = false; int G, c;
    __device__ __forceinline__ bool next(int i, Unit& u) const { if (c < 0) return false; const int L = i * G + c; if (L >= 32) return false;
        u.am = L >> 2; u.bn = L & 3; u.acol = (L & 3) * 256; u.ex = 0; return true; } };
struct EpiWeff { static constexpr bool PERM = true;
    bf16_t* W;
    __device__ __forceinline__ void operator()(const f32x4 (&acc)[2][2][4][2], const Unit& u, int wr, int wc, int fr, int fq) const {
        const int row0 = u.am * 256 + wr * 64 + fr; const int col0 = u.bn * 256 + wc * 32 + 8 * fq;
#pragma unroll
        for (int ai = 0; ai < 2; ++ai)
#pragma unroll
            for (int m = 0; m < 4; ++m) { bf16_t* rowp = W + (size_t)(row0 + ai * 128 + m * 16) * 2048 + col0;
#pragma unroll
                for (int bj = 0; bj < 2; ++bj) { const f32x4 v0 = acc[ai][bj][m][0], v1 = acc[ai][bj][m][1];
                    u32x4 w; w.x = cvtpk(v0[0], v0[1]); w.y = cvtpk(v0[2], v0[3]); w.z = cvtpk(v1[0], v1[1]); w.w = cvtpk(v1[2], v1[3]);
                    *(u32x4*)(rowp + bj * 128) = w; } }
    } };
struct SchedG2 { static constexpr bool GATHER = false; int G, c;
    __device__ __forceinline__ bool next(int i, Unit& u) const { const int L = i * G + c; if (L >= 256) return false;
        int pm, pn; pg8::static_unit(L, 32, 8, pm, pn); u.am = pm; u.bn = pn; u.acol = 0; u.ex = 0; return true; } };
struct EpiG2 { static constexpr bool PERM = false;
    const float* x; const float* g1; float* out; float* sumsq;
    __device__ __forceinline__ void operator()(const f32x4 (&acc)[2][2][4][2], const Unit& u, int wr, int wc, int fr, int fq) const {
        const int row0 = u.am * 256 + wr * 64 + fr, col0 = u.bn * 256 + wc * 32 + 4 * fq;
        f32x4 gv[2][2];
#pragma unroll
        for (int bj = 0; bj < 2; ++bj)
#pragma unroll
            for (int n = 0; n < 2; ++n) gv[bj][n] = *(const f32x4*)(g1 + col0 + bj * 128 + n * 16);
#pragma unroll
        for (int ai = 0; ai < 2; ++ai)
#pragma unroll
            for (int m = 0; m < 4; ++m) { const int row = row0 + ai * 128 + m * 16; const size_t off = (size_t)row * 2048 + col0; float ss = 0.f;
#pragma unroll
                for (int bj = 0; bj < 2; ++bj)
#pragma unroll
                    for (int n = 0; n < 2; ++n) { const f32x4 xv = *(const f32x4*)(x + off + bj * 128 + n * 16); const f32x4 h = xv + gv[bj][n] * acc[ai][bj][m][n];
                        *(f32x4*)(out + off + bj * 128 + n * 16) = h; ss += (h[0] * h[0] + h[1] * h[1]) + (h[2] * h[2] + h[3] * h[3]); }
                ss += __shfl_xor(ss, 16); ss += __shfl_xor(ss, 32);
                if (fq == 0) sumsq[(size_t)row * 32 + u.bn * 4 + wc] = ss; }
    } };
struct SchedMoE { static constexpr bool GATHER = false; int G, c, NN, btpe; const LAS int* tab;
    __device__ __forceinline__ bool next(int i, Unit& u) const { const int L = i * G + c; const int nt = tab[0]; if (L >= nt * NN) return false;
        const int tau = L / NN, pn = L - tau * NN; const int e = tab[1 + tau]; u.am = tau; u.bn = e * btpe + pn; u.acol = 0; u.ex = pn; return true; } };
struct SchedMoEG { static constexpr bool GATHER = true; int G, c, NN, btpe; const LAS int* tab; const int* ptok; const int* cnt;
    __device__ __forceinline__ bool next(int i, Unit& u) const { const int L = i * G + c; const int nt = tab[0]; if (L >= nt * NN) return false;
        const int tau = L / NN, pn = L - tau * NN; const int e = tab[1 + tau]; u.am = tau; u.bn = e * btpe + pn; u.acol = e; u.ex = pn; return true; }
    __device__ __forceinline__ int arow(const Unit& u, int r) const { const int e = u.acol; const int pos = (u.am - tab[128 + e]) * 256 + r; return pos < cnt[e] ? ptok[e * 8192 + pos] : 0; } };
struct EpiUp { static constexpr bool PERM = true;
    bf16_t* H;
    __device__ __forceinline__ void operator()(const f32x4 (&acc)[2][2][4][2], const Unit& u, int wr, int wc, int fr, int fq) const {
        const int row0 = u.am * 256 + wr * 64 + fr; const int col0 = u.ex * 128 + wc * 16 + 4 * fq;
#pragma unroll
        for (int ai = 0; ai < 2; ++ai)
#pragma unroll
            for (int m = 0; m < 4; ++m) { bf16_t* rowp = H + (size_t)(row0 + ai * 128 + m * 16) * 512 + col0;
#pragma unroll
                for (int bj = 0; bj < 2; ++bj) { const f32x4 v0 = acc[ai][bj][m][0], v1 = acc[ai][bj][m][1];
                    u32x2 w; w.x = cvtpk(siluf(v0[0]) * v0[1], siluf(v0[2]) * v0[3]); w.y = cvtpk(siluf(v1[0]) * v1[1], siluf(v1[2]) * v1[3]);
                    *(u32x2*)(rowp + bj * 64) = w; } }
    } };
struct EpiDown { static constexpr bool PERM = true;
    bf16_t* Y;
    __device__ __forceinline__ void operator()(const f32x4 (&acc)[2][2][4][2], const Unit& u, int wr, int wc, int fr, int fq) const {
        const int row0 = u.am * 256 + wr * 64 + fr; const int col0 = u.ex * 256 + wc * 32 + 8 * fq;
#pragma unroll
        for (int ai = 0; ai < 2; ++ai)
#pragma unroll
            for (int m = 0; m < 4; ++m) { bf16_t* rowp = Y + (size_t)(row0 + ai * 128 + m * 16) * 2048 + col0;
#pragma unroll
                for (int bj = 0; bj < 2; ++bj) { const f32x4 v0 = acc[ai][bj][m][0], v1 = acc[ai][bj][m][1];
                    u32x4 w; w.x = cvtpk(v0[0], v0[1]); w.y = cvtpk(v0[2], v0[3]); w.z = cvtpk(v1[0], v1[1]); w.w = cvtpk(v1[2], v1[3]);
                    *(u32x4*)(rowp + bj * 128) = w; } }
    } };
__device__ __forceinline__ void p0_adaln(const Params& P, LAS unsigned char* lds) {
    const int tid = otid();
    LAS float* sc = (LAS float*)lds; LAS float* scc = sc + 2048; LAS float* red = scc + 2048; LAS float* red2 = red + 42 * 48;
    const float* c = P.in[I_C]; const float* cc = P.in[I_CCTX]; const float* wmod = P.in[I_WMOD]; const float* bmod = P.in[I_BMOD];
    float* mod = (float*)(P.ws + WS_MOD); float* modc = mod + 16384;
    for (int i = tid; i < 2048; i += 512) { sc[i] = siluf(c[i]); scc[i] = siluf(cc[i]); }
    __syncthreads();
    for (int cb = blockIdx.x; cb < 256; cb += gridDim.x) {
        const int n0 = 48 * cb; const bool has_ctx = n0 < 4096;
        if (tid < 504) { const int col4 = tid % 12, rg = tid / 12;
            const f32x4* wp = (const f32x4*)(wmod + n0) + col4;
            f32x4 a = {0.f, 0.f, 0.f, 0.f}, a2 = {0.f, 0.f, 0.f, 0.f};
#pragma unroll 7
            for (int k = rg; k < 2048; k += 42) { const f32x4 w = wp[(size_t)k * 3072]; a += w * sc[k]; if (has_ctx) a2 += w * scc[k]; }
            *(LAS f32x4*)(red + rg * 48 + col4 * 4) = a; *(LAS f32x4*)(red2 + rg * 48 + col4 * 4) = a2; }
        __syncthreads();
        if (tid < 48) { float s = 0.f; for (int r = 0; r < 42; ++r) s += red[r * 48 + tid]; mod[n0 + tid] = s + bmod[n0 + tid]; }
        else if (has_ctx && tid >= 64 && tid < 112) { const int t = tid - 64; if (n0 + t < 4096) { float s = 0.f; for (int r = 0; r < 42; ++r) s += red2[r * 48 + t]; modc[n0 + t] = s + bmod[n0 + t]; } }
        __syncthreads();
    }
}
struct TrItem { const float* src; bf16_t* dst; int K, N, rmul; const float* nscale; bool ok; };
constexpr int I_IN = 32 * 161, I_OUT = 32 * 64, I_PL = 4 * 32, I_E13 = 32 * 16, I_E2 = 8 * 64;
constexpr int B_OUT = I_IN, B_PL = B_OUT + I_OUT, B_W1 = B_PL + I_PL, B_W3 = B_W1 + 32 * I_E13, B_W2 = B_W3 + 32 * I_E13, B_END = B_W2 + 32 * I_E2;
__device__ __forceinline__ void tr_decode(const Params& P, int it, int lane, const float*& W, bf16_t*& WT, int& K, int& N, int& row_off, int& rmul, int& item) {
    if (it < B_OUT) { W = P.in[I_WIN]; K = 2048; N = INC; WT = (bf16_t*)(P.ws + WS_WINT); row_off = 0; rmul = 1; item = it; }
    else if (it < B_W1) { W = P.in[I_WOUT]; K = 2048; N = 2048; WT = (bf16_t*)(P.ws + WS_WOUTT); row_off = 0; rmul = 1; item = it - B_OUT; }
    else if (it < B_W3) { const int r = it - B_W1, e = r / I_E13; W = P.in[I_W1] + (size_t)e * 2048 * 512; K = 2048; N = 512; WT = (bf16_t*)(P.ws + WS_W13T) + (size_t)e * 1024 * 2048; row_off = 0; rmul = 2; item = r - e * I_E13; }
    else if (it < B_W2) { const int r = it - B_W3, e = r / I_E13; W = P.in[I_W3] + (size_t)e * 2048 * 512; K = 2048; N = 512; WT = (bf16_t*)(P.ws + WS_W13T) + (size_t)e * 1024 * 2048; row_off = 1; rmul = 2; item = r - e * I_E13; }
    else { const int r = it - B_W2, e = r / I_E2; W = P.in[I_W2] + (size_t)e * 512 * 2048; K = 512; N = 2048; WT = (bf16_t*)(P.ws + WS_W2T) + (size_t)e * 2048 * 512; row_off = 0; rmul = 1; item = r - e * I_E2; }
}
__device__ __forceinline__ void tr_load(const Params& P, int it, int lane, f32x4 (&v)[8]) {
    const float* W; bf16_t* WT; int K, N, row_off, rmul, item; tr_decode(P, it, lane, W, WT, K, N, row_off, rmul, item);
    const int nblk = (N + 31) >> 5, kb = item / nblk, nb = item - kb * nblk, k0 = 64 * kb, n0 = 32 * nb; const int nn = n0 + 4 * (lane & 7); const bool ok = nn < N;
#pragma unroll
    for (int i = 0; i < 8; ++i) { const int kk = 8 * i + (lane >> 3); v[i] = ok ? *(const f32x4*)(W + (size_t)(k0 + kk) * N + nn) : (f32x4){0.f, 0.f, 0.f, 0.f}; }
}
__device__ __forceinline__ void tr_store(const Params& P, int it, int lane, const f32x4 (&v)[8], LAS float* scr) {
    const float* W; bf16_t* WT; int K, N, row_off, rmul, item; tr_decode(P, it, lane, W, WT, K, N, row_off, rmul, item);
    const int nblk = (N + 31) >> 5, kb = item / nblk, nb = item - kb * nblk, k0 = 64 * kb, n0 = 32 * nb; const int c4 = lane & 7;
#pragma unroll
    for (int i = 0; i < 8; ++i) { const int kk = 8 * i + (lane >> 3); LAS float* d = scr + kk * 33 + 4 * c4; d[0] = v[i][0]; d[1] = v[i][1]; d[2] = v[i][2]; d[3] = v[i][3]; }
    LDS_WAIT(); asm volatile("" ::: "memory");
    const int cch = lane & 7;
#pragma unroll
    for (int j = 0; j < 4; ++j) { const int n = (lane >> 3) + 8 * j; const LAS float* s = scr + (8 * cch) * 33 + n;
        u32x4 o; o.x = cvtpk(s[0 * 33], s[1 * 33]); o.y = cvtpk(s[2 * 33], s[3 * 33]); o.z = cvtpk(s[4 * 33], s[5 * 33]); o.w = cvtpk(s[6 * 33], s[7 * 33]);
        *(u32x4*)(WT + (size_t)(row_off + (n0 + n) * rmul) * K + k0 + 8 * cch) = o; }
    LDS_WAIT(); asm volatile("" ::: "memory");
}
__device__ __forceinline__ void p0_transposes(const Params& P, LAS unsigned char* lds, int lo_item, int hi_item, int gw, int NGW) {
    const int tid = otid(), lane = tid & 63, wave = __builtin_amdgcn_readfirstlane(tid >> 6);
    LAS float* scr = (LAS float*)(lds + 32768 + wave * 8704);
    if (hi_item > B_END) hi_item = B_END;
    int it = lo_item + gw; if (it >= hi_item) return;
    if (it >= B_PL && it < B_W1) it += NGW * ((B_W1 - it + NGW - 1) / NGW);
    if (it >= hi_item) return;
    f32x4 va[8], vb[8];
    tr_load(P, it, lane, va);
    for (;;) {
        int nx = it + NGW; if (nx >= B_PL && nx < B_W1) nx += NGW * ((B_W1 - nx + NGW - 1) / NGW);
        const bool h1 = nx < hi_item; if (h1) tr_load(P, nx, lane, vb);
        tr_store(P, it, lane, va, scr); if (!h1) break; it = nx;
        nx = it + NGW; if (nx >= B_PL && nx < B_W1) nx += NGW * ((B_W1 - nx + NGW - 1) / NGW);
        const bool h2 = nx < hi_item; if (h2) tr_load(P, nx, lane, va);
        tr_store(P, it, lane, vb, scr); if (!h2) break; it = nx;
    }
}
constexpr int TR_ITEMS_EARLY = 32 * 161 + 32 * 64 + 4 * 32;
constexpr int TR_ITEMS_ALL = TR_ITEMS_EARLY + 64 * 512 + 32 * 512;
#ifndef TR_SPLIT_PCT
#define TR_SPLIT_PCT 50
#endif
constexpr int TR_ITEMS_MID = TR_ITEMS_EARLY + (int)((long)(TR_ITEMS_ALL - TR_ITEMS_EARLY) * TR_SPLIT_PCT / 100);
__device__ __forceinline__ void p0_wpool_scaled(const Params& P) {
    const float* wp = P.in[I_WPOOL]; const float* ps = P.in[I_PSC]; u32x2* o = (u32x2*)(P.ws + WS_WPOOLS);
    for (int i = blockIdx.x * 512 + threadIdx.x; i < 65536; i += gridDim.x * 512) { const f32x4 w = *(const f32x4*)(wp + (size_t)4 * i); const int g = i >> 14, d0 = (4 * i) & 255; const f32x4 sc = *(const f32x4*)(ps + g * 256 + d0);
        const f32x4 y = w * sc; u32x2 r; r.x = cvtpk(y[0], y[1]); r.y = cvtpk(y[2], y[3]); o[i] = r; }
}
__device__ __forceinline__ void p0_zero_pad(const Params& P) {
    u32x4* z = (u32x4*)((bf16_t*)(P.ws + WS_WINT) + (size_t)5152 * 2048); const int n = (NPAD - 5152) * 2048 / 8;
    for (int i = blockIdx.x * 512 + threadIdx.x; i < n; i += gridDim.x * 512) z[i] = (u32x4){0u, 0u, 0u, 0u};
}
__device__ __forceinline__ void p1_router_prep(const Params& P) {
    const int tid = otid(), lane = tid & 63, wave = tid >> 6;
    const float* mod = (const float*)(P.ws + WS_MOD); const float* g = P.in[I_N2G]; const float* wg = P.in[I_WGRP]; const float* wr = P.in[I_WRT];
    float* WRP = (float*)(P.ws + WS_WRP); float* BRP = (float*)(P.ws + WS_WRP + 448 * 1024);
    for (int idx = blockIdx.x * 512 + tid; idx < 2048 * 48; idx += gridDim.x * 512) { const int k = idx / 48, c = idx - 48 * k;
        const float w = c < 32 ? wr[k * 32 + c] : c < 36 ? wg[k * 4 + c - 32] : 0.f;
        WRP[(size_t)((k >> 2) * 48 + c) * 4 + (k & 3)] = w * g[k] * (1.0f + mod[8192 + k]); }
    if (wave == 0) for (int c = blockIdx.x; c < 48; c += gridDim.x) { float s = 0.f;
        if (c < 36) { for (int k = lane; k < 2048; k += 64) s += mod[6144 + k] * (c < 32 ? wr[k * 32 + c] : wg[k * 4 + c - 32]); s = wave_sum(s) + (c < 32 ? P.in[I_BRT][c] : P.in[I_BGRP][c - 32]); }
        if (lane == 0) BRP[c] = s; }
}
__device__ __forceinline__ void p1_xn(const Params& P, int nwg) {
    const int tid = otid(), lane = tid & 63, wave = tid >> 6;
    const int gw = blockIdx.x * 8 + wave, NGW = nwg * 8;
    const float* mod = (const float*)(P.ws + WS_MOD); const float* modc = mod + 16384; const float* g = P.in[I_N1G];
    bf16_t* XN = (bf16_t*)(P.ws + WS_XN);
    for (int pass = 0; pass < 2; ++pass) {
        const float* sh = pass == 0 ? mod : modc; const float* scl = pass == 0 ? mod + 2048 : modc + 2048;
        const float* src = pass == 0 ? P.in[I_X] : P.in[I_CTX]; const int nrows = pass == 0 ? SEQ : CTXL; const int rbase = pass == 0 ? 0 : SEQ;
        if (gw >= nrows) continue;
        f32x4 a[8], s[8];
#pragma unroll
        for (int j = 0; j < 8; ++j) { const int d0 = 4 * lane + 256 * j; const f32x4 gg = *(const f32x4*)(g + d0), sv = *(const f32x4*)(scl + d0); a[j] = gg * (sv + 1.0f); s[j] = *(const f32x4*)(sh + d0); }
        for (int r = gw; r < nrows; r += 2 * NGW) {
            const int r2 = r + NGW; const bool h2 = r2 < nrows; const int rr2 = h2 ? r2 : r;
            const f32x4* xr = (const f32x4*)(src + (size_t)r * D) + lane; const f32x4* xq = (const f32x4*)(src + (size_t)rr2 * D) + lane; f32x4 v[8], w[8]; float ss = 0.f, st = 0.f;
#pragma unroll
            for (int j = 0; j < 8; ++j) { v[j] = xr[64 * j]; w[j] = xq[64 * j]; }
#pragma unroll
            for (int j = 0; j < 8; ++j) { ss += (v[j][0] * v[j][0] + v[j][1] * v[j][1]) + (v[j][2] * v[j][2] + v[j][3] * v[j][3]); st += (w[j][0] * w[j][0] + w[j][1] * w[j][1]) + (w[j][2] * w[j][2] + w[j][3] * w[j][3]); }
            const float rstd = 1.0f / sqrtf(wave_sum(ss) * (1.0f / D) + EPSF), rstd2 = 1.0f / sqrtf(wave_sum(st) * (1.0f / D) + EPSF);
            u32x2* o = (u32x2*)(XN + (size_t)(rbase + r) * D) + lane; u32x2* o2 = (u32x2*)(XN + (size_t)(rbase + rr2) * D) + lane;
#pragma unroll
            for (int j = 0; j < 8; ++j) { const f32x4 y = v[j] * rstd * a[j] + s[j]; u32x2 pk; pk.x = cvtpk(y[0], y[1]); pk.y = cvtpk(y[2], y[3]); o[64 * j] = pk; }
            if (h2) {
#pragma unroll
                for (int j = 0; j < 8; ++j) { const f32x4 y = w[j] * rstd2 * a[j] + s[j]; u32x2 pk; pk.x = cvtpk(y[0], y[1]); pk.y = cvtpk(y[2], y[3]); o2[64 * j] = pk; } }
        }
    }
}
__device__ __forceinline__ void p3_qk_task(const Params& P, int isk, int j, int h) {
    const int tid = otid(), o = tid >> 6, f4 = tid & 63;
    const int t0 = 64 * j, seq_lo = j < 128 ? 0 : SEQ, seq_hi = j < 128 ? SEQ : MTOT;
    const bf16_t* U = (const bf16_t*)(P.ws + (isk ? WS_UK : WS_UQ)); const float* wc = P.in[isk ? I_WCK : I_WCQ];
    const int f0 = h * 256 + 4 * f4;
    const f32x4 w0 = *(const f32x4*)(wc + f0), w1 = *(const f32x4*)(wc + 1024 + f0), w2 = *(const f32x4*)(wc + 2048 + f0);
    const float osc = isk ? 1.0f : 0.0625f;
    u32x2 raw[10];
#pragma unroll
    for (int i = 0; i < 10; ++i) { const int t = t0 + 8 * o - 1 + i; raw[i] = (t >= seq_lo && t < seq_hi) ? *(const u32x2*)(U + (size_t)t * 1024 + f0) : (u32x2){0u, 0u}; }
    float outv[8][4];
#pragma unroll
    for (int i = 0; i < 8; ++i) {
        const f32x4 a = {bflo(raw[i].x), bfhi(raw[i].x), bflo(raw[i].y), bfhi(raw[i].y)}, b = {bflo(raw[i + 1].x), bfhi(raw[i + 1].x), bflo(raw[i + 1].y), bfhi(raw[i + 1].y)},
                    c = {bflo(raw[i + 2].x), bfhi(raw[i + 2].x), bflo(raw[i + 2].y), bfhi(raw[i + 2].y)};
        const f32x4 s = a * w0 + b * w1 + c * w2;
#pragma unroll
        for (int e = 0; e < 4; ++e) outv[i][e] = siluf(s[e]) * osc;
    }
    bf16_t* R = (bf16_t*)(P.ws + (isk ? WS_KC : WS_QC));
#pragma unroll
    for (int i = 0; i < 8; ++i) { u32x2 w; w.x = cvtpk(outv[i][0], outv[i][1]); w.y = cvtpk(outv[i][2], outv[i][3]); *(u32x2*)(R + (size_t)(t0 + 8 * o + i) * 1024 + f0) = w; }
    if (isk) { bf16_t* KT = (bf16_t*)(P.ws + WS_KT);
#pragma unroll
        for (int e = 0; e < 4; ++e) { u32x4 w; w.x = cvtpk(outv[0][e], outv[1][e]); w.y = cvtpk(outv[2][e], outv[3][e]); w.z = cvtpk(outv[4][e], outv[5][e]); w.w = cvtpk(outv[6][e], outv[7][e]);
            *(u32x4*)(KT + ((size_t)(h * 132 + j) * 256 + 4 * f4 + e) * 64 + 8 * o) = w; } }
}
__device__ __forceinline__ void p3_v_task(const Params& P, LAS unsigned char* lds, int j, int h) {
    const int tid = otid(), lane = tid & 63, wave = tid >> 6, o = tid >> 6, f4 = tid & 63;
    const int t0 = 64 * j; LAS float* wkl = (LAS float*)lds;
    __syncthreads();
    if (wave < 2) { const int d = wave; const float* G = (const float*)(P.ws + WS_GATES) + (size_t)(t0 + lane) * 16;
        const float ig = G[(2 * d) * 4 + h], fg = G[(2 * d + 1) * 4 + h];
        float b = logsigmoidf_(fg);
        if (d == 0) {
#pragma unroll
            for (int s = 1; s < 64; s <<= 1) { const float t = __shfl_up(b, s); if (lane >= s) b += t; }
        } else {
#pragma unroll
            for (int s = 1; s < 64; s <<= 1) { const float t = __shfl_down(b, s); if (lane + s < 64) b += t; }
        }
        const float gtot = __shfl(b, d == 0 ? 63 : 0); const float e = ig - b; const float em = wave_max(e);
        const size_t ix = (size_t)(d * 4 + h) * MTOT + t0 + lane;
        ((float*)(P.ws + WS_E))[ix] = e; ((float*)(P.ws + WS_BC))[ix] = b;
        if (lane == 0) { float* gc = (float*)(P.ws + WS_GC); gc[(d * 4 + h) * 132 + j] = gtot; gc[2048 + (d * 4 + h) * 132 + j] = em; }
        wkl[d * 64 + lane] = __expf(e - em);
    }
    __syncthreads();
    const bf16_t* U = (const bf16_t*)(P.ws + WS_UV); const int f0 = h * 256 + 4 * f4;
    float v[8][4];
#pragma unroll
    for (int i = 0; i < 8; ++i) { const u32x2 r = *(const u32x2*)(U + (size_t)(t0 + 8 * o + i) * 1024 + f0); v[i][0] = bflo(r.x); v[i][1] = bfhi(r.x); v[i][2] = bflo(r.y); v[i][3] = bfhi(r.y); }
    bf16_t* VT = (bf16_t*)(P.ws + WS_VT); bf16_t* VSF = (bf16_t*)(P.ws + WS_VSF); bf16_t* VSB = (bf16_t*)(P.ws + WS_VSB);
    float sf[8], sb[8];
#pragma unroll
    for (int i = 0; i < 8; ++i) { sf[i] = wkl[8 * o + i]; sb[i] = wkl[64 + 8 * o + i]; }
#pragma unroll
    for (int e = 0; e < 4; ++e) { const size_t off = ((size_t)(h * 132 + j) * 272 + 4 * f4 + e) * 64 + 8 * o; u32x4 w;
        w.x = cvtpk(v[0][e], v[1][e]); w.y = cvtpk(v[2][e], v[3][e]); w.z = cvtpk(v[4][e], v[5][e]); w.w = cvtpk(v[6][e], v[7][e]); *(u32x4*)(VT + off) = w;
        w.x = cvtpk(v[0][e] * sf[0], v[1][e] * sf[1]); w.y = cvtpk(v[2][e] * sf[2], v[3][e] * sf[3]); w.z = cvtpk(v[4][e] * sf[4], v[5][e] * sf[5]); w.w = cvtpk(v[6][e] * sf[6], v[7][e] * sf[7]); *(u32x4*)(VSF + off) = w;
        w.x = cvtpk(v[0][e] * sb[0], v[1][e] * sb[1]); w.y = cvtpk(v[2][e] * sb[2], v[3][e] * sb[3]); w.z = cvtpk(v[4][e] * sb[4], v[5][e] * sb[5]); w.w = cvtpk(v[6][e] * sb[6], v[7][e] * sb[7]); *(u32x4*)(VSB + off) = w; }
    if (tid < 128) {
        const int rr = tid >> 3, oc = tid & 7; const size_t off = ((size_t)(h * 132 + j) * 272 + 256 + rr) * 64 + 8 * oc; u32x4 w1 = {0u, 0u, 0u, 0u}, wf = w1, wb = w1;
        if (rr == 0) { w1 = (u32x4){0x3f803f80u, 0x3f803f80u, 0x3f803f80u, 0x3f803f80u};
            wf.x = cvtpk(wkl[8 * oc], wkl[8 * oc + 1]); wf.y = cvtpk(wkl[8 * oc + 2], wkl[8 * oc + 3]); wf.z = cvtpk(wkl[8 * oc + 4], wkl[8 * oc + 5]); wf.w = cvtpk(wkl[8 * oc + 6], wkl[8 * oc + 7]);
            wb.x = cvtpk(wkl[64 + 8 * oc], wkl[64 + 8 * oc + 1]); wb.y = cvtpk(wkl[64 + 8 * oc + 2], wkl[64 + 8 * oc + 3]); wb.z = cvtpk(wkl[64 + 8 * oc + 4], wkl[64 + 8 * oc + 5]); wb.w = cvtpk(wkl[64 + 8 * oc + 6], wkl[64 + 8 * oc + 7]); }
        *(u32x4*)(VT + off) = w1; *(u32x4*)(VSF + off) = wf; *(u32x4*)(VSB + off) = wb; }
}
__device__ __forceinline__ void p3_pool_task(const Params& P, LAS unsigned char* lds, int r, int gi) {
    const int tid = otid(), chunk = tid & 31, cb = tid >> 5; const int win = 2 << gi, hw = win >> 1;
    const int rlo = max(r - hw, 0), rhi = min(r - hw + win, 128);
    const bf16_t* U = (const bf16_t*)(P.ws + WS_UP) + gi * 256 + 8 * chunk; LAS float* vs = (LAS float*)lds;
    __syncthreads();
    float own[4][8];
#pragma unroll
    for (int i = 0; i < 4; ++i) { const int c = cb + 16 * i; float a[8];
#pragma unroll
        for (int e = 0; e < 8; ++e) a[e] = 0.f;
        for (int rr = rlo; rr < rhi; ++rr) { const u32x4 w = *(const u32x4*)(U + (size_t)(rr * 64 + c) * 1024);
            const float x[8] = {bflo(w.x), bfhi(w.x), bflo(w.y), bfhi(w.y), bflo(w.z), bfhi(w.z), bflo(w.w), bfhi(w.w)};
#pragma unroll
            for (int e = 0; e < 8; ++e) a[e] += x[e];
            if (rr == r) {
#pragma unroll
                for (int e = 0; e < 8; ++e) own[i][e] = x[e]; } }
        *(LAS f32x4*)(vs + c * 256 + 8 * chunk) = (f32x4){a[0], a[1], a[2], a[3]}; *(LAS f32x4*)(vs + c * 256 + 8 * chunk + 4) = (f32x4){a[4], a[5], a[6], a[7]}; }
    __syncthreads();
    bf16_t* Dp = (bf16_t*)(P.ws + WS_A2) + gi * 256 + 8 * chunk;
#pragma unroll
    for (int i = 0; i < 4; ++i) { const int c = cb + 16 * i; const int clo = max(c - hw, 0), chi = min(c - hw + win, 64);
        f32x4 s0 = {0.f, 0.f, 0.f, 0.f}, s1 = s0;
        for (int cc = clo; cc < chi; ++cc) { s0 += *(const LAS f32x4*)(vs + cc * 256 + 8 * chunk); s1 += *(const LAS f32x4*)(vs + cc * 256 + 8 * chunk + 4); }
        const float inv = 1.0f / (float)((rhi - rlo) * (chi - clo));
        u32x4 w; w.x = cvtpk(s0[0] * inv - own[i][0], s0[1] * inv - own[i][1]); w.y = cvtpk(s0[2] * inv - own[i][2], s0[3] * inv - own[i][3]);
        w.z = cvtpk(s1[0] * inv - own[i][4], s1[1] * inv - own[i][5]); w.w = cvtpk(s1[2] * inv - own[i][6], s1[3] * inv - own[i][7]);
        *(u32x4*)(Dp + (size_t)(r * 64 + c) * 2048) = w; }
}
__device__ __forceinline__ void p3_all(const Params& P, LAS unsigned char* lds) {
    for (int t = blockIdx.x; t < 2080; t += gridDim.x) {
        if (t < 512) p3_qk_task(P, 0, t >> 2, t & 3);
        else if (t < 1040) p3_qk_task(P, 1, (t - 512) >> 2, (t - 512) & 3);
        else if (t < 1568) p3_v_task(P, lds, (t - 1040) >> 2, (t - 1040) & 3);
        else p3_pool_task(P, lds, (t - 1568) >> 2, (t - 1568) & 3);
    }
}
__device__ __forceinline__ int step_chunk(int d, int j) { return d == 0 ? (j < 4 ? 128 + j : j - 4) : (j < 4 ? 131 - j : 131 - j); }
__device__ __forceinline__ void p4_state(const Params& P, LAS unsigned char* lds, int sb, bool dry = false) {
    const int tid = otid(), lane = tid & 63, wave = __builtin_amdgcn_readfirstlane(tid >> 6);
    const int hd = sb & 7, h = hd >> 1, d = hd & 1, lb = sb >> 3;
    LAS float* tg = (LAS float*)(lds + 110592); LAS float* te = tg + 132; LAS float* tm = te + 132; LAS float* tdec = tm + 132; LAS float* tsf = tdec + 132;
    const float* gc = (const float*)(P.ws + WS_GC);
    if (tid < 132) { const int ci = step_chunk(d, tid); tg[tid] = gc[(d * 4 + h) * 132 + ci]; te[tid] = gc[2048 + (d * 4 + h) * 132 + ci]; }
    __syncthreads();
    if (tid == 0) { float m = 0.f;
#pragma unroll 4
        for (int j = 0; j < 132; ++j) { tm[j] = m; m = tg[j] + fmaxf(m, te[j]); } }
    __syncthreads();
    if (tid < 132) { const float m = tm[tid], em = te[tid], Mf = fmaxf(m, em); tdec[tid] = __expf(m - Mf); tsf[tid] = __expf(em - Mf);
        if (lb == 0 && !dry) ((float*)(P.ws + WS_GC))[4096 + (d * 4 + h) * 132 + step_chunk(d, tid)] = m; }
    __syncthreads();
    if (wave >= 3) { if (!dry && STAGE >= 4) p0_transposes(P, lds, TR_ITEMS_MID, TR_ITEMS_ALL, sb * 5 + (wave - 3), (int)gridDim.x * 5); return; }
    const int task = lb + 32 * wave; if (task >= 72) return;
    const int kq = task / 9, vq = task - 9 * kq; const bool two = vq < 8; const int vt0 = two ? 2 * vq : 16;
    const int fr = lane & 15, fq = lane >> 4;
    const bf16_t* KT = (const bf16_t*)(P.ws + WS_KT) + ((size_t)(h * 132) * 256 + kq * 32) * 64 + lane * 8;
    const bf16_t* VS = (const bf16_t*)(P.ws + (d == 0 ? WS_VSF : WS_VSB)) + ((size_t)(h * 132) * 272 + vt0 * 16) * 64 + lane * 8;
    const int vs1 = two ? 16 * 64 : 0;
    LAS unsigned char* wb = lds + wave * 9216;
    const int wofs = (lane >> 3) * 144 + 16 * (lane & 7), rofs = fr * 144 + 16 * fq;
    bf16_t* CST = (bf16_t*)(P.ws + WS_CST); float* NST = (float*)(P.ws + WS_NST);
    f32x4 C[2][2];
#pragma unroll
    for (int a = 0; a < 2; ++a)
#pragma unroll
        for (int b = 0; b < 2; ++b) C[a][b] = (f32x4){0.f, 0.f, 0.f, 0.f};
    u32x4 rg[4][8];
#define P4_LOAD(slot, jj) do { const size_t cj_ = (size_t)step_chunk(d, (jj)); const bf16_t* kp_ = KT + cj_ * (256 * 64); const bf16_t* vp_ = VS + cj_ * (272 * 64); \
        rg[slot][0] = *(const u32x4*)(kp_); rg[slot][1] = *(const u32x4*)(kp_ + 512); rg[slot][2] = *(const u32x4*)(kp_ + 1024); rg[slot][3] = *(const u32x4*)(kp_ + 1536); \
        rg[slot][4] = *(const u32x4*)(vp_); rg[slot][5] = *(const u32x4*)(vp_ + 512); rg[slot][6] = *(const u32x4*)(vp_ + vs1); rg[slot][7] = *(const u32x4*)(vp_ + vs1 + 512); } while (0)
    P4_LOAD(0, 0); P4_LOAD(1, 1); P4_LOAD(2, 2);
    for (int j0 = 0; j0 < 132; j0 += 4) {
#pragma unroll
        for (int u = 0; u < 4; ++u) { const int j = j0 + u;
            if (j + 3 < 132) P4_LOAD((u + 3) & 3, j + 3);
#pragma unroll
            for (int i = 0; i < 8; ++i) *(LAS u32x4*)(wb + (i >> 1) * 2304 + (i & 1) * 1152 + wofs) = rg[u][i];
            const int ci = step_chunk(d, j);
            if (ci < 128 && !dry) {
                const size_t rb = (((size_t)ci * 4 + h) * 2 + d) * 256;
                if (two) {
#pragma unroll
                    for (int a = 0; a < 2; ++a)
#pragma unroll
                        for (int b = 0; b < 2; ++b) { u32x2 w; w.x = cvtpk(C[a][b][0], C[a][b][1]); w.y = cvtpk(C[a][b][2], C[a][b][3]); *(u32x2*)(CST + (rb + (vt0 + b) * 16 + fr) * 256 + kq * 32 + 16 * a + 4 * fq) = w; }
                } else if (fr == 0) {
#pragma unroll
                    for (int a = 0; a < 2; ++a) *(f32x4*)(NST + rb + kq * 32 + 16 * a + 4 * fq) = C[a][0]; }
            }
            const float dec = tdec[j], sf = tsf[j];
            bf16x8 fa[2][2], fb[2][2];
#pragma unroll
            for (int t = 0; t < 2; ++t)
#pragma unroll
                for (int ks = 0; ks < 2; ++ks) { fa[t][ks] = *(const LAS bf16x8*)(wb + t * 2304 + rofs + 64 * ks); fb[t][ks] = *(const LAS bf16x8*)(wb + (2 + t) * 2304 + rofs + 64 * ks); }
#pragma unroll
            for (int a = 0; a < 2; ++a)
#pragma unroll
                for (int b = 0; b < 2; ++b) { f32x4 Dt = {0.f, 0.f, 0.f, 0.f};
#pragma unroll
                    for (int ks = 0; ks < 2; ++ks) Dt = __builtin_amdgcn_mfma_f32_16x16x32_bf16(fa[a][ks], fb[b][ks], Dt, 0, 0, 0);
                    C[a][b] = C[a][b] * dec + Dt * sf; }
        }
    }
#undef P4_LOAD
}
constexpr int O_QS = 0, O_KS = 33792, O_VT = 67584, O_WS = 106752, O_SC = 125184, O_DEN = 127232, O_RED = 127744, O_END = 131840;
__device__ __forceinline__ void p5_task(const Params& P, LAS unsigned char* lds, int c, int h) {
    const int tid = otid(), lane = tid & 63, wave = __builtin_amdgcn_readfirstlane(tid >> 6), fr = lane & 15, fq = lane >> 4;
    const int t0 = 64 * c;
    LAS float* Es = (LAS float*)(lds + O_SC); LAS float* Ms = Es + 128; LAS float* Wi = Ms + 128; LAS float* Fl = Wi + 128; LAS float* dens = (LAS float*)(lds + O_DEN); LAS float* red = (LAS float*)(lds + O_RED);
    __syncthreads();
    { const bf16_t* Q = (const bf16_t*)(P.ws + WS_QC) + (size_t)t0 * 1024 + h * 256; const bf16_t* Kc = (const bf16_t*)(P.ws + WS_KC) + (size_t)t0 * 1024 + h * 256;
#pragma unroll
      for (int i = 0; i < 4; ++i) { const int idx = tid + 512 * i, r = idx >> 5, ch = idx & 31;
          const u32x4 qv = *(const u32x4*)(Q + (size_t)r * 1024 + 8 * ch), kv = *(const u32x4*)(Kc + (size_t)r * 1024 + 8 * ch);
          *(LAS u32x4*)(lds + O_QS + r * 528 + 16 * ch) = qv; *(LAS u32x4*)(lds + O_KS + r * 528 + 16 * ch) = kv; }
      const bf16_t* VT = (const bf16_t*)(P.ws + WS_VT) + (size_t)(h * 132 + c) * (272 * 64);
      for (int idx = tid; idx < 272 * 8; idx += 512) { const int r = idx >> 3, ch = idx & 7; *(LAS u32x4*)(lds + O_VT + r * 144 + 16 * ch) = *(const u32x4*)(VT + (size_t)r * 64 + 8 * ch); } }
    if (wave < 2) { const int d = wave; const size_t ix = (size_t)(d * 4 + h) * MTOT + t0 + lane;
        const float e = ((const float*)(P.ws + WS_E))[ix], b = ((const float*)(P.ws + WS_BC))[ix]; const float m = ((const float*)(P.ws + WS_GC))[4096 + (d * 4 + h) * 132 + c];
        float pm = e;
        if (d == 0) {
#pragma unroll
            for (int s = 1; s < 64; s <<= 1) { const float t = __shfl_up(pm, s); if (lane >= s) pm = fmaxf(pm, t); }
        } else {
#pragma unroll
            for (int s = 1; s < 64; s <<= 1) { const float t = __shfl_down(pm, s); if (lane + s < 64) pm = fmaxf(pm, t); }
        }
        const float Mt = fmaxf(m, pm);
        Es[d * 64 + lane] = e; Ms[d * 64 + lane] = Mt; Wi[d * 64 + lane] = __expf(m - Mt); Fl[d * 64 + lane] = __expf(-(b + Mt)); }
    __syncthreads();
    { const int st = wave >> 1, tt0 = 2 * (wave & 1); f32x4 S0 = {0.f, 0.f, 0.f, 0.f}, S1 = S0;
#pragma unroll
      for (int ks = 0; ks < 8; ++ks) { const bf16x8 ak = *(const LAS bf16x8*)(lds + O_KS + (16 * st + fr) * 528 + 64 * ks + 16 * fq);
          const bf16x8 bq0 = *(const LAS bf16x8*)(lds + O_QS + (16 * tt0 + fr) * 528 + 64 * ks + 16 * fq), bq1 = *(const LAS bf16x8*)(lds + O_QS + (16 * tt0 + 16 + fr) * 528 + 64 * ks + 16 * fq);
          S0 = __builtin_amdgcn_mfma_f32_16x16x32_bf16(ak, bq0, S0, 0, 0, 0); S1 = __builtin_amdgcn_mfma_f32_16x16x32_bf16(ak, bq1, S1, 0, 0, 0); }
      const int s0 = 16 * st + 4 * fq;
#pragma unroll
      for (int d = 0; d < 2; ++d) { const f32x4 ev = *(const LAS f32x4*)(Es + d * 64 + s0);
#pragma unroll
          for (int q = 0; q < 2; ++q) { const int t = 16 * (tt0 + q) + fr; const float Mt = Ms[d * 64 + t]; const f32x4 S = q == 0 ? S0 : S1; float w[4];
#pragma unroll
              for (int i = 0; i < 4; ++i) { const int s = s0 + i; const bool on = d == 0 ? (s <= t) : (s >= t); w[i] = on ? __expf(ev[i] - Mt) * S[i] : 0.f; }
              u32x2 pk; pk.x = cvtpk(w[0], w[1]); pk.y = cvtpk(w[2], w[3]); *(LAS u32x2*)(lds + O_WS + (d * 64 + t) * 144 + 2 * s0) = pk; } } }
    __syncthreads();
    f32x4 acc[2][2][4];
    const bf16_t* CST = (const bf16_t*)(P.ws + WS_CST);
#pragma unroll
    for (int d = 0; d < 2; ++d) {
        const bf16_t* Cp = CST + ((((size_t)c * 4 + h) * 2 + d) * 256 + 32 * wave + fr) * 256 + 8 * fq;
        bf16x8 ca[2][8];
#pragma unroll
        for (int v = 0; v < 2; ++v)
#pragma unroll
            for (int ks = 0; ks < 8; ++ks) ca[v][ks] = *(const bf16x8*)(Cp + (size_t)v * 16 * 256 + 32 * ks);
#pragma unroll
        for (int v = 0; v < 2; ++v)
#pragma unroll
            for (int tt = 0; tt < 4; ++tt) acc[d][v][tt] = (f32x4){0.f, 0.f, 0.f, 0.f};
#pragma unroll
        for (int ks = 0; ks < 8; ++ks) {
#pragma unroll
            for (int tt = 0; tt < 4; ++tt) { const bf16x8 bq = *(const LAS bf16x8*)(lds + O_QS + (16 * tt + fr) * 528 + 64 * ks + 16 * fq);
                acc[d][0][tt] = __builtin_amdgcn_mfma_f32_16x16x32_bf16(ca[0][ks], bq, acc[d][0][tt], 0, 0, 0); acc[d][1][tt] = __builtin_amdgcn_mfma_f32_16x16x32_bf16(ca[1][ks], bq, acc[d][1][tt], 0, 0, 0); } }
#pragma unroll
        for (int tt = 0; tt < 4; ++tt) { const float wi = Wi[d * 64 + 16 * tt + fr]; acc[d][0][tt] *= wi; acc[d][1][tt] *= wi; }
#pragma unroll
        for (int ks = 0; ks < 2; ++ks) { const bf16x8 va0 = *(const LAS bf16x8*)(lds + O_VT + (32 * wave + fr) * 144 + 64 * ks + 16 * fq), va1 = *(const LAS bf16x8*)(lds + O_VT + (32 * wave + 16 + fr) * 144 + 64 * ks + 16 * fq);
#pragma unroll
            for (int tt = 0; tt < 4; ++tt) { const bf16x8 bw = *(const LAS bf16x8*)(lds + O_WS + (d * 64 + 16 * tt + fr) * 144 + 64 * ks + 16 * fq);
                acc[d][0][tt] = __builtin_amdgcn_mfma_f32_16x16x32_bf16(va0, bw, acc[d][0][tt], 0, 0, 0); acc[d][1][tt] = __builtin_amdgcn_mfma_f32_16x16x32_bf16(va1, bw, acc[d][1][tt], 0, 0, 0); } }
    }
    { const int tt = wave & 3, d = wave >> 2; f32x4 dn = {0.f, 0.f, 0.f, 0.f};
      const float* np = (const float*)(P.ws + WS_NST) + (((size_t)c * 4 + h) * 2 + d) * 256 + 8 * fq;
#pragma unroll
      for (int ks = 0; ks < 8; ++ks) { bf16x8 an = {0, 0, 0, 0, 0, 0, 0, 0};
          if (fr == 0) { const f32x4 n0 = *(const f32x4*)(np + 32 * ks), n1 = *(const f32x4*)(np + 32 * ks + 4); u32x4 w; w.x = cvtpk(n0[0], n0[1]); w.y = cvtpk(n0[2], n0[3]); w.z = cvtpk(n1[0], n1[1]); w.w = cvtpk(n1[2], n1[3]); an = __builtin_bit_cast(bf16x8, w); }
          const bf16x8 bq = *(const LAS bf16x8*)(lds + O_QS + (16 * tt + fr) * 528 + 64 * ks + 16 * fq);
          dn = __builtin_amdgcn_mfma_f32_16x16x32_bf16(an, bq, dn, 0, 0, 0); }
      dn *= Wi[d * 64 + 16 * tt + fr];
#pragma unroll
      for (int ks = 0; ks < 2; ++ks) { const bf16x8 va = *(const LAS bf16x8*)(lds + O_VT + (256 + fr) * 144 + 64 * ks + 16 * fq); const bf16x8 bw = *(const LAS bf16x8*)(lds + O_WS + (d * 64 + 16 * tt + fr) * 144 + 64 * ks + 16 * fq);
          dn = __builtin_amdgcn_mfma_f32_16x16x32_bf16(va, bw, dn, 0, 0, 0); }
      if (fq == 0) dens[d * 64 + 16 * tt + fr] = dn[0]; }
    __syncthreads();
    float hv[2][4][4];
#pragma unroll
    for (int tt = 0; tt < 4; ++tt) { const int t = 16 * tt + fr; const float rf = 1.0f / fmaxf(fabsf(dens[t]), Fl[t]), rb = 1.0f / fmaxf(fabsf(dens[64 + t]), Fl[64 + t]);
        float s = 0.f, s2 = 0.f;
#pragma unroll
        for (int v = 0; v < 2; ++v)
#pragma unroll
            for (int i = 0; i < 4; ++i) { const float x = acc[0][v][tt][i] * rf + acc[1][v][tt][i] * rb; hv[v][tt][i] = x; s += x; s2 += x * x; }
        s += __shfl_xor(s, 16); s += __shfl_xor(s, 32); s2 += __shfl_xor(s2, 16); s2 += __shfl_xor(s2, 32);
        if (fq == 0) { red[(wave * 64 + t) * 2] = s; red[(wave * 64 + t) * 2 + 1] = s2; } }
    __syncthreads();
    { const float* hg = P.in[I_HNG] + h * 256; const bf16_t* UO = (const bf16_t*)(P.ws + WS_UO); bf16_t* A2 = (bf16_t*)(P.ws + WS_A2);
#pragma unroll
      for (int tt = 0; tt < 4; ++tt) { const int t = 16 * tt + fr; float s = 0.f, s2 = 0.f;
#pragma unroll
          for (int w = 0; w < 8; ++w) { s += red[(w * 64 + t) * 2]; s2 += red[(w * 64 + t) * 2 + 1]; }
          const float mu = s * (1.0f / 256.0f), var = fmaxf(s2 * (1.0f / 256.0f) - mu * mu, 0.f), rstd = 1.0f / sqrtf(var + EPSF);
#pragma unroll
          for (int v = 0; v < 2; ++v) { const int vf = 32 * wave + 16 * v + 4 * fq; const f32x4 g = *(const f32x4*)(hg + vf);
              const u32x2 ow = *(const u32x2*)(UO + (size_t)(t0 + t) * 1024 + h * 256 + vf); const float o[4] = {bflo(ow.x), bfhi(ow.x), bflo(ow.y), bfhi(ow.y)}; float r[4];
#pragma unroll
              for (int i = 0; i < 4; ++i) r[i] = (hv[v][tt][i] - mu) * rstd * g[i] * sigmoidf_(o[i]);
              u32x2 pk; pk.x = cvtpk(r[0], r[1]); pk.y = cvtpk(r[2], r[3]); *(u32x2*)(A2 + (size_t)(t0 + t) * 2048 + 1024 + h * 256 + vf) = pk; } } }
}
#define XB_TMO      128
#define XB_XCNT(j)  (256  + 64 * (j))
#define XB_XSUB(j)  (1280 + 64 * (j))
#define XB_XGEN(j)  (2304 + 64 * (j))
#define XB_TOP      3328
#define XB_TOPGEN   3392
#define XCD_BAR_WORDS 3456
#define XB_SPIN_CAP (1u << 18)
__device__ __forceinline__ unsigned xb_ld(unsigned* p)              { return __hip_atomic_load(p, __ATOMIC_RELAXED, __HIP_MEMORY_SCOPE_AGENT); }
__device__ __forceinline__ unsigned xb_add(unsigned* p, unsigned v) { return __hip_atomic_fetch_add(p, v, __ATOMIC_RELAXED, __HIP_MEMORY_SCOPE_AGENT); }
__device__ __forceinline__ unsigned xb_xcc_id() { return (unsigned)__builtin_amdgcn_s_getreg((3 << 11) | 20) & 0xFu; }
#define XB_SPIN(cond, bar) do { unsigned _sp = 0; while (cond) { __builtin_amdgcn_s_sleep(1); \
    if ((++_sp & 255u) == 0u) { if (xb_ld(&(bar)[XB_TMO])) break; if (_sp > XB_SPIN_CAP) { atomicAdd(&(bar)[XB_TMO], 1u); break; } } } } while (0)
struct XcdBarrier { unsigned* bar; unsigned x; volatile LAS unsigned* st; };
__device__ __forceinline__ XcdBarrier xcd_barrier_post(unsigned* bar, volatile LAS unsigned* st) {
    XcdBarrier b; b.bar = bar; b.x = xb_xcc_id(); b.st = st;
    if (threadIdx.x == 0) (void)xb_add(&bar[XB_XCNT(b.x)], 1u);
    return b;
}
__device__ __forceinline__ void xcd_barrier_complete(unsigned* bar, unsigned x, unsigned& nloc, unsigned& nx) {
    const unsigned G = gridDim.x * gridDim.y * gridDim.z;
    unsigned sum, cnt, mine, sp = 0u;
    for (;;) {
        sum = 0u; cnt = 0u; mine = 0u;
#pragma unroll
        for (unsigned j = 0; j < 16; ++j) { const unsigned c = xb_ld(&bar[XB_XCNT(j)]); sum += c; cnt += (c > 0u) ? 1u : 0u; mine = (j == x) ? c : mine; }
        if (sum == G) break;
        __builtin_amdgcn_s_sleep(1);
        if ((++sp & 255u) == 0u) { if (xb_ld(&bar[XB_TMO])) break; if (sp > XB_SPIN_CAP) { atomicAdd(&bar[XB_TMO], 1u); break; } }
    }
    nloc = mine > 0u ? mine : 1u; nx = cnt > 0u ? cnt : 1u;
}
__device__ __forceinline__ void xcd_barrier(const XcdBarrier& b) {
    asm volatile("s_waitcnt vmcnt(0)" ::: "memory");
    __syncthreads();
    if (threadIdx.x == 0) {
        unsigned* bar = b.bar;
        __builtin_amdgcn_s_waitcnt(0);
        unsigned nloc = b.st[0], nx = b.st[1];
        if (nloc == 0u) { xcd_barrier_complete(bar, b.x, nloc, nx); b.st[0] = nloc; b.st[1] = nx; }
        const unsigned old = xb_add(&bar[XB_XSUB(b.x)], 1u);
        const unsigned gen = old / nloc;
        if (old + 1u == (gen + 1u) * nloc) {
            __builtin_amdgcn_fence(__ATOMIC_RELEASE, "agent");
            asm volatile("s_waitcnt vmcnt(0)" ::: "memory");
            const unsigned og = xb_add(&bar[XB_TOP], 1u);
            const unsigned tg = og / nx;
            if (og + 1u == (tg + 1u) * nx) xb_add(&bar[XB_TOPGEN], 1u);
            else XB_SPIN(xb_ld(&bar[XB_TOPGEN]) == tg, bar);
            __builtin_amdgcn_fence(__ATOMIC_ACQUIRE, "agent");
            xb_add(&bar[XB_XGEN(b.x)], 1u);
            asm volatile("s_waitcnt vmcnt(0)" ::: "memory");
        } else {
            XB_SPIN(xb_ld(&bar[XB_XGEN(b.x)]) == gen, bar);
            __builtin_amdgcn_fence(__ATOMIC_ACQUIRE, "agent");
            asm volatile("s_waitcnt vmcnt(0)" ::: "memory");
        }
    }
    __syncthreads();
}
__device__ __forceinline__ void p7a_route(const Params& P, LAS unsigned char* lds, bool dry = false) {
    const int tid = otid(), lane = tid & 63, wave = __builtin_amdgcn_readfirstlane(tid >> 6), fr = lane & 15, fq = lane >> 4;
    const float* sumsq = (const float*)(P.ws + WS_SUMSQ); const float* BRP = (const float*)(P.ws + WS_WRP + 448 * 1024);
    int* cnt = (int*)(P.ws + WS_CTL) + (dry ? 2048 : 1024); const size_t ro = dry ? 262144 : 0; int* eid = (int*)(P.ws + WS_ROUTE + ro); float* wtok = (float*)(P.ws + WS_ROUTE + ro + 65536); int* spos = (int*)(P.ws + WS_ROUTE + ro + 131072);
    LAS float* part = (LAS float*)lds; LAS float* lgs = part + 8 * 32 * 48;
    for (int rb = blockIdx.x; rb < SEQ / 32; rb += gridDim.x) {
        const int row0 = 32 * rb;
        f32x4 acc[2][3];
#pragma unroll
        for (int a = 0; a < 2; ++a)
#pragma unroll
            for (int c = 0; c < 3; ++c) acc[a][c] = (f32x4){0.f, 0.f, 0.f, 0.f};
        LAS unsigned char* hb = lds + wave * 16640; LAS float* rs = (LAS float*)(lds + 133120);
        const f32x4* wp = (const f32x4*)(P.ws + WS_WRP) + (size_t)(64 * wave + fq) * 48 + fr;
        __syncthreads();
        if (tid < 32) { const int r = row0 + tid; float ss = 0.f;
#pragma unroll
            for (int q = 0; q < 8; ++q) { const f32x4 v = *(const f32x4*)(sumsq + (size_t)r * 32 + 4 * q); ss += (v[0] + v[1]) + (v[2] + v[3]); }
            rs[tid] = 1.0f / sqrtf(ss * (1.0f / D) + EPSF); }
        const int dcol = 256 * wave + 4 * lane;
        const f32x4 fA = *(const f32x4*)(P.in[I_N2G] + dcol) * (*(const f32x4*)((const float*)(P.ws + WS_MOD) + 8192 + dcol) + 1.0f), fS = *(const f32x4*)((const float*)(P.ws + WS_MOD) + 6144 + dcol);
        __syncthreads();
#pragma unroll
        for (int a = 0; a < 2; ++a) { f32x4 hv[16];
#pragma unroll
            for (int r = 0; r < 16; ++r) hv[r] = *(const f32x4*)(P.out + (size_t)(row0 + 16 * a + r) * D + 256 * wave + 4 * lane);
#pragma unroll
            for (int r = 0; r < 16; ++r) *(LAS f32x4*)(hb + r * 1040 + 16 * lane) = hv[r];
            if (!dry) {
#pragma unroll
                for (int r = 0; r < 16; ++r) { const f32x4 y = hv[r] * rs[16 * a + r] * fA + fS; u32x2 pk; pk.x = cvtpk(y[0], y[1]); pk.y = cvtpk(y[2], y[3]);
                    *(u32x2*)((bf16_t*)(P.ws + WS_FN) + (size_t)(row0 + 16 * a + r) * D + dcol) = pk; } }
#pragma unroll 4
            for (int j = 0; j < 16; ++j) { const f32x4 a0 = *(const LAS f32x4*)(hb + fr * 1040 + 64 * j + 16 * fq);
                f32x4 b[3];
#pragma unroll
                for (int c = 0; c < 3; ++c) b[c] = wp[(size_t)(4 * j) * 48 + 16 * c];
#pragma unroll
                for (int i = 0; i < 4; ++i)
#pragma unroll
                    for (int c = 0; c < 3; ++c) acc[a][c] = __builtin_amdgcn_mfma_f32_16x16x4f32(a0[i], b[c][i], acc[a][c], 0, 0, 0); } }
        __syncthreads();
#pragma unroll
        for (int a = 0; a < 2; ++a)
#pragma unroll
            for (int c = 0; c < 3; ++c)
#pragma unroll
                for (int i = 0; i < 4; ++i) part[(wave * 32 + 16 * a + 4 * fq + i) * 48 + 16 * c + fr] = acc[a][c][i];
        __syncthreads();
        { const int row = tid >> 4, pc = tid & 15;
#pragma unroll
          for (int c = 0; c < 3; ++c) { float s = 0.f;
#pragma unroll
              for (int w = 0; w < 8; ++w) s += part[(w * 32 + row) * 48 + 16 * c + pc];
              lgs[row * 48 + 16 * c + pc] = s; } }
        __syncthreads();
        if (tid < 32) { const int r = row0 + tid; const float rstd = rs[tid];
            float lg[4];
#pragma unroll
            for (int i = 0; i < 4; ++i) lg[i] = lgs[tid * 48 + 32 + i] * rstd + BRP[32 + i];
            int gs = 0; float gm = lg[0];
#pragma unroll
            for (int i = 1; i < 4; ++i) if (lg[i] > gm) { gm = lg[i]; gs = i; }
            float gsum = 0.f;
#pragma unroll
            for (int i = 0; i < 4; ++i) gsum += __expf(lg[i] - gm);
            const float pg = 1.0f / gsum;
            float sl[8];
#pragma unroll
            for (int i = 0; i < 8; ++i) sl[i] = lgs[tid * 48 + gs * 8 + i] * rstd + BRP[gs * 8 + i];
            int i1 = 0; float m1 = sl[0];
#pragma unroll
            for (int i = 1; i < 8; ++i) if (sl[i] > m1) { m1 = sl[i]; i1 = i; }
            int i2 = i1 == 0 ? 1 : 0; float m2 = sl[i2];
#pragma unroll
            for (int i = 0; i < 8; ++i) if (i != i1 && sl[i] > m2) { m2 = sl[i]; i2 = i; }
            const float p2 = __expf(m2 - m1); const float w1 = pg / (1.0f + p2), w2 = pg * p2 / (1.0f + p2);
            const int e1 = gs * 8 + i1, e2 = gs * 8 + i2;
            const int s1 = atomicAdd(cnt + e1, 1), s2 = atomicAdd(cnt + e2, 1);
            if (!dry) { int* ptok = (int*)(P.ws + WS_PTOK); ptok[e1 * 8192 + s1] = r; ptok[e2 * 8192 + s2] = r; }
            eid[2 * r] = e1; eid[2 * r + 1] = e2; wtok[2 * r] = w1; wtok[2 * r + 1] = w2; spos[2 * r] = s1; spos[2 * r + 1] = s2; }
    }
}
__device__ __forceinline__ void moe_tables(const Params& P, LAS int* tab) {
    __syncthreads();
    if (threadIdx.x == 0) { const int* cnt = (const int*)(P.ws + WS_CTL) + 1024; int tt = 0;
        for (int e = 0; e < NEXP; ++e) { const int c = __hip_atomic_load(cnt + e, __ATOMIC_RELAXED, __HIP_MEMORY_SCOPE_AGENT); const int nt = (c + 255) >> 8; tab[128 + e] = tt; for (int i = 0; i < nt; ++i) tab[1 + tt + i] = e; tt += nt; }
        tab[0] = tt; }
    __syncthreads();
}
__device__ __forceinline__ void p7b_scatter(const Params& P, const LAS int* tab) {
    const int tid = otid(), lane = tid & 63, wave = tid >> 6; const int gw = blockIdx.x * 8 + wave, NGW = gridDim.x * 8;
    const float* mod = (const float*)(P.ws + WS_MOD); const float* g = P.in[I_N2G]; const float* sumsq = (const float*)(P.ws + WS_SUMSQ);
    const int* eid = (const int*)(P.ws + WS_ROUTE); const int* spos = (const int*)(P.ws + WS_ROUTE + 131072); bf16_t* FNS = (bf16_t*)(P.ws + WS_FNS);
    for (int r = gw; r < SEQ; r += NGW) {
        float ss = lane < 32 ? sumsq[(size_t)r * 32 + lane] : 0.f; ss = wave_sum(ss);
        const float rstd = 1.0f / sqrtf(ss * (1.0f / D) + EPSF);
        const int e1 = eid[2 * r], e2 = eid[2 * r + 1]; const size_t sl1 = (size_t)tab[128 + e1] * 256 + spos[2 * r], sl2 = (size_t)tab[128 + e2] * 256 + spos[2 * r + 1];
        const f32x4* hr = (const f32x4*)(P.out + (size_t)r * D) + lane; u32x2* o1 = (u32x2*)(FNS + sl1 * D) + lane; u32x2* o2 = (u32x2*)(FNS + sl2 * D) + lane;
#pragma unroll
        for (int j = 0; j < 8; ++j) { const int d0 = 4 * lane + 256 * j; const f32x4 hv = hr[64 * j]; const f32x4 gg = *(const f32x4*)(g + d0), sc = *(const f32x4*)(mod + 8192 + d0), sh = *(const f32x4*)(mod + 6144 + d0);
            const f32x4 y = hv * rstd * gg * (sc + 1.0f) + sh; u32x2 w; w.x = cvtpk(y[0], y[1]); w.y = cvtpk(y[2], y[3]); o1[64 * j] = w; o2[64 * j] = w; }
    }
}
__device__ __forceinline__ void p10_final(const Params& P, const LAS int* tab, bool dry = false) {
    const int tid = otid(), lane = tid & 63, wave = tid >> 6; const int gw = blockIdx.x * 8 + wave, NGW = gridDim.x * 8;
    const float* mod = (const float*)(P.ws + WS_MOD); const float* fg = P.in[I_FG];
    const int* eid = (const int*)(P.ws + WS_ROUTE); const float* wtok = (const float*)(P.ws + WS_ROUTE + 65536); const int* spos = (const int*)(P.ws + WS_ROUTE + 131072); const bf16_t* Y = (const bf16_t*)(P.ws + WS_Y);
    for (int r = gw; r < SEQ; r += NGW) {
        const int e1 = eid[2 * r], e2 = eid[2 * r + 1]; const size_t sl1 = (size_t)tab[128 + e1] * 256 + spos[2 * r], sl2 = (size_t)tab[128 + e2] * 256 + spos[2 * r + 1];
        const float w1 = wtok[2 * r], w2 = wtok[2 * r + 1];
        f32x4* hr = (f32x4*)(P.out + (size_t)r * D) + lane; f32x4* wrp = dry ? (f32x4*)((float*)(P.ws + WS_FNS) + (size_t)r * D) + lane : hr; const u32x2* y1 = (const u32x2*)(Y + sl1 * D) + lane; const u32x2* y2 = (const u32x2*)(Y + sl2 * D) + lane;
        f32x4 v[8]; float ss = 0.f;
#pragma unroll
        for (int j = 0; j < 8; ++j) { const int d0 = 4 * lane + 256 * j; const f32x4 hv = hr[64 * j]; const f32x4 g2 = *(const f32x4*)(mod + 10240 + d0); const u32x2 a = y1[64 * j], b = y2[64 * j];
            const f32x4 ya = {bflo(a.x), bfhi(a.x), bflo(a.y), bfhi(a.y)}, yb = {bflo(b.x), bfhi(b.x), bflo(b.y), bfhi(b.y)};
            v[j] = hv + g2 * (ya * w1 + yb * w2); ss += (v[j][0] * v[j][0] + v[j][1] * v[j][1]) + (v[j][2] * v[j][2] + v[j][3] * v[j][3]); }
        const float rstd = 1.0f / sqrtf(wave_sum(ss) * (1.0f / D) + EPSF);
#pragma unroll
        for (int j = 0; j < 8; ++j) { const int d0 = 4 * lane + 256 * j; wrp[64 * j] = v[j] * rstd * *(const f32x4*)(fg + d0); }
    }
}
__device__ __forceinline__ void p10_plain(const Params& P, const float* src) {
    const int tid = otid(), lane = tid & 63, wave = tid >> 6; const int gw = blockIdx.x * 8 + wave, NGW = gridDim.x * 8; const float* fg = P.in[I_FG];
    for (int r = gw; r < SEQ; r += NGW) { const f32x4* sr = (const f32x4*)(src + (size_t)r * D) + lane; f32x4* hr = (f32x4*)(P.out + (size_t)r * D) + lane; f32x4 v[8]; float ss = 0.f;
#pragma unroll
        for (int j = 0; j < 8; ++j) { v[j] = sr[64 * j]; ss += (v[j][0] * v[j][0] + v[j][1] * v[j][1]) + (v[j][2] * v[j][2] + v[j][3] * v[j][3]); }
        const float rstd = 1.0f / sqrtf(wave_sum(ss) * (1.0f / D) + EPSF);
#pragma unroll
        for (int j = 0; j < 8; ++j) hr[64 * j] = v[j] * rstd * *(const f32x4*)(fg + 4 * lane + 256 * j); }
}
#ifndef STAGE
#define STAGE 4
#endif
#ifndef N_LAUNCHES
#define N_LAUNCHES 1
#endif
constexpr int NPHASE = 12;
__global__ void __launch_bounds__(512, 2) mk_fwd(Params P) {
    extern __shared__ __attribute__((aligned(16))) unsigned char lds_raw[];
    LAS unsigned char* lds = (LAS unsigned char*)lds_raw;
    LAS int* tab = (LAS int*)(lds + LDSCTL_OFF + 4096);
    const int lo = P.ph_lo, hi = P.ph_hi; const int G = gridDim.x, bx = blockIdx.x;
#ifndef ONLYP
#define ONLYP -1
#endif
#define IN(k) ((ONLYP < 0 || ONLYP == (k)) && lo <= (k) && (k) < hi)
#ifndef P4SEL
#define P4SEL 0
#endif
#ifndef REP_PHASE
#define REP_PHASE -1
#endif
#define NREP(k) ((k) == REP_PHASE ? 2 : 1)
    { volatile LAS unsigned* st = (volatile LAS unsigned*)(lds + LDS_BYTES - 64); if (threadIdx.x < 2) st[threadIdx.x] = 0u; __syncthreads(); }
    XcdBarrier xbar = xcd_barrier_post((unsigned*)(P.ws + WS_CTL) + 4096, (volatile LAS unsigned*)(lds + LDS_BYTES - 64));
#if N_LAUNCHES == 2
#define SEAM(k) do { if ((k) + 1 < hi) { xcd_barrier(xbar); } } while (0)
#else
#define SEAM(k) do { if ((k) + 1 < hi) { cg::this_grid().sync(); } } while (0)
#endif
    if (IN(0)) { for (int rep_ = 0; rep_ < NREP(0); ++rep_) { if (rep_) xcd_barrier(xbar);
#if STAGE >= 2
        p0_adaln(P, lds); p0_transposes(P, lds, 0, STAGE >= 4 ? TR_ITEMS_MID : TR_ITEMS_EARLY, bx * 8 + (threadIdx.x >> 6), G * 8); p0_zero_pad(P); p0_wpool_scaled(P);
#endif
        } SEAM(0); }
    if (IN(1)) { for (int rep_ = 0; rep_ < NREP(1); ++rep_) { if (rep_) xcd_barrier(xbar);
#if STAGE >= 2
        p1_router_prep(P);
        if (bx < G - 32) p1_xn(P, G - 32);
        else { pg8::Gemm g{(const bf16_t*)(P.ws + WS_WOUTT), (const bf16_t*)(P.ws + WS_WPOOLS), 2048, 256, 256}; SchedWeff S{32, bx - (G - 32)}; EpiWeff E{(bf16_t*)(P.ws + WS_WOUTT)};
            pg8::gemm_phase<EpiWeff, SchedWeff>(lds, g, S, E); }
#endif
        } SEAM(1); }
    if (IN(2)) { for (int rep_ = 0; rep_ < NREP(2); ++rep_) { if (rep_) xcd_barrier(xbar);
#if STAGE >= 2
        pg8::Gemm g{(const bf16_t*)(P.ws + WS_XN), (const bf16_t*)(P.ws + WS_WINT), 2048, 2048, 2048}; SchedG1 S{G, bx}; EpiG1 E{P.ws, P.in[I_GB]};
        pg8::gemm_phase<EpiG1, SchedG1>(lds, g, S, E);
#endif
        } SEAM(2); }
    if (IN(3)) { for (int rep_ = 0; rep_ < NREP(3); ++rep_) { if (rep_) xcd_barrier(xbar);
#if STAGE >= 2
        p3_all(P, lds);
#endif
        } SEAM(3); }
    if (IN(4)) { for (int rep_ = 0; rep_ < NREP(4); ++rep_) { if (rep_) xcd_barrier(xbar);
#if STAGE >= 2
        if (STAGE >= 3) { p4_state(P, lds, bx, rep_ > 0); }
#endif
        } SEAM(4); }
    if (IN(5)) { for (int rep_ = 0; rep_ < NREP(5); ++rep_) { if (rep_) xcd_barrier(xbar);
#if STAGE >= 3
        for (int t = bx; t < 512; t += G) p5_task(P, lds, t >> 2, t & 3);
#elif STAGE == 2
        { bf16_t* A2 = (bf16_t*)(P.ws + WS_A2); for (int i = bx * 512 + threadIdx.x; i < SEQ * 128; i += G * 512) { const int r = i >> 7, c8 = i & 127; *(u32x4*)(A2 + (size_t)r * 2048 + 1024 + 8 * c8) = (u32x4){0u, 0u, 0u, 0u}; } }
#endif
        } SEAM(5); }
    if (IN(6)) { for (int rep_ = 0; rep_ < NREP(6); ++rep_) { if (rep_) xcd_barrier(xbar);
#if STAGE >= 2
        pg8::Gemm g{(const bf16_t*)(P.ws + WS_A2), (const bf16_t*)(P.ws + WS_WOUTT), 2048, 2048, 2048}; SchedG2 S{G, bx};
        EpiG2 E{P.in[I_X], (const float*)(P.ws + WS_MOD) + 4096, P.out, (float*)(P.ws + WS_SUMSQ)};
        pg8::gemm_phase<EpiG2, SchedG2>(lds, g, S, E);
#endif
        } SEAM(6); }
    if (IN(7)) { for (int rep_ = 0; rep_ < NREP(7); ++rep_) { if (rep_) xcd_barrier(xbar);
#if STAGE >= 4
        p7a_route(P, lds, rep_ == 0 && NREP(7) == 2);
#endif
        } SEAM(7); }
    if (IN(9)) { for (int rep_ = 0; rep_ < NREP(9); ++rep_) { if (rep_) xcd_barrier(xbar);
#if STAGE >= 4
        if (rep_ == 0) moe_tables(P, tab);
        pg8::Gemm g{(const bf16_t*)(P.ws + WS_FN), (const bf16_t*)(P.ws + WS_W13T), 2048, 2048, 2048}; SchedMoEG S{G, bx, 4, 4, tab, (const int*)(P.ws + WS_PTOK), (const int*)(P.ws + WS_CTL) + 1024}; EpiUp E{(bf16_t*)(P.ws + WS_H)};
        pg8::gemm_phase<EpiUp, SchedMoEG>(lds, g, S, E);
#endif
        } SEAM(9); }
    if (IN(10)) { for (int rep_ = 0; rep_ < NREP(10); ++rep_) { if (rep_) xcd_barrier(xbar);
#if STAGE >= 4
        if (lo == 10) moe_tables(P, tab);
        pg8::Gemm g{(const bf16_t*)(P.ws + WS_H), (const bf16_t*)(P.ws + WS_W2T), 512, 512, 512}; SchedMoE S{G, bx, 8, 8, tab}; EpiDown E{(bf16_t*)(P.ws + WS_Y)};
        pg8::gemm_phase<EpiDown, SchedMoE>(lds, g, S, E);
#endif
        } SEAM(10); }
    if (IN(11)) { for (int rep_ = 0; rep_ < NREP(11); ++rep_) { if (rep_) xcd_barrier(xbar);
#if STAGE >= 4
        if (lo == 11) moe_tables(P, tab);
        p10_final(P, tab, rep_ == 0 && NREP(11) == 2);
#elif STAGE >= 2
        p10_plain(P, P.out);
#else
        p10_plain(P, P.in[I_X]);
#endif
    } }
#undef IN
#undef SEAM
}

extern "C" void kernel_launch(void* const* d_in, const int* in_sizes, int n_in, void* d_out, int out_size, void* d_ws, size_t ws_size, hipStream_t stream) {
    static int grid = 0;
    if (grid == 0) {
        if (n_in != 24 || out_size != SEQ * D || ws_size < WS_END) { fprintf(stderr, "kernel_launch: unexpected shapes (n_in %d, out %d, ws %zu < %zu)\n", n_in, out_size, ws_size, (size_t)WS_END); grid = -1; return; }
        int dev = 0, cus = 0, per_cu = 0;
        if (hipGetDevice(&dev) != hipSuccess || hipDeviceGetAttribute(&cus, hipDeviceAttributeMultiprocessorCount, dev) != hipSuccess) { grid = -1; return; }
        if (hipFuncSetAttribute((const void*)mk_fwd, hipFuncAttributeMaxDynamicSharedMemorySize, LDS_BYTES) != hipSuccess) { fprintf(stderr, "kernel_launch: hipFuncSetAttribute failed\n"); grid = -1; return; }
        if (hipOccupancyMaxActiveBlocksPerMultiprocessor(&per_cu, (const void*)mk_fwd, 512, LDS_BYTES) != hipSuccess || per_cu < 1) { fprintf(stderr, "kernel_launch: occupancy query says %d\n", per_cu); per_cu = 1; }
        (void)hipGetLastError();
        grid = cus;
        if (grid < 160) { fprintf(stderr, "kernel_launch: %d CUs is too few for this kernel's phase split\n", grid); grid = -1; return; }
    }
    if (grid < 0) return;
    (void)hipMemsetAsync((char*)d_ws + WS_CTL, 0, 1 * MiB, stream);
    Params p{};
    for (int i = 0; i < 24; ++i) p.in[i] = (const float*)d_in[i];
    p.out = (float*)d_out; p.ws = (unsigned char*)d_ws;
#if N_LAUNCHES == 2
    p.ph_lo = 0; p.ph_hi = NPHASE;
    hipLaunchKernelGGL(mk_fwd, dim3(grid), dim3(512), LDS_BYTES, stream, p);
#elif N_LAUNCHES == 1
    p.ph_lo = 0; p.ph_hi = NPHASE;
    void* args[] = {&p};
    hipError_t e = hipLaunchCooperativeKernel((const void*)mk_fwd, dim3(grid), dim3(512), args, LDS_BYTES, stream);
    if (e != hipSuccess) fprintf(stderr, "cooperative launch failed: %s (grid %d)\n", hipGetErrorString(e), grid);
#else
    for (int k = 0; k < NPHASE; ++k) { p.ph_lo = k; p.ph_hi = k + 1; hipLaunchKernelGGL(mk_fwd, dim3(grid), dim3(512), LDS_BYTES, stream, p);
#ifdef REP_PHASE
        if (k == REP_PHASE) hipLaunchKernelGGL(mk_fwd, dim3(grid), dim3(512), LDS_BYTES, stream, p);
#endif
    }
#endif
}
```

```cpp
#define STAGE 4
#define N_LAUNCHES 2
#include <hip/hip_runtime.h>
#include <hip/hip_cooperative_groups.h>
#include <cstdio>
#include <cstdint>
namespace cg = cooperative_groups;

#define LAS __attribute__((address_space(3)))
#define GAS __attribute__((address_space(1)))
typedef unsigned short bf16_t;
typedef short bf16x8 __attribute__((ext_vector_type(8)));
typedef float f32x4 __attribute__((ext_vector_type(4)));
typedef float f32x2 __attribute__((ext_vector_type(2)));
typedef unsigned u32x4 __attribute__((ext_vector_type(4)));
typedef unsigned u32x2 __attribute__((ext_vector_type(2)));
typedef __bf16 bf16x2_t __attribute__((ext_vector_type(2)));

#ifndef PATPROBE
#define PATPROBE 0
#endif
constexpr int D = 2048, SEQ = 8192, CTXL = 256, MTOT = SEQ + CTXL;
constexpr int INC = 5136, NPAD = 5376;
constexpr int NCH = SEQ / 64, NCHT = MTOT / 64;
constexpr int NEXP = 32, DEXP = 512;
constexpr float EPSF = 1e-6f;

constexpr size_t MiB = 1u << 20;
constexpr size_t WS_CTL = 0;
constexpr size_t WS_MOD = 1 * MiB;
constexpr size_t WS_GATES = 2 * MiB;
constexpr size_t WS_E = 3 * MiB;
constexpr size_t WS_BC = 3 * MiB + 288 * 1024;
constexpr size_t WS_GC = 3 * MiB + 576 * 1024;
constexpr size_t WS_NST = 4 * MiB;
constexpr size_t WS_SUMSQ = 5 * MiB;
constexpr size_t WS_ROUTE = 6 * MiB;
constexpr size_t WS_WRP = 7 * MiB;
constexpr size_t WS_WPOOLS = 8 * MiB;
constexpr size_t WS_WOUTT = 9 * MiB;
constexpr size_t WS_WINT = 17 * MiB;
constexpr size_t WS_W13T = 38 * MiB;
constexpr size_t WS_W2T = 166 * MiB;
constexpr size_t WS_XN = 230 * MiB;
constexpr size_t WS_UP = 263 * MiB;
constexpr size_t WS_UQ = 279 * MiB;
constexpr size_t WS_A2 = 230 * MiB;
constexpr size_t WS_UO = 295 * MiB;
constexpr size_t WS_UK = 311 * MiB;
constexpr size_t WS_UV = 328 * MiB;
constexpr size_t WS_QC = 345 * MiB;
constexpr size_t WS_KC = 361 * MiB;
constexpr size_t WS_KT = 378 * MiB;
constexpr size_t WS_VT = 395 * MiB;
constexpr size_t WS_VSF = 413 * MiB;
constexpr size_t WS_VSB = 431 * MiB;
constexpr size_t WS_CST = 449 * MiB;
constexpr size_t WS_Y = 449 * MiB;
constexpr size_t WS_H = 545 * MiB;
constexpr size_t WS_FNS = 295 * MiB;
constexpr size_t WS_FN = 295 * MiB;
constexpr size_t WS_PTOK = 4 * MiB;
constexpr size_t WS_END = 577 * MiB;
constexpr int MAXSLOT = 24576;

constexpr int RING_BYTES = 131072;
constexpr int LDSCTL_OFF = RING_BYTES;
constexpr int LDS_BYTES = 147456;

__device__ __forceinline__ float bf2f(unsigned short b) { return __uint_as_float((unsigned)b << 16); }
__device__ __forceinline__ unsigned cvtpk(float lo, float hi) { f32x2 v = {lo, hi}; bf16x2_t b = __builtin_convertvector(v, bf16x2_t); return __builtin_bit_cast(unsigned, b); }
__device__ __forceinline__ float bflo(unsigned w) { return __uint_as_float(w << 16); }
__device__ __forceinline__ float bfhi(unsigned w) { return __uint_as_float(w & 0xffff0000u); }
__device__ __forceinline__ float siluf(float x) { return x / (1.0f + __expf(-x)); }
__device__ __forceinline__ float sigmoidf_(float x) { return 1.0f / (1.0f + __expf(-x)); }
__device__ __forceinline__ float logsigmoidf_(float x) { return fminf(x, 0.f) - log1pf(__expf(-fabsf(x))); }
__device__ __forceinline__ float wave_sum(float v) {
#pragma unroll
    for (int o = 1; o < 64; o <<= 1) v += __shfl_xor(v, o);
    return v;
}
__device__ __forceinline__ float wave_max(float v) {
#pragma unroll
    for (int o = 1; o < 64; o <<= 1) v = fmaxf(v, __shfl_xor(v, o));
    return v;
}
__device__ __forceinline__ int otid() { int t = threadIdx.x; asm volatile("" : "+v"(t)); return t; }
#define LDS_WAIT() asm volatile("s_waitcnt lgkmcnt(0)" ::: "memory")
#define VM_WAIT() asm volatile("s_waitcnt vmcnt(0)" ::: "memory")

struct Params { const float* in[24]; float* out; unsigned char* ws; int ph_lo, ph_hi; };
enum { I_X = 0, I_C, I_CTX, I_CCTX, I_WMOD, I_BMOD, I_N1G, I_WIN, I_WCQ, I_WCK, I_GB, I_HNG, I_WPOOL, I_PSC, I_WOUT, I_N2G, I_WGRP, I_BGRP, I_WRT, I_BRT, I_W1, I_W3, I_W2, I_FG };
namespace pg8 {
constexpr int BM = 256, BK = 64, HALF = 128, HTB = HALF * BK * 2, STAGE_BYTES = 8 * HTB, NXCD = 8, WGM = 8;
__host__ __device__ __forceinline__ int lds_byte(int r, int c) { const int st = (r >> 4) * 2 + (c >> 5), rr = r & 15, cc = c & 31, ob = rr * 64 + cc * 2; return st * 1024 + (ob ^ (((ob >> 9) & 1) << 5)); }
__host__ __device__ __forceinline__ void stage_rc(int b, int& R, int& C) { const int st = b / 1024, sb = b % 1024, swz = sb ^ (((sb >> 9) & 1) << 5); R = (st >> 1) * 16 + swz / 64; C = (st & 1) * 32 + (swz % 64) / 2; }
__host__ __device__ __forceinline__ int perm32(int rho) { const int n = rho >> 4, i = rho & 15; return 8 * (i >> 2) + 4 * n + (i & 3); }

struct Unit { int am, bn, acol, ex; };
struct Gemm { const bf16_t* A; const bf16_t* Bt; int lda, ldb, K; };

__device__ __forceinline__ void static_unit(int L, int nM, int nN, int& pm, int& pn) {
    const int nwg = nM * nN; int wgid = L; { const int q = nwg / NXCD, r = nwg % NXCD, xcd = wgid % NXCD, off = wgid / NXCD; wgid = (xcd < r ? xcd * (q + 1) : r * (q + 1) + (xcd - r) * q) + off; }
    const int nig = WGM * nN, gid = wgid / nig, fm = gid * WGM, gsz = (nM - fm) < WGM ? (nM - fm) : WGM;
    pm = fm + ((wgid % nig) % gsz); pn = (wgid % nig) / gsz;
}

template <class Epi, class Sched>
__device__ __forceinline__ void gemm_phase(LAS unsigned char* lds, const Gemm g, const Sched& S, const Epi& E) {
    const int tid = otid(), wid = __builtin_amdgcn_readfirstlane(tid >> 6), lane = tid & 63, wr = wid >> 2, wc = wid & 3, fr = lane & 15, fq = lane >> 4;
    const int K = g.K, nt = K / BK;
    unsigned voffA[2], voffB[2];
#pragma unroll
    for (int i = 0; i < 2; ++i) { int R, C; stage_rc(tid * 16 + i * 8192, R, C); const int Rb = Epi::PERM ? ((R & ~31) + perm32(R & 31)) : R;
        voffA[i] = (unsigned)(R * g.lda + C) * 2u; voffB[i] = (unsigned)(Rb * g.ldb + C) * 2u; }
    const size_t kstep = (size_t)(BK * 2);
    const size_t hstepA = (size_t)HALF * g.lda * 2, hstepB = (size_t)HALF * g.ldb * 2;
    const size_t tstepA = 2 * hstepA, tstepB = 2 * hstepB;
    const unsigned ldsw = (unsigned)wid * 1024u;
    const int aoff = lds_byte(wr * 64 + fr, fq * 8), boff = lds_byte(wc * 32 + fr, fq * 8);
#define PG8_SA(b, h) (((b) * 2 + (h)) * HTB)
#define PG8_SB(b, h) ((4 + (b) * 2 + (h)) * HTB)
#define PG8_STAGE(bufoff, gbase, voff) do { _Pragma("unroll") for (int _i = 0; _i < 2; ++_i) \
        __builtin_amdgcn_global_load_lds((const unsigned*)((const char*)(gbase) + (voff)[_i]), (LAS unsigned*)(lds + (bufoff) + ldsw + _i * 8192), 16, 0, 0); } while (0)
#define PG8_STAGE_A(bufoff, gbase, hh, vv) do { if constexpr (Sched::GATHER) { PG8_STAGE(bufoff, gbase, (vv)[hh]); } else { PG8_STAGE(bufoff, (gbase) + (hh) * hstepA, voffA); } } while (0)
#define PG8_LDA(dst, b, h) do { _Pragma("unroll") for (int m = 0; m < 4; ++m) _Pragma("unroll") for (int k = 0; k < 2; ++k) dst[m][k] = *(const LAS bf16x8*)(lds + PG8_SA(b, h) + aoff + m * 2048 + k * 1024); } while (0)
#define PG8_LDB(dst, b, h) do { _Pragma("unroll") for (int n = 0; n < 2; ++n) _Pragma("unroll") for (int k = 0; k < 2; ++k) dst[n][k] = *(const LAS bf16x8*)(lds + PG8_SB(b, h) + boff + n * 2048 + k * 1024); } while (0)
#define PG8_MMA(ai, bj, At, Bt) do { __builtin_amdgcn_s_setprio(1); _Pragma("unroll") for (int m = 0; m < 4; ++m) _Pragma("unroll") for (int n = 0; n < 2; ++n) _Pragma("unroll") for (int k = 0; k < 2; ++k) \
        acc[ai][bj][m][n] = __builtin_amdgcn_mfma_f32_16x16x32_bf16(Bt[n][k], At[m][k], acc[ai][bj][m][n], 0, 0, 0); __builtin_amdgcn_s_setprio(0); } while (0)
#define PG8_WAIT_V(n) asm volatile("s_waitcnt vmcnt(" #n ")" ::: "memory")
#define PG8_WAIT_L(n) asm volatile("s_waitcnt lgkmcnt(" #n ")" ::: "memory")
#define PG8_BAR __builtin_amdgcn_s_barrier()
#define PG8_SCHED __builtin_amdgcn_sched_barrier(0)
    Unit cur, nxt; int ui = 0;
    if (!S.next(0, cur)) return;
    unsigned vaC[2][2], vaN[2][2];
    int gR[2], gC[2];
#pragma unroll
    for (int i = 0; i < 2; ++i) stage_rc(tid * 16 + i * 8192, gR[i], gC[i]);
    if constexpr (Sched::GATHER) {
#pragma unroll
        for (int hh = 0; hh < 2; ++hh)
#pragma unroll
            for (int i = 0; i < 2; ++i) vaC[hh][i] = (unsigned)(S.arow(cur, hh * HALF + gR[i]) * g.lda + gC[i]) * 2u;
    }
    f32x4 acc[2][2][4][2];
#pragma unroll
    for (int a = 0; a < 2; ++a)
#pragma unroll
        for (int b = 0; b < 2; ++b)
#pragma unroll
            for (int m = 0; m < 4; ++m)
#pragma unroll
                for (int n = 0; n < 2; ++n) acc[a][b][m][n] = (f32x4){0.f, 0.f, 0.f, 0.f};
    bf16x8 At[4][2], B0[2][2], B1[2][2];
    const char* cA = Sched::GATHER ? (const char*)g.A : (const char*)g.A + (size_t)cur.am * tstepA + (size_t)cur.acol * 2; const char* cB = (const char*)g.Bt + (size_t)cur.bn * tstepB;
    PG8_STAGE(PG8_SB(0, 0), cB, voffB); PG8_STAGE(PG8_SB(0, 1), cB + hstepB, voffB); PG8_STAGE_A(PG8_SA(0, 0), cA, 0, vaC); PG8_STAGE_A(PG8_SA(0, 1), cA, 1, vaC);
    if (wr == 1) PG8_BAR;
    PG8_WAIT_V(2); PG8_BAR;
    PG8_STAGE(PG8_SB(1, 0), cB + kstep, voffB); PG8_STAGE_A(PG8_SA(1, 0), cA + kstep, 0, vaC); PG8_STAGE(PG8_SB(1, 1), cB + hstepB + kstep, voffB);
    PG8_WAIT_V(6); PG8_BAR;
    for (;;) {
        const bool has_next = S.next(ui + 1, nxt);
        if constexpr (Sched::GATHER) {
#pragma unroll
            for (int hh = 0; hh < 2; ++hh)
#pragma unroll
                for (int i = 0; i < 2; ++i) vaN[hh][i] = has_next ? (unsigned)(S.arow(nxt, hh * HALF + gR[i]) * g.lda + gC[i]) * 2u : vaC[hh][i];
        }
        const char* nA = Sched::GATHER ? cA : (has_next ? (const char*)g.A + (size_t)nxt.am * tstepA + (size_t)nxt.acol * 2 : cA); const char* nB = has_next ? (const char*)g.Bt + (size_t)nxt.bn * tstepB : cB;
#pragma unroll 1
        for (int t = 0; t < nt; t += 2) {
            const bool last = (t == nt - 2);
            const char* a1 = cA + (size_t)(t + 1) * kstep;
            const char* a2 = last ? nA : cA + (size_t)(t + 2) * kstep; const char* b2 = last ? nB : cB + (size_t)(t + 2) * kstep;
            const char* a3 = a2 + kstep; const char* b3 = b2 + kstep;
            PG8_LDB(B0, 0, 0); PG8_LDB(B1, 0, 1); PG8_SCHED; PG8_LDA(At, 0, 0); PG8_STAGE_A(PG8_SA(1, 1), a1, 1, vaC);
            PG8_WAIT_V(8); PG8_WAIT_L(0); PG8_BAR; PG8_MMA(0, 0, At, B0); PG8_MMA(0, 1, At, B1); PG8_BAR; PG8_SCHED;
            PG8_LDA(At, 0, 1); PG8_STAGE(PG8_SB(0, 0), b2, voffB); PG8_STAGE(PG8_SB(0, 1), b2 + hstepB, voffB); if (last) { PG8_STAGE_A(PG8_SA(0, 0), a2, 0, vaN); } else { PG8_STAGE_A(PG8_SA(0, 0), a2, 0, vaC); }
            PG8_WAIT_V(8); PG8_WAIT_L(0); PG8_BAR; PG8_MMA(1, 0, At, B0); PG8_MMA(1, 1, At, B1); PG8_BAR; PG8_SCHED;
            PG8_LDB(B0, 1, 0); PG8_LDB(B1, 1, 1); PG8_SCHED; PG8_LDA(At, 1, 0); if (last) { PG8_STAGE_A(PG8_SA(0, 1), a2, 1, vaN); } else { PG8_STAGE_A(PG8_SA(0, 1), a2, 1, vaC); }
            PG8_WAIT_V(8); PG8_WAIT_L(0); PG8_BAR; PG8_MMA(0, 0, At, B0); PG8_MMA(0, 1, At, B1); PG8_BAR; PG8_SCHED;
            PG8_LDA(At, 1, 1); PG8_STAGE(PG8_SB(1, 0), b3, voffB); PG8_STAGE(PG8_SB(1, 1), b3 + hstepB, voffB); if (last) { PG8_STAGE_A(PG8_SA(1, 0), a3, 0, vaN); } else { PG8_STAGE_A(PG8_SA(1, 0), a3, 0, vaC); }
            PG8_WAIT_V(8); PG8_WAIT_L(0); PG8_BAR; PG8_MMA(1, 0, At, B0); PG8_MMA(1, 1, At, B1); PG8_BAR; PG8_SCHED;
        }
        if (wr == 0) PG8_BAR;
        E(acc, cur, wr, wc, fr, fq);
        if (!has_next) break;
#pragma unroll
        for (int a = 0; a < 2; ++a)
#pragma unroll
            for (int b = 0; b < 2; ++b)
#pragma unroll
                for (int m = 0; m < 4; ++m)
#pragma unroll
                    for (int n = 0; n < 2; ++n) acc[a][b][m][n] = (f32x4){0.f, 0.f, 0.f, 0.f};
        cur = nxt; cA = nA; cB = nB; ++ui;
        if constexpr (Sched::GATHER) {
#pragma unroll
            for (int hh = 0; hh < 2; ++hh)
#pragma unroll
                for (int i = 0; i < 2; ++i) vaC[hh][i] = vaN[hh][i];
        }
        if (wr == 1) PG8_BAR;
    }
    PG8_WAIT_V(0);
    PG8_BAR;
#undef PG8_SA
#undef PG8_SB
#undef PG8_STAGE
#undef PG8_STAGE_A
#undef PG8_LDA
#undef PG8_LDB
#undef PG8_MMA
#undef PG8_WAIT_V
#undef PG8_WAIT_L
#undef PG8_BAR
#undef PG8_SCHED
}
}
using pg8::Unit;
struct SchedG1 { static constexpr bool GATHER = false; int G, c;
    __device__ __forceinline__ bool next(int i, Unit& u) const { const int L = i * G + c; if (L >= 681) return false;
        if (L < 672) { int pm, pn; pg8::static_unit(L, 32, 21, pm, pn); u.am = pm; u.bn = pn; } else { u.am = 32; u.bn = 12 + (L - 672); }
        u.acol = 0; u.ex = 0; return true; } };
struct EpiG1 { static constexpr bool PERM = true;
    unsigned char* ws; const float* gate_bias;
    __device__ __forceinline__ void operator()(const f32x4 (&acc)[2][2][4][2], const Unit& u, int wr, int wc, int fr, int fq) const {
        const int row0 = u.am * 256 + wr * 64 + fr; const int seg = u.bn >> 2;
        if (seg < 5) {
            const size_t so = seg == 0 ? WS_UP : seg == 1 ? WS_UQ : seg == 2 ? WS_UO : seg == 3 ? WS_UK : WS_UV;
            bf16_t* base = (bf16_t*)(ws + so); const int col0 = (u.bn & 3) * 256 + wc * 32 + 8 * fq;
#pragma unroll
            for (int ai = 0; ai < 2; ++ai)
#pragma unroll
                for (int m = 0; m < 4; ++m) { bf16_t* rowp = base + (size_t)(row0 + ai * 128 + m * 16) * 1024 + col0;
#pragma unroll
                    for (int bj = 0; bj < 2; ++bj) { const f32x4 v0 = acc[ai][bj][m][0], v1 = acc[ai][bj][m][1];
                        u32x4 w; w.x = cvtpk(v0[0], v0[1]); w.y = cvtpk(v0[2], v0[3]); w.z = cvtpk(v1[0], v1[1]); w.w = cvtpk(v1[2], v1[3]);
                        *(u32x4*)(rowp + bj * 128) = w; } }
        } else {
            if (wc == 0 && fq < 2) { float* G = (float*)(ws + WS_GATES);
                const f32x4 b0 = *(const f32x4*)(gate_bias + 8 * fq), b1 = *(const f32x4*)(gate_bias + 8 * fq + 4);
#pragma unroll
                for (int ai = 0; ai < 2; ++ai)
#pragma unroll
                    for (int m = 0; m < 4; ++m) { float* rowp = G + (size_t)(row0 + ai * 128 + m * 16) * 16 + 8 * fq;
                        *(f32x4*)(rowp) = acc[ai][0][m][0] + b0; *(f32x4*)(rowp + 4) = acc[ai][0][m][1] + b1; } }
        }
    } };
struct SchedWeff { static constexpr bool GATHER = false; int G, c;
    __device__ __forceinline__ bool next(int i, Unit& u) const { if (c < 0) return false; const int L = i * G + c; if (L >= 32) return false;
        u.am = L >> 2; u.bn = L & 3; u.acol = (L & 3) * 256; u.ex = 0; return true; } };
struct EpiWeff { static constexpr bool PERM = true;
    bf16_t* W;
    __device__ __forceinline__ void operator()(const f32x4 (&acc)[2][2][4][2], const Unit& u, int wr, int wc, int fr, int fq) const {
        const int row0 = u.am * 256 + wr * 64 + fr; const int col0 = u.bn * 256 + wc * 32 + 8 * fq;
#pragma unroll
        for (int ai = 0; ai < 2; ++ai)
#pragma unroll
            for (int m = 0; m < 4; ++m) { bf16_t* rowp = W + (size_t)(row0 + ai * 128 + m * 16) * 2048 + col0;
#pragma unroll
                for (int bj = 0; bj < 2; ++bj) { const f32x4 v0 = acc[ai][bj][m][0], v1 = acc[ai][bj][m][1];
                    u32x4 w; w.x = cvtpk(v0[0], v0[1]); w.y = cvtpk(v0[2], v0[3]); w.z = cvtpk(v1[0], v1[1]); w.w = cvtpk(v1[2], v1[3]);
                    *(u32x4*)(rowp + bj * 128) = w; } }
    } };
struct SchedG2 { static constexpr bool GATHER = false; int G, c;
    __device__ __forceinline__ bool next(int i, Unit& u) const { const int L = i * G + c; if (L >= 256) return false;
        int pm, pn; pg8::static_unit(L, 32, 8, pm, pn); u.am = pm; u.bn = pn; u.acol = 0; u.ex = 0; return true; } };
struct EpiG2 { static constexpr bool PERM = false;
    const float* x; const float* g1; float* out; float* sumsq;
    __device__ __forceinline__ void operator()(const f32x4 (&acc)[2][2][4][2], const Unit& u, int wr, int wc, int fr, int fq) const {
        const int row0 = u.am * 256 + wr * 64 + fr, col0 = u.bn * 256 + wc * 32 + 4 * fq;
        f32x4 gv[2][2];
#pragma unroll
        for (int bj = 0; bj < 2; ++bj)
#pragma unroll
            for (int n = 0; n < 2; ++n) gv[bj][n] = *(const f32x4*)(g1 + col0 + bj * 128 + n * 16);
#pragma unroll
        for (int ai = 0; ai < 2; ++ai)
#pragma unroll
            for (int m = 0; m < 4; ++m) { const int row = row0 + ai * 128 + m * 16; const size_t off = (size_t)row * 2048 + col0; float ss = 0.f;
#pragma unroll
                for (int bj = 0; bj < 2; ++bj)
#pragma unroll
                    for (int n = 0; n < 2; ++n) { const f32x4 xv = *(const f32x4*)(x + off + bj * 128 + n * 16); const f32x4 h = xv + gv[bj][n] * acc[ai][bj][m][n];
                        *(f32x4*)(out + off + bj * 128 + n * 16) = h; ss += (h[0] * h[0] + h[1] * h[1]) + (h[2] * h[2] + h[3] * h[3]); }
                ss += __shfl_xor(ss, 16); ss += __shfl_xor(ss, 32);
                if (fq == 0) sumsq[(size_t)row * 32 + u.bn * 4 + wc] = ss; }
    } };
struct SchedMoE { static constexpr bool GATHER = false; int G, c, NN, btpe; const LAS int* tab;
    __device__ __forceinline__ bool next(int i, Unit& u) const { const int L = i * G + c; const int nt = tab[0]; if (L >= nt * NN) return false;
        const int tau = L / NN, pn = L - tau * NN; const int e = tab[1 + tau]; u.am = tau; u.bn = e * btpe + pn; u.acol = 0; u.ex = pn; return true; } };
struct SchedMoEG { static constexpr bool GATHER = true; int G, c, NN, btpe; const LAS int* tab; const int* ptok; const int* cnt;
    __device__ __forceinline__ bool next(int i, Unit& u) const { const int L = i * G + c; const int nt = tab[0]; if (L >= nt * NN) return false;
        const int tau = L / NN, pn = L - tau * NN; const int e = tab[1 + tau]; u.am = tau; u.bn = e * btpe + pn; u.acol = e; u.ex = pn; return true; }
    __device__ __forceinline__ int arow(const Unit& u, int r) const { const int e = u.acol; const int pos = (u.am - tab[128 + e]) * 256 + r; return pos < cnt[e] ? ptok[e * 8192 + pos] : 0; } };
struct EpiUp { static constexpr bool PERM = true;
    bf16_t* H;
    __device__ __forceinline__ void operator()(const f32x4 (&acc)[2][2][4][2], const Unit& u, int wr, int wc, int fr, int fq) const {
        const int row0 = u.am * 256 + wr * 64 + fr; const int col0 = u.ex * 128 + wc * 16 + 4 * fq;
#pragma unroll
        for (int ai = 0; ai < 2; ++ai)
#pragma unroll
            for (int m = 0; m < 4; ++m) { bf16_t* rowp = H + (size_t)(row0 + ai * 128 + m * 16) * 512 + col0;
#pragma unroll
                for (int bj = 0; bj < 2; ++bj) { const f32x4 v0 = acc[ai][bj][m][0], v1 = acc[ai][bj][m][1];
                    u32x2 w; w.x = cvtpk(siluf(v0[0]) * v0[1], siluf(v0[2]) * v0[3]); w.y = cvtpk(siluf(v1[0]) * v1[1], siluf(v1[2]) * v1[3]);
                    *(u32x2*)(rowp + bj * 64) = w; } }
    } };
struct EpiDown { static constexpr bool PERM = true;
    bf16_t* Y;
    __device__ __forceinline__ void operator()(const f32x4 (&acc)[2][2][4][2], const Unit& u, int wr, int wc, int fr, int fq) const {
        const int row0 = u.am * 256 + wr * 64 + fr; const int col0 = u.ex * 256 + wc * 32 + 8 * fq;
#pragma unroll
        for (int ai = 0; ai < 2; ++ai)
#pragma unroll
            for (int m = 0; m < 4; ++m) { bf16_t* rowp = Y + (size_t)(row0 + ai * 128 + m * 16) * 2048 + col0;
#pragma unroll
                for (int bj = 0; bj < 2; ++bj) { const f32x4 v0 = acc[ai][bj][m][0], v1 = acc[ai][bj][m][1];
                    u32x4 w; w.x = cvtpk(v0[0], v0[1]); w.y = cvtpk(v0[2], v0[3]); w.z = cvtpk(v1[0], v1[1]); w.w = cvtpk(v1[2], v1[3]);
                    *(u32x4*)(rowp + bj * 128) = w; } }
    } };
__device__ __forceinline__ void p0_adaln(const Params& P, LAS unsigned char* lds) {
    const int tid = otid();
    LAS float* sc = (LAS float*)lds; LAS float* scc = sc + 2048; LAS float* red = scc + 2048; LAS float* red2 = red + 42 * 48;
    const float* c = P.in[I_C]; const float* cc = P.in[I_CCTX]; const float* wmod = P.in[I_WMOD]; const float* bmod = P.in[I_BMOD];
    float* mod = (float*)(P.ws + WS_MOD); float* modc = mod + 16384;
    for (int i = tid; i < 2048; i += 512) { sc[i] = siluf(c[i]); scc[i] = siluf(cc[i]); }
    __syncthreads();
    for (int cb = blockIdx.x; cb < 256; cb += gridDim.x) {
        const int n0 = 48 * cb; const bool has_ctx = n0 < 4096;
        if (tid < 504) { const int col4 = tid % 12, rg = tid / 12;
            const f32x4* wp = (const f32x4*)(wmod + n0) + col4;
            f32x4 a = {0.f, 0.f, 0.f, 0.f}, a2 = {0.f, 0.f, 0.f, 0.f};
#pragma unroll 7
            for (int k = rg; k < 2048; k += 42) { const f32x4 w = wp[(size_t)k * 3072]; a += w * sc[k]; if (has_ctx) a2 += w * scc[k]; }
            *(LAS f32x4*)(red + rg * 48 + col4 * 4) = a; *(LAS f32x4*)(red2 + rg * 48 + col4 * 4) = a2; }
        __syncthreads();
        if (tid < 48) { float s = 0.f; for (int r = 0; r < 42; ++r) s += red[r * 48 + tid]; mod[n0 + tid] = s + bmod[n0 + tid]; }
        else if (has_ctx && tid >= 64 && tid < 112) { const int t = tid - 64; if (n0 + t < 4096) { float s = 0.f; for (int r = 0; r < 42; ++r) s += red2[r * 48 + t]; modc[n0 + t] = s + bmod[n0 + t]; } }
        __syncthreads();
    }
}
struct TrItem { const float* src; bf16_t* dst; int K, N, rmul; const float* nscale; bool ok; };
constexpr int I_IN = 32 * 161, I_OUT = 32 * 64, I_PL = 4 * 32, I_E13 = 32 * 16, I_E2 = 8 * 64;
constexpr int B_OUT = I_IN, B_PL = B_OUT + I_OUT, B_W1 = B_PL + I_PL, B_W3 = B_W1 + 32 * I_E13, B_W2 = B_W3 + 32 * I_E13, B_END = B_W2 + 32 * I_E2;
__device__ __forceinline__ void tr_decode(const Params& P, int it, int lane, const float*& W, bf16_t*& WT, int& K, int& N, int& row_off, int& rmul, int& item) {
    if (it < B_OUT) { W = P.in[I_WIN]; K = 2048; N = INC; WT = (bf16_t*)(P.ws + WS_WINT); row_off = 0; rmul = 1; item = it; }
    else if (it < B_W1) { W = P.in[I_WOUT]; K = 2048; N = 2048; WT = (bf16_t*)(P.ws + WS_WOUTT); row_off = 0; rmul = 1; item = it - B_OUT; }
    else if (it < B_W3) { const int r = it - B_W1, e = r / I_E13; W = P.in[I_W1] + (size_t)e * 2048 * 512; K = 2048; N = 512; WT = (bf16_t*)(P.ws + WS_W13T) + (size_t)e * 1024 * 2048; row_off = 0; rmul = 2; item = r - e * I_E13; }
    else if (it < B_W2) { const int r = it - B_W3, e = r / I_E13; W = P.in[I_W3] + (size_t)e * 2048 * 512; K = 2048; N = 512; WT = (bf16_t*)(P.ws + WS_W13T) + (size_t)e * 1024 * 2048; row_off = 1; rmul = 2; item = r - e * I_E13; }
    else { const int r = it - B_W2, e = r / I_E2; W = P.in[I_W2] + (size_t)e * 512 * 2048; K = 512; N = 2048; WT = (bf16_t*)(P.ws + WS_W2T) + (size_t)e * 2048 * 512; row_off = 0; rmul = 1; item = r - e * I_E2; }
}
__device__ __forceinline__ void tr_load(const Params& P, int it, int lane, f32x4 (&v)[8]) {
    const float* W; bf16_t* WT; int K, N, row_off, rmul, item; tr_decode(P, it, lane, W, WT, K, N, row_off, rmul, item);
    const int nblk = (N + 31) >> 5, kb = item / nblk, nb = item - kb * nblk, k0 = 64 * kb, n0 = 32 * nb; const int nn = n0 + 4 * (lane & 7); const bool ok = nn < N;
#pragma unroll
    for (int i = 0; i < 8; ++i) { const int kk = 8 * i + (lane >> 3); v[i] = ok ? *(const f32x4*)(W + (size_t)(k0 + kk) * N + nn) : (f32x4){0.f, 0.f, 0.f, 0.f}; }
}
__device__ __forceinline__ void tr_store(const Params& P, int it, int lane, const f32x4 (&v)[8], LAS float* scr) {
    const float* W; bf16_t* WT; int K, N, row_off, rmul, item; tr_decode(P, it, lane, W, WT, K, N, row_off, rmul, item);
    const int nblk = (N + 31) >> 5, kb = item / nblk, nb = item - kb * nblk, k0 = 64 * kb, n0 = 32 * nb; const int c4 = lane & 7;
#pragma unroll
    for (int i = 0; i < 8; ++i) { const int kk = 8 * i + (lane >> 3); LAS float* d = scr + kk * 33 + 4 * c4; d[0] = v[i][0]; d[1] = v[i][1]; d[2] = v[i][2]; d[3] = v[i][3]; }
    LDS_WAIT(); asm volatile("" ::: "memory");
    const int cch = lane & 7;
#pragma unroll
    for (int j = 0; j < 4; ++j) { const int n = (lane >> 3) + 8 * j; const LAS float* s = scr + (8 * cch) * 33 + n;
        u32x4 o; o.x = cvtpk(s[0 * 33], s[1 * 33]); o.y = cvtpk(s[2 * 33], s[3 * 33]); o.z = cvtpk(s[4 * 33], s[5 * 33]); o.w = cvtpk(s[6 * 33], s[7 * 33]);
        *(u32x4*)(WT + (size_t)(row_off + (n0 + n) * rmul) * K + k0 + 8 * cch) = o; }
    LDS_WAIT(); asm volatile("" ::: "memory");
}
__device__ __forceinline__ void p0_transposes(const Params& P, LAS unsigned char* lds, int lo_item, int hi_item, int gw, int NGW) {
    const int tid = otid(), lane = tid & 63, wave = __builtin_amdgcn_readfirstlane(tid >> 6);
    LAS float* scr = (LAS float*)(lds + 32768 + wave * 8704);
    if (hi_item > B_END) hi_item = B_END;
    int it = lo_item + gw; if (it >= hi_item) return;
    if (it >= B_PL && it < B_W1) it += NGW * ((B_W1 - it + NGW - 1) / NGW);
    if (it >= hi_item) return;
    f32x4 va[8], vb[8];
    tr_load(P, it, lane, va);
    for (;;) {
        int nx = it + NGW; if (nx >= B_PL && nx < B_W1) nx += NGW * ((B_W1 - nx + NGW - 1) / NGW);
        const bool h1 = nx < hi_item; if (h1) tr_load(P, nx, lane, vb);
        tr_store(P, it, lane, va, scr); if (!h1) break; it = nx;
        nx = it + NGW; if (nx >= B_PL && nx < B_W1) nx += NGW * ((B_W1 - nx + NGW - 1) / NGW);
        const bool h2 = nx < hi_item; if (h2) tr_load(P, nx, lane, va);
        tr_store(P, it, lane, vb, scr); if (!h2) break; it = nx;
    }
}
__device__ __forceinline__ int moe_run_item(int r, int kbi, int wave) {
    if (r < 512) { const int m = r >> 8, rr = r & 255, e = rr >> 3, q = rr & 7, nb = (q >> 2) * 8 + wave, kb = (q & 3) * 8 + kbi; return (m == 0 ? B_W1 : B_W3) + e * I_E13 + kb * 16 + nb; }
    const int r2 = r - 512, e = r2 >> 3, nb = (r2 & 7) * 8 + wave; return B_W2 + e * I_E2 + kbi * 64 + nb;
}
__device__ __forceinline__ void p0_moe_weights(const Params& P, LAS unsigned char* lds) {
    const int tid = otid(), lane = tid & 63, wave = __builtin_amdgcn_readfirstlane(tid >> 6);
    LAS float* scr = (LAS float*)(lds + 32768 + wave * 8704);
    for (int r = blockIdx.x; r < 768; r += gridDim.x) {
        f32x4 va[8], vb[8];
        tr_load(P, moe_run_item(r, 0, wave), lane, va);
#pragma unroll 1
        for (int kbi = 0; kbi < 8; kbi += 2) {
            tr_load(P, moe_run_item(r, kbi + 1, wave), lane, vb);
            tr_store(P, moe_run_item(r, kbi, wave), lane, va, scr);
            if (kbi + 2 < 8) tr_load(P, moe_run_item(r, kbi + 2, wave), lane, va);
            tr_store(P, moe_run_item(r, kbi + 1, wave), lane, vb, scr);
        }
    }
}
constexpr int TR_ITEMS_EARLY = 32 * 161 + 32 * 64 + 4 * 32;
constexpr int TR_ITEMS_ALL = TR_ITEMS_EARLY + 64 * 512 + 32 * 512;
#ifndef TR_SPLIT_PCT
#define TR_SPLIT_PCT 50
#endif
constexpr int TR_ITEMS_MID = TR_ITEMS_EARLY + (int)((long)(TR_ITEMS_ALL - TR_ITEMS_EARLY) * TR_SPLIT_PCT / 100);
__device__ __forceinline__ void p0_wpool_scaled(const Params& P) {
    const float* wp = P.in[I_WPOOL]; const float* ps = P.in[I_PSC]; u32x2* o = (u32x2*)(P.ws + WS_WPOOLS);
    for (int i = blockIdx.x * 512 + threadIdx.x; i < 65536; i += gridDim.x * 512) { const f32x4 w = *(const f32x4*)(wp + (size_t)4 * i); const int g = i >> 14, d0 = (4 * i) & 255; const f32x4 sc = *(const f32x4*)(ps + g * 256 + d0);
        const f32x4 y = w * sc; u32x2 r; r.x = cvtpk(y[0], y[1]); r.y = cvtpk(y[2], y[3]); o[i] = r; }
}
__device__ __forceinline__ void p0_zero_pad(const Params& P) {
    u32x4* z = (u32x4*)((bf16_t*)(P.ws + WS_WINT) + (size_t)5152 * 2048); const int n = (NPAD - 5152) * 2048 / 8;
    for (int i = blockIdx.x * 512 + threadIdx.x; i < n; i += gridDim.x * 512) z[i] = (u32x4){0u, 0u, 0u, 0u};
}
__device__ __forceinline__ void p1_router_prep(const Params& P) {
    const int tid = otid(), lane = tid & 63, wave = tid >> 6;
    const float* mod = (const float*)(P.ws + WS_MOD); const float* g = P.in[I_N2G]; const float* wg = P.in[I_WGRP]; const float* wr = P.in[I_WRT];
    float* WRP = (float*)(P.ws + WS_WRP); float* BRP = (float*)(P.ws + WS_WRP + 448 * 1024);
    for (int idx = blockIdx.x * 512 + tid; idx < 2048 * 48; idx += gridDim.x * 512) { const int k = idx / 48, c = idx - 48 * k;
        const float w = c < 32 ? wr[k * 32 + c] : c < 36 ? wg[k * 4 + c - 32] : 0.f;
        WRP[(size_t)((k >> 2) * 48 + c) * 4 + (k & 3)] = w * g[k] * (1.0f + mod[8192 + k]); }
    if (wave == 0) for (int c = blockIdx.x; c < 48; c += gridDim.x) { float s = 0.f;
        if (c < 36) { for (int k = lane; k < 2048; k += 64) s += mod[6144 + k] * (c < 32 ? wr[k * 32 + c] : wg[k * 4 + c - 32]); s = wave_sum(s) + (c < 32 ? P.in[I_BRT][c] : P.in[I_BGRP][c - 32]); }
        if (lane == 0) BRP[c] = s; }
}
__device__ __forceinline__ void p1_xn(const Params& P, int nwg) {
    const int tid = otid(), lane = tid & 63, wave = tid >> 6;
    const int gw = blockIdx.x * 8 + wave, NGW = nwg * 8;
    const float* mod = (const float*)(P.ws + WS_MOD); const float* modc = mod + 16384; const float* g = P.in[I_N1G];
    bf16_t* XN = (bf16_t*)(P.ws + WS_XN);
    for (int pass = 0; pass < 2; ++pass) {
        const float* sh = pass == 0 ? mod : modc; const float* scl = pass == 0 ? mod + 2048 : modc + 2048;
        const float* src = pass == 0 ? P.in[I_X] : P.in[I_CTX]; const int nrows = pass == 0 ? SEQ : CTXL; const int rbase = pass == 0 ? 0 : SEQ;
        if (gw >= nrows) continue;
        f32x4 a[8], s[8];
#pragma unroll
        for (int j = 0; j < 8; ++j) { const int d0 = 4 * lane + 256 * j; const f32x4 gg = *(const f32x4*)(g + d0), sv = *(const f32x4*)(scl + d0); a[j] = gg * (sv + 1.0f); s[j] = *(const f32x4*)(sh + d0); }
        for (int r = gw; r < nrows; r += 2 * NGW) {
            const int r2 = r + NGW; const bool h2 = r2 < nrows; const int rr2 = h2 ? r2 : r;
            const f32x4* xr = (const f32x4*)(src + (size_t)r * D) + lane; const f32x4* xq = (const f32x4*)(src + (size_t)rr2 * D) + lane; f32x4 v[8], w[8]; float ss = 0.f, st = 0.f;
#pragma unroll
            for (int j = 0; j < 8; ++j) { v[j] = xr[64 * j]; w[j] = xq[64 * j]; }
#pragma unroll
            for (int j = 0; j < 8; ++j) { ss += (v[j][0] * v[j][0] + v[j][1] * v[j][1]) + (v[j][2] * v[j][2] + v[j][3] * v[j][3]); st += (w[j][0] * w[j][0] + w[j][1] * w[j][1]) + (w[j][2] * w[j][2] + w[j][3] * w[j][3]); }
            const float rstd = 1.0f / sqrtf(wave_sum(ss) * (1.0f / D) + EPSF), rstd2 = 1.0f / sqrtf(wave_sum(st) * (1.0f / D) + EPSF);
            u32x2* o = (u32x2*)(XN + (size_t)(rbase + r) * D) + lane; u32x2* o2 = (u32x2*)(XN + (size_t)(rbase + rr2) * D) + lane;
#pragma unroll
            for (int j = 0; j < 8; ++j) { const f32x4 y = v[j] * rstd * a[j] + s[j]; u32x2 pk; pk.x = cvtpk(y[0], y[1]); pk.y = cvtpk(y[2], y[3]); o[64 * j] = pk; }
            if (h2) {
#pragma unroll
                for (int j = 0; j < 8; ++j) { const f32x4 y = w[j] * rstd2 * a[j] + s[j]; u32x2 pk; pk.x = cvtpk(y[0], y[1]); pk.y = cvtpk(y[2], y[3]); o2[64 * j] = pk; } }
        }
    }
}
__device__ __forceinline__ void p3_qk_task(const Params& P, int isk, int jp, int h) {
    const int tid = otid(), o = tid >> 6, f4 = tid & 63;
    const bf16_t* U = (const bf16_t*)(P.ws + (isk ? WS_UK : WS_UQ)); const float* wc = P.in[isk ? I_WCK : I_WCQ];
    const int f0 = h * 256 + 4 * f4;
    const f32x4 w0 = *(const f32x4*)(wc + f0), w1 = *(const f32x4*)(wc + 1024 + f0), w2 = *(const f32x4*)(wc + 2048 + f0);
    const float osc = isk ? 1.0f : 0.0625f;
    u32x2 raw[2][10];
#pragma unroll
    for (int q = 0; q < 2; ++q) { const int j = 2 * jp + q; const int t0 = 64 * j, seq_lo = j < 128 ? 0 : SEQ, seq_hi = j < 128 ? SEQ : MTOT;
#pragma unroll
        for (int i = 0; i < 10; ++i) { const int t = t0 + 8 * o - 1 + i; raw[q][i] = (t >= seq_lo && t < seq_hi) ? *(const u32x2*)(U + (size_t)t * 1024 + f0) : (u32x2){0u, 0u}; } }
    bf16_t* R = (bf16_t*)(P.ws + (isk ? WS_KC : WS_QC)); bf16_t* KT = (bf16_t*)(P.ws + WS_KT);
#pragma unroll
    for (int q = 0; q < 2; ++q) { const int j = 2 * jp + q; const int t0 = 64 * j;
        float outv[8][4];
#pragma unroll
        for (int i = 0; i < 8; ++i) {
            const f32x4 a = {bflo(raw[q][i].x), bfhi(raw[q][i].x), bflo(raw[q][i].y), bfhi(raw[q][i].y)}, b = {bflo(raw[q][i + 1].x), bfhi(raw[q][i + 1].x), bflo(raw[q][i + 1].y), bfhi(raw[q][i + 1].y)},
                        c = {bflo(raw[q][i + 2].x), bfhi(raw[q][i + 2].x), bflo(raw[q][i + 2].y), bfhi(raw[q][i + 2].y)};
            const f32x4 s = a * w0 + b * w1 + c * w2;
#pragma unroll
            for (int e = 0; e < 4; ++e) outv[i][e] = siluf(s[e]) * osc;
        }
#pragma unroll
        for (int i = 0; i < 8; ++i) { u32x2 w; w.x = cvtpk(outv[i][0], outv[i][1]); w.y = cvtpk(outv[i][2], outv[i][3]); *(u32x2*)(R + (size_t)(t0 + 8 * o + i) * 1024 + f0) = w; }
        if (isk) {
#pragma unroll
            for (int e = 0; e < 4; ++e) { u32x4 w; w.x = cvtpk(outv[0][e], outv[1][e]); w.y = cvtpk(outv[2][e], outv[3][e]); w.z = cvtpk(outv[4][e], outv[5][e]); w.w = cvtpk(outv[6][e], outv[7][e]);
                *(u32x4*)(KT + ((size_t)(h * 132 + j) * 256 + 4 * f4 + e) * 64 + 8 * o) = w; } }
    }
}
__device__ __forceinline__ void p3_v_task(const Params& P, LAS unsigned char* lds, int j, int h) {
    const int tid = otid(), lane = tid & 63, wave = tid >> 6, o = tid >> 6, f4 = tid & 63;
    const int t0 = 64 * j; LAS float* wkl = (LAS float*)lds;
    const bf16_t* U = (const bf16_t*)(P.ws + WS_UV); const int f0 = h * 256 + 4 * f4;
    u32x2 vraw[8];
#pragma unroll
    for (int i = 0; i < 8; ++i) vraw[i] = *(const u32x2*)(U + (size_t)(t0 + 8 * o + i) * 1024 + f0);
    __syncthreads();
    if (wave < 2) { const int d = wave; const float* G = (const float*)(P.ws + WS_GATES) + (size_t)(t0 + lane) * 16;
        const float ig = G[(2 * d) * 4 + h], fg = G[(2 * d + 1) * 4 + h];
        float b = logsigmoidf_(fg);
        if (d == 0) {
#pragma unroll
            for (int s = 1; s < 64; s <<= 1) { const float t = __shfl_up(b, s); if (lane >= s) b += t; }
        } else {
#pragma unroll
            for (int s = 1; s < 64; s <<= 1) { const float t = __shfl_down(b, s); if (lane + s < 64) b += t; }
        }
        const float gtot = __shfl(b, d == 0 ? 63 : 0); const float e = ig - b; const float em = wave_max(e);
        const size_t ix = (size_t)(d * 4 + h) * MTOT + t0 + lane;
        ((float*)(P.ws + WS_E))[ix] = e; ((float*)(P.ws + WS_BC))[ix] = b;
        if (lane == 0) { float* gc = (float*)(P.ws + WS_GC); gc[(d * 4 + h) * 132 + j] = gtot; gc[2048 + (d * 4 + h) * 132 + j] = em; }
        wkl[d * 64 + lane] = __expf(e - em);
    }
    __syncthreads();
    float v[8][4];
#pragma unroll
    for (int i = 0; i < 8; ++i) { v[i][0] = bflo(vraw[i].x); v[i][1] = bfhi(vraw[i].x); v[i][2] = bflo(vraw[i].y); v[i][3] = bfhi(vraw[i].y); }
    bf16_t* VT = (bf16_t*)(P.ws + WS_VT); bf16_t* VSF = (bf16_t*)(P.ws + WS_VSF); bf16_t* VSB = (bf16_t*)(P.ws + WS_VSB);
    float sf[8], sb[8];
#pragma unroll
    for (int i = 0; i < 8; ++i) { sf[i] = wkl[8 * o + i]; sb[i] = wkl[64 + 8 * o + i]; }
#pragma unroll
    for (int e = 0; e < 4; ++e) { const size_t off = ((size_t)(h * 132 + j) * 272 + 4 * f4 + e) * 64 + 8 * o; u32x4 w;
        w.x = cvtpk(v[0][e], v[1][e]); w.y = cvtpk(v[2][e], v[3][e]); w.z = cvtpk(v[4][e], v[5][e]); w.w = cvtpk(v[6][e], v[7][e]); *(u32x4*)(VT + off) = w;
        w.x = cvtpk(v[0][e] * sf[0], v[1][e] * sf[1]); w.y = cvtpk(v[2][e] * sf[2], v[3][e] * sf[3]); w.z = cvtpk(v[4][e] * sf[4], v[5][e] * sf[5]); w.w = cvtpk(v[6][e] * sf[6], v[7][e] * sf[7]); *(u32x4*)(VSF + off) = w;
        w.x = cvtpk(v[0][e] * sb[0], v[1][e] * sb[1]); w.y = cvtpk(v[2][e] * sb[2], v[3][e] * sb[3]); w.z = cvtpk(v[4][e] * sb[4], v[5][e] * sb[5]); w.w = cvtpk(v[6][e] * sb[6], v[7][e] * sb[7]); *(u32x4*)(VSB + off) = w; }
    if (tid < 128) {
        const int rr = tid >> 3, oc = tid & 7; const size_t off = ((size_t)(h * 132 + j) * 272 + 256 + rr) * 64 + 8 * oc; u32x4 w1 = {0u, 0u, 0u, 0u}, wf = w1, wb = w1;
        if (rr == 0) { w1 = (u32x4){0x3f803f80u, 0x3f803f80u, 0x3f803f80u, 0x3f803f80u};
            wf.x = cvtpk(wkl[8 * oc], wkl[8 * oc + 1]); wf.y = cvtpk(wkl[8 * oc + 2], wkl[8 * oc + 3]); wf.z = cvtpk(wkl[8 * oc + 4], wkl[8 * oc + 5]); wf.w = cvtpk(wkl[8 * oc + 6], wkl[8 * oc + 7]);
            wb.x = cvtpk(wkl[64 + 8 * oc], wkl[64 + 8 * oc + 1]); wb.y = cvtpk(wkl[64 + 8 * oc + 2], wkl[64 + 8 * oc + 3]); wb.z = cvtpk(wkl[64 + 8 * oc + 4], wkl[64 + 8 * oc + 5]); wb.w = cvtpk(wkl[64 + 8 * oc + 6], wkl[64 + 8 * oc + 7]); }
        *(u32x4*)(VT + off) = w1; *(u32x4*)(VSF + off) = wf; *(u32x4*)(VSB + off) = wb; }
}
__device__ __forceinline__ void p3_pool_task(const Params& P, LAS unsigned char* lds, int r, int gi) {
    const int tid = otid(), chunk = tid & 31, cb = tid >> 5; const int win = 2 << gi, hw = win >> 1;
    const int rlo = max(r - hw, 0), rhi = min(r - hw + win, 128);
    const bf16_t* U = (const bf16_t*)(P.ws + WS_UP) + gi * 256 + 8 * chunk; LAS float* vs = (LAS float*)lds;
    __syncthreads();
    float own[4][8];
#pragma unroll
    for (int i = 0; i < 4; ++i) { const int c = cb + 16 * i; float a[8];
#pragma unroll
        for (int e = 0; e < 8; ++e) a[e] = 0.f;
        u32x4 wv[16];
#pragma unroll
        for (int q = 0; q < 16; ++q) { const int rr = rlo + q; wv[q] = (q < win && rr < rhi) ? *(const u32x4*)(U + (size_t)(rr * 64 + c) * 1024) : (u32x4){0u, 0u, 0u, 0u}; }
#pragma unroll
        for (int q = 0; q < 16; ++q) { const int rr = rlo + q; const u32x4 w = wv[q];
            const float x[8] = {bflo(w.x), bfhi(w.x), bflo(w.y), bfhi(w.y), bflo(w.z), bfhi(w.z), bflo(w.w), bfhi(w.w)};
#pragma unroll
            for (int e = 0; e < 8; ++e) a[e] += x[e];
            if (rr == r) {
#pragma unroll
                for (int e = 0; e < 8; ++e) own[i][e] = x[e]; } }
        *(LAS f32x4*)(vs + c * 256 + 8 * chunk) = (f32x4){a[0], a[1], a[2], a[3]}; *(LAS f32x4*)(vs + c * 256 + 8 * chunk + 4) = (f32x4){a[4], a[5], a[6], a[7]}; }
    __syncthreads();
    bf16_t* Dp = (bf16_t*)(P.ws + WS_A2) + gi * 256 + 8 * chunk;
#pragma unroll
    for (int i = 0; i < 4; ++i) { const int c = cb + 16 * i; const int clo = max(c - hw, 0), chi = min(c - hw + win, 64);
        f32x4 s0 = {0.f, 0.f, 0.f, 0.f}, s1 = s0;
        for (int cc = clo; cc < chi; ++cc) { s0 += *(const LAS f32x4*)(vs + cc * 256 + 8 * chunk); s1 += *(const LAS f32x4*)(vs + cc * 256 + 8 * chunk + 4); }
        const float inv = 1.0f / (float)((rhi - rlo) * (chi - clo));
        u32x4 w; w.x = cvtpk(s0[0] * inv - own[i][0], s0[1] * inv - own[i][1]); w.y = cvtpk(s0[2] * inv - own[i][2], s0[3] * inv - own[i][3]);
        w.z = cvtpk(s1[0] * inv - own[i][4], s1[1] * inv - own[i][5]); w.w = cvtpk(s1[2] * inv - own[i][6], s1[3] * inv - own[i][7]);
        *(u32x4*)(Dp + (size_t)(r * 64 + c) * 2048) = w; }
}
__device__ __forceinline__ void p3_all(const Params& P, LAS unsigned char* lds) {
    for (int t = blockIdx.x; t < 1560; t += gridDim.x) {
        if (t < 256) p3_qk_task(P, 0, t >> 2, t & 3);
        else if (t < 520) p3_qk_task(P, 1, (t - 256) >> 2, (t - 256) & 3);
        else if (t < 1048) p3_v_task(P, lds, (t - 520) >> 2, (t - 520) & 3);
        else p3_pool_task(P, lds, (t - 1048) >> 2, (t - 1048) & 3);
    }
}
__device__ __forceinline__ int step_chunk(int d, int j) { return d == 0 ? (j < 4 ? 128 + j : j - 4) : (j < 4 ? 131 - j : 131 - j); }
__device__ __forceinline__ void p4_state(const Params& P, LAS unsigned char* lds, int sb, bool dry = false) {
    const int tid = otid(), lane = tid & 63, wave = __builtin_amdgcn_readfirstlane(tid >> 6);
    const int hd = sb & 7, h = hd >> 1, d = hd & 1, lb = sb >> 3;
    LAS float* tg = (LAS float*)(lds + 110592); LAS float* te = tg + 132; LAS float* tm = te + 132; LAS float* tdec = tm + 132; LAS float* tsf = tdec + 132;
    const float* gc = (const float*)(P.ws + WS_GC);
    if (tid < 132) { const int ci = step_chunk(d, tid); tg[tid] = gc[(d * 4 + h) * 132 + ci]; te[tid] = gc[2048 + (d * 4 + h) * 132 + ci]; }
    __syncthreads();
    if (tid == 0) { float m = 0.f;
#pragma unroll 4
        for (int j = 0; j < 132; ++j) { tm[j] = m; m = tg[j] + fmaxf(m, te[j]); } }
    __syncthreads();
    if (tid < 132) { const float m = tm[tid], em = te[tid], Mf = fmaxf(m, em); tdec[tid] = __expf(m - Mf); tsf[tid] = __expf(em - Mf);
        if (lb == 0 && !dry) ((float*)(P.ws + WS_GC))[4096 + (d * 4 + h) * 132 + step_chunk(d, tid)] = m; }
    __syncthreads();
    if (wave >= 3) return;
    const int task = lb + 32 * wave; if (task >= 72) return;
    const int kq = task / 9, vq = task - 9 * kq; const bool two = vq < 8; const int vt0 = two ? 2 * vq : 16;
    const int fr = lane & 15, fq = lane >> 4;
    const bf16_t* KT = (const bf16_t*)(P.ws + WS_KT) + ((size_t)(h * 132) * 256 + kq * 32) * 64 + lane * 8;
    const bf16_t* VS = (const bf16_t*)(P.ws + (d == 0 ? WS_VSF : WS_VSB)) + ((size_t)(h * 132) * 272 + vt0 * 16) * 64 + lane * 8;
    const int vs1 = two ? 16 * 64 : 0;
    LAS unsigned char* wb = lds + wave * 9216;
    const int wofs = (lane >> 3) * 144 + 16 * (lane & 7), rofs = fr * 144 + 16 * fq;
    bf16_t* CST = (bf16_t*)(P.ws + WS_CST); float* NST = (float*)(P.ws + WS_NST);
    f32x4 C[2][2];
#pragma unroll
    for (int a = 0; a < 2; ++a)
#pragma unroll
        for (int b = 0; b < 2; ++b) C[a][b] = (f32x4){0.f, 0.f, 0.f, 0.f};
    u32x4 rg[4][8];
#define P4_LOAD(slot, jj) do { const size_t cj_ = (size_t)step_chunk(d, (jj)); const bf16_t* kp_ = KT + cj_ * (256 * 64); const bf16_t* vp_ = VS + cj_ * (272 * 64); \
        rg[slot][0] = *(const u32x4*)(kp_); rg[slot][1] = *(const u32x4*)(kp_ + 512); rg[slot][2] = *(const u32x4*)(kp_ + 1024); rg[slot][3] = *(const u32x4*)(kp_ + 1536); \
        rg[slot][4] = *(const u32x4*)(vp_); rg[slot][5] = *(const u32x4*)(vp_ + 512); rg[slot][6] = *(const u32x4*)(vp_ + vs1); rg[slot][7] = *(const u32x4*)(vp_ + vs1 + 512); } while (0)
    P4_LOAD(0, 0); P4_LOAD(1, 1); P4_LOAD(2, 2);
    for (int j0 = 0; j0 < 132; j0 += 4) {
#pragma unroll
        for (int u = 0; u < 4; ++u) { const int j = j0 + u;
            if (j + 3 < 132) P4_LOAD((u + 3) & 3, j + 3);
#pragma unroll
            for (int i = 0; i < 8; ++i) *(LAS u32x4*)(wb + (i >> 1) * 2304 + (i & 1) * 1152 + wofs) = rg[u][i];
            const int ci = step_chunk(d, j);
            if (ci < 128 && !dry) {
                const size_t rb = (((size_t)ci * 4 + h) * 2 + d) * 256;
                if (two) {
#pragma unroll
                    for (int a = 0; a < 2; ++a)
#pragma unroll
                        for (int b = 0; b < 2; ++b) { u32x2 w; w.x = cvtpk(C[a][b][0], C[a][b][1]); w.y = cvtpk(C[a][b][2], C[a][b][3]); *(u32x2*)(CST + (rb + (vt0 + b) * 16 + fr) * 256 + kq * 32 + 16 * a + 4 * fq) = w; }
                } else if (fr == 0) {
#pragma unroll
                    for (int a = 0; a < 2; ++a) *(f32x4*)(NST + rb + kq * 32 + 16 * a + 4 * fq) = C[a][0]; }
            }
            const float dec = tdec[j], sf = tsf[j];
            bf16x8 fa[2][2], fb[2][2];
#pragma unroll
            for (int t = 0; t < 2; ++t)
#pragma unroll
                for (int ks = 0; ks < 2; ++ks) { fa[t][ks] = *(const LAS bf16x8*)(wb + t * 2304 + rofs + 64 * ks); fb[t][ks] = *(const LAS bf16x8*)(wb + (2 + t) * 2304 + rofs + 64 * ks); }
#pragma unroll
            for (int a = 0; a < 2; ++a)
#pragma unroll
                for (int b = 0; b < 2; ++b) { f32x4 Dt = {0.f, 0.f, 0.f, 0.f};
#pragma unroll
                    for (int ks = 0; ks < 2; ++ks) Dt = __builtin_amdgcn_mfma_f32_16x16x32_bf16(fa[a][ks], fb[b][ks], Dt, 0, 0, 0);
                    C[a][b] = C[a][b] * dec + Dt * sf; }
        }
    }
#undef P4_LOAD
}
constexpr int O_QS = 0, O_KS = 33792, O_VT = 67584, O_WS = 106752, O_SC = 125184, O_DEN = 127232, O_RED = 127744, O_END = 131840;
__device__ __forceinline__ void p5_task(const Params& P, LAS unsigned char* lds, int c, int h) {
    const int tid = otid(), lane = tid & 63, wave = __builtin_amdgcn_readfirstlane(tid >> 6), fr = lane & 15, fq = lane >> 4;
    const int t0 = 64 * c;
    LAS float* Es = (LAS float*)(lds + O_SC); LAS float* Ms = Es + 128; LAS float* Wi = Ms + 128; LAS float* Fl = Wi + 128; LAS float* dens = (LAS float*)(lds + O_DEN); LAS float* red = (LAS float*)(lds + O_RED);
    __syncthreads();
    { const bf16_t* Q = (const bf16_t*)(P.ws + WS_QC) + (size_t)t0 * 1024 + h * 256; const bf16_t* Kc = (const bf16_t*)(P.ws + WS_KC) + (size_t)t0 * 1024 + h * 256;
#pragma unroll
      for (int i = 0; i < 4; ++i) { const int idx = tid + 512 * i, r = idx >> 5, ch = idx & 31;
          const u32x4 qv = *(const u32x4*)(Q + (size_t)r * 1024 + 8 * ch), kv = *(const u32x4*)(Kc + (size_t)r * 1024 + 8 * ch);
          *(LAS u32x4*)(lds + O_QS + r * 528 + 16 * ch) = qv; *(LAS u32x4*)(lds + O_KS + r * 528 + 16 * ch) = kv; }
      const bf16_t* VT = (const bf16_t*)(P.ws + WS_VT) + (size_t)(h * 132 + c) * (272 * 64);
      for (int idx = tid; idx < 272 * 8; idx += 512) { const int r = idx >> 3, ch = idx & 7; *(LAS u32x4*)(lds + O_VT + r * 144 + 16 * ch) = *(const u32x4*)(VT + (size_t)r * 64 + 8 * ch); } }
    if (wave < 2) { const int d = wave; const size_t ix = (size_t)(d * 4 + h) * MTOT + t0 + lane;
        const float e = ((const float*)(P.ws + WS_E))[ix], b = ((const float*)(P.ws + WS_BC))[ix]; const float m = ((const float*)(P.ws + WS_GC))[4096 + (d * 4 + h) * 132 + c];
        float pm = e;
        if (d == 0) {
#pragma unroll
            for (int s = 1; s < 64; s <<= 1) { const float t = __shfl_up(pm, s); if (lane >= s) pm = fmaxf(pm, t); }
        } else {
#pragma unroll
            for (int s = 1; s < 64; s <<= 1) { const float t = __shfl_down(pm, s); if (lane + s < 64) pm = fmaxf(pm, t); }
        }
        const float Mt = fmaxf(m, pm);
        Es[d * 64 + lane] = e; Ms[d * 64 + lane] = Mt; Wi[d * 64 + lane] = __expf(m - Mt); Fl[d * 64 + lane] = __expf(-(b + Mt)); }
    __syncthreads();
    { const int st = wave >> 1, tt0 = 2 * (wave & 1); f32x4 S0 = {0.f, 0.f, 0.f, 0.f}, S1 = S0;
#pragma unroll
      for (int ks = 0; ks < 8; ++ks) { const bf16x8 ak = *(const LAS bf16x8*)(lds + O_KS + (16 * st + fr) * 528 + 64 * ks + 16 * fq);
          const bf16x8 bq0 = *(const LAS bf16x8*)(lds + O_QS + (16 * tt0 + fr) * 528 + 64 * ks + 16 * fq), bq1 = *(const LAS bf16x8*)(lds + O_QS + (16 * tt0 + 16 + fr) * 528 + 64 * ks + 16 * fq);
          S0 = __builtin_amdgcn_mfma_f32_16x16x32_bf16(ak, bq0, S0, 0, 0, 0); S1 = __builtin_amdgcn_mfma_f32_16x16x32_bf16(ak, bq1, S1, 0, 0, 0); }
      const int s0 = 16 * st + 4 * fq;
#pragma unroll
      for (int d = 0; d < 2; ++d) { const f32x4 ev = *(const LAS f32x4*)(Es + d * 64 + s0);
#pragma unroll
          for (int q = 0; q < 2; ++q) { const int t = 16 * (tt0 + q) + fr; const float Mt = Ms[d * 64 + t]; const f32x4 S = q == 0 ? S0 : S1; float w[4];
#pragma unroll
              for (int i = 0; i < 4; ++i) { const int s = s0 + i; const bool on = d == 0 ? (s <= t) : (s >= t); w[i] = on ? __expf(ev[i] - Mt) * S[i] : 0.f; }
              u32x2 pk; pk.x = cvtpk(w[0], w[1]); pk.y = cvtpk(w[2], w[3]); *(LAS u32x2*)(lds + O_WS + (d * 64 + t) * 144 + 2 * s0) = pk; } } }
    __syncthreads();
    f32x4 acc[2][2][4];
    const bf16_t* CST = (const bf16_t*)(P.ws + WS_CST);
#pragma unroll
    for (int d = 0; d < 2; ++d) {
        const bf16_t* Cp = CST + ((((size_t)c * 4 + h) * 2 + d) * 256 + 32 * wave + fr) * 256 + 8 * fq;
        bf16x8 ca[2][8];
#pragma unroll
        for (int v = 0; v < 2; ++v)
#pragma unroll
            for (int ks = 0; ks < 8; ++ks) ca[v][ks] = *(const bf16x8*)(Cp + (size_t)v * 16 * 256 + 32 * ks);
#pragma unroll
        for (int v = 0; v < 2; ++v)
#pragma unroll
            for (int tt = 0; tt < 4; ++tt) acc[d][v][tt] = (f32x4){0.f, 0.f, 0.f, 0.f};
#pragma unroll
        for (int ks = 0; ks < 8; ++ks) {
#pragma unroll
            for (int tt = 0; tt < 4; ++tt) { const bf16x8 bq = *(const LAS bf16x8*)(lds + O_QS + (16 * tt + fr) * 528 + 64 * ks + 16 * fq);
                acc[d][0][tt] = __builtin_amdgcn_mfma_f32_16x16x32_bf16(ca[0][ks], bq, acc[d][0][tt], 0, 0, 0); acc[d][1][tt] = __builtin_amdgcn_mfma_f32_16x16x32_bf16(ca[1][ks], bq, acc[d][1][tt], 0, 0, 0); } }
#pragma unroll
        for (int tt = 0; tt < 4; ++tt) { const float wi = Wi[d * 64 + 16 * tt + fr]; acc[d][0][tt] *= wi; acc[d][1][tt] *= wi; }
#pragma unroll
        for (int ks = 0; ks < 2; ++ks) { const bf16x8 va0 = *(const LAS bf16x8*)(lds + O_VT + (32 * wave + fr) * 144 + 64 * ks + 16 * fq), va1 = *(const LAS bf16x8*)(lds + O_VT + (32 * wave + 16 + fr) * 144 + 64 * ks + 16 * fq);
#pragma unroll
            for (int tt = 0; tt < 4; ++tt) { const bf16x8 bw = *(const LAS bf16x8*)(lds + O_WS + (d * 64 + 16 * tt + fr) * 144 + 64 * ks + 16 * fq);
                acc[d][0][tt] = __builtin_amdgcn_mfma_f32_16x16x32_bf16(va0, bw, acc[d][0][tt], 0, 0, 0); acc[d][1][tt] = __builtin_amdgcn_mfma_f32_16x16x32_bf16(va1, bw, acc[d][1][tt], 0, 0, 0); } }
    }
    { const int tt = wave & 3, d = wave >> 2; f32x4 dn = {0.f, 0.f, 0.f, 0.f};
      const float* np = (const float*)(P.ws + WS_NST) + (((size_t)c * 4 + h) * 2 + d) * 256 + 8 * fq;
#pragma unroll
      for (int ks = 0; ks < 8; ++ks) { bf16x8 an = {0, 0, 0, 0, 0, 0, 0, 0};
          if (fr == 0) { const f32x4 n0 = *(const f32x4*)(np + 32 * ks), n1 = *(const f32x4*)(np + 32 * ks + 4); u32x4 w; w.x = cvtpk(n0[0], n0[1]); w.y = cvtpk(n0[2], n0[3]); w.z = cvtpk(n1[0], n1[1]); w.w = cvtpk(n1[2], n1[3]); an = __builtin_bit_cast(bf16x8, w); }
          const bf16x8 bq = *(const LAS bf16x8*)(lds + O_QS + (16 * tt + fr) * 528 + 64 * ks + 16 * fq);
          dn = __builtin_amdgcn_mfma_f32_16x16x32_bf16(an, bq, dn, 0, 0, 0); }
      dn *= Wi[d * 64 + 16 * tt + fr];
#pragma unroll
      for (int ks = 0; ks < 2; ++ks) { const bf16x8 va = *(const LAS bf16x8*)(lds + O_VT + (256 + fr) * 144 + 64 * ks + 16 * fq); const bf16x8 bw = *(const LAS bf16x8*)(lds + O_WS + (d * 64 + 16 * tt + fr) * 144 + 64 * ks + 16 * fq);
          dn = __builtin_amdgcn_mfma_f32_16x16x32_bf16(va, bw, dn, 0, 0, 0); }
      if (fq == 0) dens[d * 64 + 16 * tt + fr] = dn[0]; }
    __syncthreads();
    float hv[2][4][4];
#pragma unroll
    for (int tt = 0; tt < 4; ++tt) { const int t = 16 * tt + fr; const float rf = 1.0f / fmaxf(fabsf(dens[t]), Fl[t]), rb = 1.0f / fmaxf(fabsf(dens[64 + t]), Fl[64 + t]);
        float s = 0.f, s2 = 0.f;
#pragma unroll
        for (int v = 0; v < 2; ++v)
#pragma unroll
            for (int i = 0; i < 4; ++i) { const float x = acc[0][v][tt][i] * rf + acc[1][v][tt][i] * rb; hv[v][tt][i] = x; s += x; s2 += x * x; }
        s += __shfl_xor(s, 16); s += __shfl_xor(s, 32); s2 += __shfl_xor(s2, 16); s2 += __shfl_xor(s2, 32);
        if (fq == 0) { red[(wave * 64 + t) * 2] = s; red[(wave * 64 + t) * 2 + 1] = s2; } }
    __syncthreads();
    { const float* hg = P.in[I_HNG] + h * 256; const bf16_t* UO = (const bf16_t*)(P.ws + WS_UO); bf16_t* A2 = (bf16_t*)(P.ws + WS_A2);
#pragma unroll
      for (int tt = 0; tt < 4; ++tt) { const int t = 16 * tt + fr; float s = 0.f, s2 = 0.f;
#pragma unroll
          for (int w = 0; w < 8; ++w) { s += red[(w * 64 + t) * 2]; s2 += red[(w * 64 + t) * 2 + 1]; }
          const float mu = s * (1.0f / 256.0f), var = fmaxf(s2 * (1.0f / 256.0f) - mu * mu, 0.f), rstd = 1.0f / sqrtf(var + EPSF);
#pragma unroll
          for (int v = 0; v < 2; ++v) { const int vf = 32 * wave + 16 * v + 4 * fq; const f32x4 g = *(const f32x4*)(hg + vf);
              const u32x2 ow = *(const u32x2*)(UO + (size_t)(t0 + t) * 1024 + h * 256 + vf); const float o[4] = {bflo(ow.x), bfhi(ow.x), bflo(ow.y), bfhi(ow.y)}; float r[4];
#pragma unroll
              for (int i = 0; i < 4; ++i) r[i] = (hv[v][tt][i] - mu) * rstd * g[i] * sigmoidf_(o[i]);
              u32x2 pk; pk.x = cvtpk(r[0], r[1]); pk.y = cvtpk(r[2], r[3]); *(u32x2*)(A2 + (size_t)(t0 + t) * 2048 + 1024 + h * 256 + vf) = pk; } } }
}
#define XB_TMO      128
#define XB_XCNT(j)  (256  + 64 * (j))
#define XB_XSUB(j)  (1280 + 64 * (j))
#define XB_XGEN(j)  (2304 + 64 * (j))
#define XB_TOP      3328
#define XB_TOPGEN   3392
#define XCD_BAR_WORDS 3456
#define XB_SPIN_CAP (1u << 18)
__device__ __forceinline__ unsigned xb_ld(unsigned* p)              { return __hip_atomic_load(p, __ATOMIC_RELAXED, __HIP_MEMORY_SCOPE_AGENT); }
__device__ __forceinline__ unsigned xb_add(unsigned* p, unsigned v) { return __hip_atomic_fetch_add(p, v, __ATOMIC_RELAXED, __HIP_MEMORY_SCOPE_AGENT); }
__device__ __forceinline__ unsigned xb_xcc_id() { return (unsigned)__builtin_amdgcn_s_getreg((3 << 11) | 20) & 0xFu; }
#define XB_SPIN(cond, bar) do { unsigned _sp = 0; while (cond) { __builtin_amdgcn_s_sleep(1); \
    if ((++_sp & 255u) == 0u) { if (xb_ld(&(bar)[XB_TMO])) break; if (_sp > XB_SPIN_CAP) { atomicAdd(&(bar)[XB_TMO], 1u); break; } } } } while (0)
struct XcdBarrier { unsigned* bar; unsigned x; volatile LAS unsigned* st; };
__device__ __forceinline__ XcdBarrier xcd_barrier_post(unsigned* bar, volatile LAS unsigned* st) {
    XcdBarrier b; b.bar = bar; b.x = xb_xcc_id(); b.st = st;
    if (threadIdx.x == 0) (void)xb_add(&bar[XB_XCNT(b.x)], 1u);
    return b;
}
__device__ __forceinline__ void xcd_barrier_complete(unsigned* bar, unsigned x, unsigned& nloc, unsigned& nx) {
    const unsigned G = gridDim.x * gridDim.y * gridDim.z;
    unsigned sum, cnt, mine, sp = 0u;
    for (;;) {
        sum = 0u; cnt = 0u; mine = 0u;
#pragma unroll
        for (unsigned j = 0; j < 16; ++j) { const unsigned c = xb_ld(&bar[XB_XCNT(j)]); sum += c; cnt += (c > 0u) ? 1u : 0u; mine = (j == x) ? c : mine; }
        if (sum == G) break;
        __builtin_amdgcn_s_sleep(1);
        if ((++sp & 255u) == 0u) { if (xb_ld(&bar[XB_TMO])) break; if (sp > XB_SPIN_CAP) { atomicAdd(&bar[XB_TMO], 1u); break; } }
    }
    nloc = mine > 0u ? mine : 1u; nx = cnt > 0u ? cnt : 1u;
}
__device__ __forceinline__ void xcd_barrier(const XcdBarrier& b) {
    asm volatile("s_waitcnt vmcnt(0)" ::: "memory");
    __syncthreads();
    if (threadIdx.x == 0) {
        unsigned* bar = b.bar;
        __builtin_amdgcn_s_waitcnt(0);
        unsigned nloc = b.st[0], nx = b.st[1];
        if (nloc == 0u) { xcd_barrier_complete(bar, b.x, nloc, nx); b.st[0] = nloc; b.st[1] = nx; }
        const unsigned old = xb_add(&bar[XB_XSUB(b.x)], 1u);
        const unsigned gen = old / nloc;
        if (old + 1u == (gen + 1u) * nloc) {
            __builtin_amdgcn_fence(__ATOMIC_RELEASE, "agent");
            asm volatile("s_waitcnt vmcnt(0)" ::: "memory");
            const unsigned og = xb_add(&bar[XB_TOP], 1u);
            const unsigned tg = og / nx;
            if (og + 1u == (tg + 1u) * nx) xb_add(&bar[XB_TOPGEN], 1u);
            else XB_SPIN(xb_ld(&bar[XB_TOPGEN]) == tg, bar);
            __builtin_amdgcn_fence(__ATOMIC_ACQUIRE, "agent");
            xb_add(&bar[XB_XGEN(b.x)], 1u);
            asm volatile("s_waitcnt vmcnt(0)" ::: "memory");
        } else {
            XB_SPIN(xb_ld(&bar[XB_XGEN(b.x)]) == gen, bar);
            __builtin_amdgcn_fence(__ATOMIC_ACQUIRE, "agent");
            asm volatile("s_waitcnt vmcnt(0)" ::: "memory");
        }
    }
    __syncthreads();
}
__device__ __forceinline__ void p7a_route(const Params& P, LAS unsigned char* lds, bool dry = false) {
    const int tid = otid(), lane = tid & 63, wave = __builtin_amdgcn_readfirstlane(tid >> 6), fr = lane & 15, fq = lane >> 4;
    const float* sumsq = (const float*)(P.ws + WS_SUMSQ); const float* BRP = (const float*)(P.ws + WS_WRP + 448 * 1024);
    int* cnt = (int*)(P.ws + WS_CTL) + (dry ? 2048 : 1024); const size_t ro = dry ? 262144 : 0; int* eid = (int*)(P.ws + WS_ROUTE + ro); float* wtok = (float*)(P.ws + WS_ROUTE + ro + 65536); int* spos = (int*)(P.ws + WS_ROUTE + ro + 131072);
    LAS float* part = (LAS float*)lds; LAS float* lgs = part + 8 * 32 * 48;
    for (int rb = blockIdx.x; rb < SEQ / 32; rb += gridDim.x) {
        const int row0 = 32 * rb;
        f32x4 acc[2][3];
#pragma unroll
        for (int a = 0; a < 2; ++a)
#pragma unroll
            for (int c = 0; c < 3; ++c) acc[a][c] = (f32x4){0.f, 0.f, 0.f, 0.f};
        LAS unsigned char* hb = lds + wave * 16640; LAS float* rs = (LAS float*)(lds + 133120);
        const f32x4* wp = (const f32x4*)(P.ws + WS_WRP) + (size_t)(64 * wave + fq) * 48 + fr;
        __syncthreads();
        if (tid < 32) { const int r = row0 + tid; float ss = 0.f;
#pragma unroll
            for (int q = 0; q < 8; ++q) { const f32x4 v = *(const f32x4*)(sumsq + (size_t)r * 32 + 4 * q); ss += (v[0] + v[1]) + (v[2] + v[3]); }
            rs[tid] = 1.0f / sqrtf(ss * (1.0f / D) + EPSF); }
        const int dcol = 256 * wave + 4 * lane;
        const f32x4 fA = *(const f32x4*)(P.in[I_N2G] + dcol) * (*(const f32x4*)((const float*)(P.ws + WS_MOD) + 8192 + dcol) + 1.0f), fS = *(const f32x4*)((const float*)(P.ws + WS_MOD) + 6144 + dcol);
        __syncthreads();
#pragma unroll
        for (int a = 0; a < 2; ++a) { f32x4 hv[16];
#pragma unroll
            for (int r = 0; r < 16; ++r) hv[r] = *(const f32x4*)(P.out + (size_t)(row0 + 16 * a + r) * D + 256 * wave + 4 * lane);
#pragma unroll
            for (int r = 0; r < 16; ++r) *(LAS f32x4*)(hb + r * 1040 + 16 * lane) = hv[r];
            if (!dry) {
#pragma unroll
                for (int r = 0; r < 16; ++r) { const f32x4 y = hv[r] * rs[16 * a + r] * fA + fS; u32x2 pk; pk.x = cvtpk(y[0], y[1]); pk.y = cvtpk(y[2], y[3]);
                    *(u32x2*)((bf16_t*)(P.ws + WS_FN) + (size_t)(row0 + 16 * a + r) * D + dcol) = pk; } }
#pragma unroll 4
            for (int j = 0; j < 16; ++j) { const f32x4 a0 = *(const LAS f32x4*)(hb + fr * 1040 + 64 * j + 16 * fq);
                f32x4 b[3];
#pragma unroll
                for (int c = 0; c < 3; ++c) b[c] = wp[(size_t)(4 * j) * 48 + 16 * c];
#pragma unroll
                for (int i = 0; i < 4; ++i)
#pragma unroll
                    for (int c = 0; c < 3; ++c) acc[a][c] = __builtin_amdgcn_mfma_f32_16x16x4f32(a0[i], b[c][i], acc[a][c], 0, 0, 0); } }
        __syncthreads();
#pragma unroll
        for (int a = 0; a < 2; ++a)
#pragma unroll
            for (int c = 0; c < 3; ++c)
#pragma unroll
                for (int i = 0; i < 4; ++i) part[(wave * 32 + 16 * a + 4 * fq + i) * 48 + 16 * c + fr] = acc[a][c][i];
        __syncthreads();
        { const int row = tid >> 4, pc = tid & 15;
#pragma unroll
          for (int c = 0; c < 3; ++c) { float s = 0.f;
#pragma unroll
              for (int w = 0; w < 8; ++w) s += part[(w * 32 + row) * 48 + 16 * c + pc];
              lgs[row * 48 + 16 * c + pc] = s; } }
        __syncthreads();
        if (tid < 32) { const int r = row0 + tid; const float rstd = rs[tid];
            float lg[4];
#pragma unroll
            for (int i = 0; i < 4; ++i) lg[i] = lgs[tid * 48 + 32 + i] * rstd + BRP[32 + i];
            int gs = 0; float gm = lg[0];
#pragma unroll
            for (int i = 1; i < 4; ++i) if (lg[i] > gm) { gm = lg[i]; gs = i; }
            float gsum = 0.f;
#pragma unroll
            for (int i = 0; i < 4; ++i) gsum += __expf(lg[i] - gm);
            const float pg = 1.0f / gsum;
            float sl[8];
#pragma unroll
            for (int i = 0; i < 8; ++i) sl[i] = lgs[tid * 48 + gs * 8 + i] * rstd + BRP[gs * 8 + i];
            int i1 = 0; float m1 = sl[0];
#pragma unroll
            for (int i = 1; i < 8; ++i) if (sl[i] > m1) { m1 = sl[i]; i1 = i; }
            int i2 = i1 == 0 ? 1 : 0; float m2 = sl[i2];
#pragma unroll
            for (int i = 0; i < 8; ++i) if (i != i1 && sl[i] > m2) { m2 = sl[i]; i2 = i; }
            const float p2 = __expf(m2 - m1); const float w1 = pg / (1.0f + p2), w2 = pg * p2 / (1.0f + p2);
            const int e1 = gs * 8 + i1, e2 = gs * 8 + i2;
            const int s1 = atomicAdd(cnt + e1, 1), s2 = atomicAdd(cnt + e2, 1);
            if (!dry) { int* ptok = (int*)(P.ws + WS_PTOK); ptok[e1 * 8192 + s1] = r; ptok[e2 * 8192 + s2] = r; }
            eid[2 * r] = e1; eid[2 * r + 1] = e2; wtok[2 * r] = w1; wtok[2 * r + 1] = w2; spos[2 * r] = s1; spos[2 * r + 1] = s2; }
    }
}
__device__ __forceinline__ void moe_tables(const Params& P, LAS int* tab) {
    __syncthreads();
    if (threadIdx.x == 0) { const int* cnt = (const int*)(P.ws + WS_CTL) + 1024; int tt = 0;
        for (int e = 0; e < NEXP; ++e) { const int c = __hip_atomic_load(cnt + e, __ATOMIC_RELAXED, __HIP_MEMORY_SCOPE_AGENT); const int nt = (c + 255) >> 8; tab[128 + e] = tt; for (int i = 0; i < nt; ++i) tab[1 + tt + i] = e; tt += nt; }
        tab[0] = tt; }
    __syncthreads();
}
__device__ __forceinline__ void p7b_scatter(const Params& P, const LAS int* tab) {
    const int tid = otid(), lane = tid & 63, wave = tid >> 6; const int gw = blockIdx.x * 8 + wave, NGW = gridDim.x * 8;
    const float* mod = (const float*)(P.ws + WS_MOD); const float* g = P.in[I_N2G]; const float* sumsq = (const float*)(P.ws + WS_SUMSQ);
    const int* eid = (const int*)(P.ws + WS_ROUTE); const int* spos = (const int*)(P.ws + WS_ROUTE + 131072); bf16_t* FNS = (bf16_t*)(P.ws + WS_FNS);
    for (int r = gw; r < SEQ; r += NGW) {
        float ss = lane < 32 ? sumsq[(size_t)r * 32 + lane] : 0.f; ss = wave_sum(ss);
        const float rstd = 1.0f / sqrtf(ss * (1.0f / D) + EPSF);
        const int e1 = eid[2 * r], e2 = eid[2 * r + 1]; const size_t sl1 = (size_t)tab[128 + e1] * 256 + spos[2 * r], sl2 = (size_t)tab[128 + e2] * 256 + spos[2 * r + 1];
        const f32x4* hr = (const f32x4*)(P.out + (size_t)r * D) + lane; u32x2* o1 = (u32x2*)(FNS + sl1 * D) + lane; u32x2* o2 = (u32x2*)(FNS + sl2 * D) + lane;
#pragma unroll
        for (int j = 0; j < 8; ++j) { const int d0 = 4 * lane + 256 * j; const f32x4 hv = hr[64 * j]; const f32x4 gg = *(const f32x4*)(g + d0), sc = *(const f32x4*)(mod + 8192 + d0), sh = *(const f32x4*)(mod + 6144 + d0);
            const f32x4 y = hv * rstd * gg * (sc + 1.0f) + sh; u32x2 w; w.x = cvtpk(y[0], y[1]); w.y = cvtpk(y[2], y[3]); o1[64 * j] = w; o2[64 * j] = w; }
    }
}
__device__ __forceinline__ void p10_final(const Params& P, const LAS int* tab, bool dry = false) {
    const int tid = otid(), lane = tid & 63, wave = tid >> 6; const int gw = blockIdx.x * 8 + wave, NGW = gridDim.x * 8;
    const float* mod = (const float*)(P.ws + WS_MOD); const float* fg = P.in[I_FG];
    const int* eid = (const int*)(P.ws + WS_ROUTE); const float* wtok = (const float*)(P.ws + WS_ROUTE + 65536); const int* spos = (const int*)(P.ws + WS_ROUTE + 131072); const bf16_t* Y = (const bf16_t*)(P.ws + WS_Y);
    for (int r = gw; r < SEQ; r += NGW) {
        const int e1 = eid[2 * r], e2 = eid[2 * r + 1]; const size_t sl1 = (size_t)tab[128 + e1] * 256 + spos[2 * r], sl2 = (size_t)tab[128 + e2] * 256 + spos[2 * r + 1];
        const float w1 = wtok[2 * r], w2 = wtok[2 * r + 1];
        f32x4* hr = (f32x4*)(P.out + (size_t)r * D) + lane; f32x4* wrp = dry ? (f32x4*)((float*)(P.ws + WS_FNS) + (size_t)r * D) + lane : hr; const u32x2* y1 = (const u32x2*)(Y + sl1 * D) + lane; const u32x2* y2 = (const u32x2*)(Y + sl2 * D) + lane;
        f32x4 v[8]; float ss = 0.f;
#pragma unroll
        for (int j = 0; j < 8; ++j) { const int d0 = 4 * lane + 256 * j; const f32x4 hv = hr[64 * j]; const f32x4 g2 = *(const f32x4*)(mod + 10240 + d0); const u32x2 a = y1[64 * j], b = y2[64 * j];
            const f32x4 ya = {bflo(a.x), bfhi(a.x), bflo(a.y), bfhi(a.y)}, yb = {bflo(b.x), bfhi(b.x), bflo(b.y), bfhi(b.y)};
            v[j] = hv + g2 * (ya * w1 + yb * w2); ss += (v[j][0] * v[j][0] + v[j][1] * v[j][1]) + (v[j][2] * v[j][2] + v[j][3] * v[j][3]); }
        const float rstd = 1.0f / sqrtf(wave_sum(ss) * (1.0f / D) + EPSF);
#pragma unroll
        for (int j = 0; j < 8; ++j) { const int d0 = 4 * lane + 256 * j; wrp[64 * j] = v[j] * rstd * *(const f32x4*)(fg + d0); }
    }
}
__device__ __forceinline__ void p10_plain(const Params& P, const float* src) {
    const int tid = otid(), lane = tid & 63, wave = tid >> 6; const int gw = blockIdx.x * 8 + wave, NGW = gridDim.x * 8; const float* fg = P.in[I_FG];
    for (int r = gw; r < SEQ; r += NGW) { const f32x4* sr = (const f32x4*)(src + (size_t)r * D) + lane; f32x4* hr = (f32x4*)(P.out + (size_t)r * D) + lane; f32x4 v[8]; float ss = 0.f;
#pragma unroll
        for (int j = 0; j < 8; ++j) { v[j] = sr[64 * j]; ss += (v[j][0] * v[j][0] + v[j][1] * v[j][1]) + (v[j][2] * v[j][2] + v[j][3] * v[j][3]); }
        const float rstd = 1.0f / sqrtf(wave_sum(ss) * (1.0f / D) + EPSF);
#pragma unroll
        for (int j = 0; j < 8; ++j) hr[64 * j] = v[j] * rstd * *(const f32x4*)(fg + 4 * lane + 256 * j); }
}
#ifndef STAGE
#define STAGE 4
#endif
#ifndef N_LAUNCHES
#define N_LAUNCHES 1
#endif
constexpr int NPHASE = 12;
__global__ void __launch_bounds__(512, 2) mk_fwd(Params P) {
    extern __shared__ __attribute__((aligned(16))) unsigned char lds_raw[];
    LAS unsigned char* lds = (LAS unsigned char*)lds_raw;
    LAS int* tab = (LAS int*)(lds + LDSCTL_OFF + 4096);
    const int lo = P.ph_lo, hi = P.ph_hi; const int G = gridDim.x, bx = blockIdx.x;
#ifndef ONLYP
#define ONLYP -1
#endif
#define IN(k) ((ONLYP < 0 || ONLYP == (k)) && lo <= (k) && (k) < hi)
#ifndef TS_PHASE
#define TS_PHASE -1
#endif
#ifndef TS_MULT
#define TS_MULT 4
#endif
#ifndef P4SEL
#define P4SEL 0
#endif
#ifndef REP_PHASE
#define REP_PHASE -1
#endif
#define NREP(k) ((k) == REP_PHASE ? 2 : 1)
    { volatile LAS unsigned* st = (volatile LAS unsigned*)(lds + LDS_BYTES - 64); if (threadIdx.x < 2) st[threadIdx.x] = 0u; __syncthreads(); }
    XcdBarrier xbar = xcd_barrier_post((unsigned*)(P.ws + WS_CTL) + 4096, (volatile LAS unsigned*)(lds + LDS_BYTES - 64));
#if N_LAUNCHES == 2
#define SEAM(k) do { if ((k) + 1 < hi) { xcd_barrier(xbar); } if (TS_PHASE >= 0 && bx == 0 && threadIdx.x == 0) ((volatile LAS unsigned long long*)(lds + LDS_BYTES - 256))[(k) + 1] = __builtin_amdgcn_s_memrealtime(); } while (0)
#else
#define SEAM(k) do { if ((k) + 1 < hi) { cg::this_grid().sync(); } } while (0)
#endif
    if (TS_PHASE >= 0 && bx == 0 && threadIdx.x == 0) ((volatile LAS unsigned long long*)(lds + LDS_BYTES - 256))[0] = __builtin_amdgcn_s_memrealtime();
    if (IN(0)) { for (int rep_ = 0; rep_ < NREP(0); ++rep_) { if (rep_) xcd_barrier(xbar);
#if STAGE >= 2
        p0_adaln(P, lds); p0_transposes(P, lds, 0, TR_ITEMS_EARLY, bx * 8 + (threadIdx.x >> 6), G * 8); if (STAGE >= 4) p0_moe_weights(P, lds); p0_zero_pad(P); p0_wpool_scaled(P);
#endif
        } SEAM(0); }
    if (IN(1)) { for (int rep_ = 0; rep_ < NREP(1); ++rep_) { if (rep_) xcd_barrier(xbar);
#if STAGE >= 2
        p1_router_prep(P);
        if (bx < G - 32) p1_xn(P, G - 32);
        else { pg8::Gemm g{(const bf16_t*)(P.ws + WS_WOUTT), (const bf16_t*)(P.ws + WS_WPOOLS), 2048, 256, 256}; SchedWeff S{32, bx - (G - 32)}; EpiWeff E{(bf16_t*)(P.ws + WS_WOUTT)};
            pg8::gemm_phase<EpiWeff, SchedWeff>(lds, g, S, E); }
#endif
        } SEAM(1); }
    if (IN(2)) { for (int rep_ = 0; rep_ < NREP(2); ++rep_) { if (rep_) xcd_barrier(xbar);
#if STAGE >= 2
        pg8::Gemm g{(const bf16_t*)(P.ws + WS_XN), (const bf16_t*)(P.ws + WS_WINT), 2048, 2048, 2048}; SchedG1 S{G, bx}; EpiG1 E{P.ws, P.in[I_GB]};
        pg8::gemm_phase<EpiG1, SchedG1>(lds, g, S, E);
#endif
        } SEAM(2); }
    if (IN(3)) { for (int rep_ = 0; rep_ < NREP(3); ++rep_) { if (rep_) xcd_barrier(xbar);
#if STAGE >= 2
        p3_all(P, lds);
#endif
        } SEAM(3); }
    if (IN(4)) { for (int rep_ = 0; rep_ < NREP(4); ++rep_) { if (rep_) xcd_barrier(xbar);
#if STAGE >= 2
        if (STAGE >= 3) { p4_state(P, lds, bx, rep_ > 0); }
#endif
        } SEAM(4); }
    if (IN(5)) { for (int rep_ = 0; rep_ < NREP(5); ++rep_) { if (rep_) xcd_barrier(xbar);
#if STAGE >= 3
        for (int t = bx; t < 512; t += G) p5_task(P, lds, t >> 2, t & 3);
#elif STAGE == 2
        { bf16_t* A2 = (bf16_t*)(P.ws + WS_A2); for (int i = bx * 512 + threadIdx.x; i < SEQ * 128; i += G * 512) { const int r = i >> 7, c8 = i & 127; *(u32x4*)(A2 + (size_t)r * 2048 + 1024 + 8 * c8) = (u32x4){0u, 0u, 0u, 0u}; } }
#endif
        } SEAM(5); }
    if (IN(6)) { for (int rep_ = 0; rep_ < NREP(6); ++rep_) { if (rep_) xcd_barrier(xbar);
#if STAGE >= 2
        pg8::Gemm g{(const bf16_t*)(P.ws + WS_A2), (const bf16_t*)(P.ws + WS_WOUTT), 2048, 2048, 2048}; SchedG2 S{G, bx};
        EpiG2 E{P.in[I_X], (const float*)(P.ws + WS_MOD) + 4096, P.out, (float*)(P.ws + WS_SUMSQ)};
        pg8::gemm_phase<EpiG2, SchedG2>(lds, g, S, E);
#endif
        } SEAM(6); }
    if (IN(7)) { for (int rep_ = 0; rep_ < NREP(7); ++rep_) { if (rep_) xcd_barrier(xbar);
#if STAGE >= 4
        p7a_route(P, lds, rep_ == 0 && NREP(7) == 2);
#endif
        } SEAM(7); }
    if (IN(9)) { for (int rep_ = 0; rep_ < NREP(9); ++rep_) { if (rep_) xcd_barrier(xbar);
#if STAGE >= 4
        if (rep_ == 0) moe_tables(P, tab);
        pg8::Gemm g{(const bf16_t*)(P.ws + WS_FN), (const bf16_t*)(P.ws + WS_W13T), 2048, 2048, 2048}; SchedMoEG S{G, bx, 4, 4, tab, (const int*)(P.ws + WS_PTOK), (const int*)(P.ws + WS_CTL) + 1024}; EpiUp E{(bf16_t*)(P.ws + WS_H)};
        pg8::gemm_phase<EpiUp, SchedMoEG>(lds, g, S, E);
#endif
        } SEAM(9); }
    if (IN(10)) { for (int rep_ = 0; rep_ < NREP(10); ++rep_) { if (rep_) xcd_barrier(xbar);
#if STAGE >= 4
        if (lo == 10) moe_tables(P, tab);
        pg8::Gemm g{(const bf16_t*)(P.ws + WS_H), (const bf16_t*)(P.ws + WS_W2T), 512, 512, 512}; SchedMoE S{G, bx, 8, 8, tab}; EpiDown E{(bf16_t*)(P.ws + WS_Y)};
        pg8::gemm_phase<EpiDown, SchedMoE>(lds, g, S, E);
#endif
        } SEAM(10); }
    if (IN(11)) { for (int rep_ = 0; rep_ < NREP(11); ++rep_) { if (rep_) xcd_barrier(xbar);
#if STAGE >= 4
        if (lo == 11) moe_tables(P, tab);
        p10_final(P, tab, rep_ == 0 && NREP(11) == 2);
#elif STAGE >= 2
        p10_plain(P, P.out);
#else
        p10_plain(P, P.in[I_X]);
#endif
    } }
    if (TS_PHASE >= 0 && bx == 0 && threadIdx.x == 0) { volatile LAS unsigned long long* ts = (volatile LAS unsigned long long*)(lds + LDS_BYTES - 256);
        const unsigned long long tend = __builtin_amdgcn_s_memrealtime(); const int k = TS_PHASE; const unsigned long long t1 = k >= 11 ? tend : ts[k + 1]; const unsigned long long span = t1 - ts[k == 9 ? 8 : k];
        const unsigned long long until = tend + span * TS_MULT; while (__builtin_amdgcn_s_memrealtime() < until) __builtin_amdgcn_s_sleep(8); }
#undef IN
#undef SEAM
}

extern "C" void kernel_launch(void* const* d_in, const int* in_sizes, int n_in, void* d_out, int out_size, void* d_ws, size_t ws_size, hipStream_t stream) {
    static int grid = 0;
    if (grid == 0) {
        if (n_in != 24 || out_size != SEQ * D || ws_size < WS_END) { fprintf(stderr, "kernel_launch: unexpected shapes (n_in %d, out %d, ws %zu < %zu)\n", n_in, out_size, ws_size, (size_t)WS_END); grid = -1; return; }
        int dev = 0, cus = 0, per_cu = 0;
        if (hipGetDevice(&dev) != hipSuccess || hipDeviceGetAttribute(&cus, hipDeviceAttributeMultiprocessorCount, dev) != hipSuccess) { grid = -1; return; }
        if (hipFuncSetAttribute((const void*)mk_fwd, hipFuncAttributeMaxDynamicSharedMemorySize, LDS_BYTES) != hipSuccess) { fprintf(stderr, "kernel_launch: hipFuncSetAttribute failed\n"); grid = -1; return; }
        if (hipOccupancyMaxActiveBlocksPerMultiprocessor(&per_cu, (const void*)mk_fwd, 512, LDS_BYTES) != hipSuccess || per_cu < 1) { fprintf(stderr, "kernel_launch: occupancy query says %d\n", per_cu); per_cu = 1; }
        (void)hipGetLastError();
        grid = cus;
        if (grid < 160) { fprintf(stderr, "kernel_launch: %d CUs is too few for this kernel's phase split\n", grid); grid = -1; return; }
    }
    if (grid < 0) return;
    (void)hipMemsetAsync((char*)d_ws + WS_CTL, 0, 1 * MiB, stream);
    Params p{};
    for (int i = 0; i < 24; ++i) p.in[i] = (const float*)d_in[i];
    p.out = (float*)d_out; p.ws = (unsigned char*)d_ws;
#if N_LAUNCHES == 2
    p.ph_lo = 0; p.ph_hi = NPHASE;
    hipLaunchKernelGGL(mk_fwd, dim3(grid), dim3(512), LDS_BYTES, stream, p);
#elif N_LAUNCHES == 1
    p.ph_lo = 0; p.ph_hi = NPHASE;
    void* args[] = {&p};
    hipError_t e = hipLaunchCooperativeKernel((const void*)mk_fwd, dim3(grid), dim3(512), args, LDS_BYTES, stream);
    if (e != hipSuccess) fprintf(stderr, "cooperative launch failed: %s (grid %d)\n", hipGetErrorString(e), grid);
#else
    for (int k = 0; k < NPHASE; ++k) { p.ph_lo = k; p.ph_hi = k + 1; hipLaunchKernelGGL(mk_fwd, dim3(grid), dim3(512), LDS_BYTES, stream, p);
#ifdef REP_PHASE
        if (k == REP_PHASE) hipLaunchKernelGGL(mk_fwd, dim3(grid), dim3(512), LDS_BYTES, stream, p);
#endif
    }
#endif
}
```

```cpp
#define STAGE 4
#define N_LAUNCHES 2
#include <hip/hip_runtime.h>
#include <hip/hip_cooperative_groups.h>
#include <cstdio>
#include <cstdint>
namespace cg = cooperative_groups;

#define LAS __attribute__((address_space(3)))
#define GAS __attribute__((address_space(1)))
typedef unsigned short bf16_t;
typedef short bf16x8 __attribute__((ext_vector_type(8)));
typedef float f32x4 __attribute__((ext_vector_type(4)));
typedef float f32x2 __attribute__((ext_vector_type(2)));
typedef unsigned u32x4 __attribute__((ext_vector_type(4)));
typedef unsigned u32x2 __attribute__((ext_vector_type(2)));
typedef __bf16 bf16x2_t __attribute__((ext_vector_type(2)));

#ifndef PATPROBE
#define PATPROBE 0
#endif
constexpr int D = 2048, SEQ = 8192, CTXL = 256, MTOT = SEQ + CTXL;
constexpr int INC = 5136, NPAD = 5376;
constexpr int NCH = SEQ / 64, NCHT = MTOT / 64;
constexpr int NEXP = 32, DEXP = 512;
constexpr float EPSF = 1e-6f;

constexpr size_t MiB = 1u << 20;
constexpr size_t WS_CTL = 0;
constexpr size_t WS_MOD = 1 * MiB;
constexpr size_t WS_GATES = 2 * MiB;
constexpr size_t WS_E = 3 * MiB;
constexpr size_t WS_BC = 3 * MiB + 288 * 1024;
constexpr size_t WS_GC = 3 * MiB + 576 * 1024;
constexpr size_t WS_NST = 4 * MiB;
constexpr size_t WS_SUMSQ = 5 * MiB;
constexpr size_t WS_ROUTE = 6 * MiB;
constexpr size_t WS_WRP = 7 * MiB;
constexpr size_t WS_WPOOLS = 8 * MiB;
constexpr size_t WS_WOUTT = 9 * MiB;
constexpr size_t WS_WINT = 17 * MiB;
constexpr size_t WS_W13T = 38 * MiB;
constexpr size_t WS_W2T = 166 * MiB;
constexpr size_t WS_XN = 230 * MiB;
constexpr size_t WS_UP = 263 * MiB;
constexpr size_t WS_UQ = 279 * MiB;
constexpr size_t WS_A2 = 230 * MiB;
constexpr size_t WS_UO = 295 * MiB;
constexpr size_t WS_UK = 311 * MiB;
constexpr size_t WS_UV = 328 * MiB;
constexpr size_t WS_QC = 345 * MiB;
constexpr size_t WS_KC = 361 * MiB;
constexpr size_t WS_KT = 378 * MiB;
constexpr size_t WS_VT = 395 * MiB;
constexpr size_t WS_VSF = 413 * MiB;
constexpr size_t WS_VSB = 431 * MiB;
constexpr size_t WS_CST = 449 * MiB;
constexpr size_t WS_Y = 449 * MiB;
constexpr size_t WS_H = 545 * MiB;
constexpr size_t WS_FNS = 295 * MiB;
constexpr size_t WS_FN = 295 * MiB;
constexpr size_t WS_PTOK = 4 * MiB;
constexpr size_t WS_END = 577 * MiB;
constexpr int MAXSLOT = 24576;

constexpr int RING_BYTES = 131072;
constexpr int LDSCTL_OFF = RING_BYTES;
constexpr int LDS_BYTES = 147456;

__device__ __forceinline__ float bf2f(unsigned short b) { return __uint_as_float((unsigned)b << 16); }
__device__ __forceinline__ unsigned cvtpk(float lo, float hi) { f32x2 v = {lo, hi}; bf16x2_t b = __builtin_convertvector(v, bf16x2_t); return __builtin_bit_cast(unsigned, b); }
__device__ __forceinline__ float bflo(unsigned w) { return __uint_as_float(w << 16); }
__device__ __forceinline__ float bfhi(unsigned w) { return __uint_as_float(w & 0xffff0000u); }
__device__ __forceinline__ float siluf(float x) { return x / (1.0f + __expf(-x)); }
__device__ __forceinline__ float sigmoidf_(float x) { return 1.0f / (1.0f + __expf(-x)); }
__device__ __forceinline__ float logsigmoidf_(float x) { return fminf(x, 0.f) - log1pf(__expf(-fabsf(x))); }
__device__ __forceinline__ float wave_sum(float v) {
#pragma unroll
    for (int o = 1; o < 64; o <<= 1) v += __shfl_xor(v, o);
    return v;
}
__device__ __forceinline__ float wave_max(float v) {
#pragma unroll
    for (int o = 1; o < 64; o <<= 1) v = fmaxf(v, __shfl_xor(v, o));
    return v;
}
__device__ __forceinline__ int otid() { int t = threadIdx.x; asm volatile("" : "+v"(t)); return t; }
#define LDS_WAIT() asm volatile("s_waitcnt lgkmcnt(0)" ::: "memory")
#define VM_WAIT() asm volatile("s_waitcnt vmcnt(0)" ::: "memory")

struct Params { const float* in[24]; float* out; unsigned char* ws; int ph_lo, ph_hi; };
enum { I_X = 0, I_C, I_CTX, I_CCTX, I_WMOD, I_BMOD, I_N1G, I_WIN, I_WCQ, I_WCK, I_GB, I_HNG, I_WPOOL, I_PSC, I_WOUT, I_N2G, I_WGRP, I_BGRP, I_WRT, I_BRT, I_W1, I_W3, I_W2, I_FG };
namespace pg8 {
constexpr int BM = 256, BK = 64, HALF = 128, HTB = HALF * BK * 2, STAGE_BYTES = 8 * HTB, NXCD = 8, WGM = 8;
__host__ __device__ __forceinline__ int lds_byte(int r, int c) { const int st = (r >> 4) * 2 + (c >> 5), rr = r & 15, cc = c & 31, ob = rr * 64 + cc * 2; return st * 1024 + (ob ^ (((ob >> 9) & 1) << 5)); }
__host__ __device__ __forceinline__ void stage_rc(int b, int& R, int& C) { const int st = b / 1024, sb = b % 1024, swz = sb ^ (((sb >> 9) & 1) << 5); R = (st >> 1) * 16 + swz / 64; C = (st & 1) * 32 + (swz % 64) / 2; }
__host__ __device__ __forceinline__ int perm32(int rho) { const int n = rho >> 4, i = rho & 15; return 8 * (i >> 2) + 4 * n + (i & 3); }

struct Unit { int am, bn, acol, ex; };
struct Gemm { const bf16_t* A; const bf16_t* Bt; int lda, ldb, K; };

__device__ __forceinline__ void static_unit(int L, int nM, int nN, int& pm, int& pn) {
    const int nwg = nM * nN; int wgid = L; { const int q = nwg / NXCD, r = nwg % NXCD, xcd = wgid % NXCD, off = wgid / NXCD; wgid = (xcd < r ? xcd * (q + 1) : r * (q + 1) + (xcd - r) * q) + off; }
    const int nig = WGM * nN, gid = wgid / nig, fm = gid * WGM, gsz = (nM - fm) < WGM ? (nM - fm) : WGM;
    pm = fm + ((wgid % nig) % gsz); pn = (wgid % nig) / gsz;
}

template <class Epi, class Sched>
__device__ __forceinline__ void gemm_phase(LAS unsigned char* lds, const Gemm g, const Sched& S, const Epi& E) {
    const int tid = otid(), wid = __builtin_amdgcn_readfirstlane(tid >> 6), lane = tid & 63, wr = wid >> 2, wc = wid & 3, fr = lane & 15, fq = lane >> 4;
    const int K = g.K, nt = K / BK;
    unsigned voffA[2], voffB[2];
#pragma unroll
    for (int i = 0; i < 2; ++i) { int R, C; stage_rc(tid * 16 + i * 8192, R, C); const int Rb = Epi::PERM ? ((R & ~31) + perm32(R & 31)) : R;
        voffA[i] = (unsigned)(R * g.lda + C) * 2u; voffB[i] = (unsigned)(Rb * g.ldb + C) * 2u; }
    const size_t kstep = (size_t)(BK * 2);
    const size_t hstepA = (size_t)HALF * g.lda * 2, hstepB = (size_t)HALF * g.ldb * 2;
    const size_t tstepA = 2 * hstepA, tstepB = 2 * hstepB;
    const unsigned ldsw = (unsigned)wid * 1024u;
    const int aoff = lds_byte(wr * 64 + fr, fq * 8), boff = lds_byte(wc * 32 + fr, fq * 8);
#define PG8_SA(b, h) (((b) * 2 + (h)) * HTB)
#define PG8_SB(b, h) ((4 + (b) * 2 + (h)) * HTB)
#define PG8_STAGE(bufoff, gbase, voff) do { _Pragma("unroll") for (int _i = 0; _i < 2; ++_i) \
        __builtin_amdgcn_global_load_lds((const unsigned*)((const char*)(gbase) + (voff)[_i]), (LAS unsigned*)(lds + (bufoff) + ldsw + _i * 8192), 16, 0, 0); } while (0)
#define PG8_STAGE_A(bufoff, gbase, hh, vv) do { if constexpr (Sched::GATHER) { PG8_STAGE(bufoff, gbase, (vv)[hh]); } else { PG8_STAGE(bufoff, (gbase) + (hh) * hstepA, voffA); } } while (0)
#define PG8_LDA(dst, b, h) do { _Pragma("unroll") for (int m = 0; m < 4; ++m) _Pragma("unroll") for (int k = 0; k < 2; ++k) dst[m][k] = *(const LAS bf16x8*)(lds + PG8_SA(b, h) + aoff + m * 2048 + k * 1024); } while (0)
#define PG8_LDB(dst, b, h) do { _Pragma("unroll") for (int n = 0; n < 2; ++n) _Pragma("unroll") for (int k = 0; k < 2; ++k) dst[n][k] = *(const LAS bf16x8*)(lds + PG8_SB(b, h) + boff + n * 2048 + k * 1024); } while (0)
#define PG8_MMA(ai, bj, At, Bt) do { __builtin_amdgcn_s_setprio(1); _Pragma("unroll") for (int m = 0; m < 4; ++m) _Pragma("unroll") for (int n = 0; n < 2; ++n) _Pragma("unroll") for (int k = 0; k < 2; ++k) \
        acc[ai][bj][m][n] = __builtin_amdgcn_mfma_f32_16x16x32_bf16(Bt[n][k], At[m][k], acc[ai][bj][m][n], 0, 0, 0); __builtin_amdgcn_s_setprio(0); } while (0)
#define PG8_WAIT_V(n) asm volatile("s_waitcnt vmcnt(" #n ")" ::: "memory")
#define PG8_WAIT_L(n) asm volatile("s_waitcnt lgkmcnt(" #n ")" ::: "memory")
#define PG8_BAR __builtin_amdgcn_s_barrier()
#define PG8_SCHED __builtin_amdgcn_sched_barrier(0)
    Unit cur, nxt; int ui = 0;
    if (!S.next(0, cur)) return;
    unsigned vaC[2][2], vaN[2][2];
    int gR[2], gC[2];
#pragma unroll
    for (int i = 0; i < 2; ++i) stage_rc(tid * 16 + i * 8192, gR[i], gC[i]);
    if constexpr (Sched::GATHER) {
#pragma unroll
        for (int hh = 0; hh < 2; ++hh)
#pragma unroll
            for (int i = 0; i < 2; ++i) vaC[hh][i] = (unsigned)(S.arow(cur, hh * HALF + gR[i]) * g.lda + gC[i]) * 2u;
    }
    f32x4 acc[2][2][4][2];
#pragma unroll
    for (int a = 0; a < 2; ++a)
#pragma unroll
        for (int b = 0; b < 2; ++b)
#pragma unroll
            for (int m = 0; m < 4; ++m)
#pragma unroll
                for (int n = 0; n < 2; ++n) acc[a][b][m][n] = (f32x4){0.f, 0.f, 0.f, 0.f};
    bf16x8 At[4][2], B0[2][2], B1[2][2];
    const char* cA = Sched::GATHER ? (const char*)g.A : (const char*)g.A + (size_t)cur.am * tstepA + (size_t)cur.acol * 2; const char* cB = (const char*)g.Bt + (size_t)cur.bn * tstepB;
    PG8_STAGE(PG8_SB(0, 0), cB, voffB); PG8_STAGE(PG8_SB(0, 1), cB + hstepB, voffB); PG8_STAGE_A(PG8_SA(0, 0), cA, 0, vaC); PG8_STAGE_A(PG8_SA(0, 1), cA, 1, vaC);
    if (wr == 1) PG8_BAR;
    PG8_WAIT_V(2); PG8_BAR;
    PG8_STAGE(PG8_SB(1, 0), cB + kstep, voffB); PG8_STAGE_A(PG8_SA(1, 0), cA + kstep, 0, vaC); PG8_STAGE(PG8_SB(1, 1), cB + hstepB + kstep, voffB);
    PG8_WAIT_V(6); PG8_BAR;
    for (;;) {
        const bool has_next = S.next(ui + 1, nxt);
        if constexpr (Sched::GATHER) {
#pragma unroll
            for (int hh = 0; hh < 2; ++hh)
#pragma unroll
                for (int i = 0; i < 2; ++i) vaN[hh][i] = has_next ? (unsigned)(S.arow(nxt, hh * HALF + gR[i]) * g.lda + gC[i]) * 2u : vaC[hh][i];
        }
        const char* nA = Sched::GATHER ? cA : (has_next ? (const char*)g.A + (size_t)nxt.am * tstepA + (size_t)nxt.acol * 2 : cA); const char* nB = has_next ? (const char*)g.Bt + (size_t)nxt.bn * tstepB : cB;
#pragma unroll 1
        for (int t = 0; t < nt; t += 2) {
            const bool last = (t == nt - 2);
            const char* a1 = cA + (size_t)(t + 1) * kstep;
            const char* a2 = last ? nA : cA + (size_t)(t + 2) * kstep; const char* b2 = last ? nB : cB + (size_t)(t + 2) * kstep;
            const char* a3 = a2 + kstep; const char* b3 = b2 + kstep;
            PG8_LDB(B0, 0, 0); PG8_LDB(B1, 0, 1); PG8_SCHED; PG8_LDA(At, 0, 0); PG8_STAGE_A(PG8_SA(1, 1), a1, 1, vaC);
            PG8_WAIT_V(8); PG8_WAIT_L(0); PG8_BAR; PG8_MMA(0, 0, At, B0); PG8_MMA(0, 1, At, B1); PG8_BAR; PG8_SCHED;
            PG8_LDA(At, 0, 1); PG8_STAGE(PG8_SB(0, 0), b2, voffB); PG8_STAGE(PG8_SB(0, 1), b2 + hstepB, voffB); if (last) { PG8_STAGE_A(PG8_SA(0, 0), a2, 0, vaN); } else { PG8_STAGE_A(PG8_SA(0, 0), a2, 0, vaC); }
            PG8_WAIT_V(8); PG8_WAIT_L(0); PG8_BAR; PG8_MMA(1, 0, At, B0); PG8_MMA(1, 1, At, B1); PG8_BAR; PG8_SCHED;
            PG8_LDB(B0, 1, 0); PG8_LDB(B1, 1, 1); PG8_SCHED; PG8_LDA(At, 1, 0); if (last) { PG8_STAGE_A(PG8_SA(0, 1), a2, 1, vaN); } else { PG8_STAGE_A(PG8_SA(0, 1), a2, 1, vaC); }
            PG8_WAIT_V(8); PG8_WAIT_L(0); PG8_BAR; PG8_MMA(0, 0, At, B0); PG8_MMA(0, 1, At, B1); PG8_BAR; PG8_SCHED;
            PG8_LDA(At, 1, 1); PG8_STAGE(PG8_SB(1, 0), b3, voffB); PG8_STAGE(PG8_SB(1, 1), b3 + hstepB, voffB); if (last) { PG8_STAGE_A(PG8_SA(1, 0), a3, 0, vaN); } else { PG8_STAGE_A(PG8_SA(1, 0), a3, 0, vaC); }
            PG8_WAIT_V(8); PG8_WAIT_L(0); PG8_BAR; PG8_MMA(1, 0, At, B0); PG8_MMA(1, 1, At, B1); PG8_BAR; PG8_SCHED;
        }
        if (wr == 0) PG8_BAR;
        E(acc, cur, wr, wc, fr, fq);
        if (!has_next) break;
#pragma unroll
        for (int a = 0; a < 2; ++a)
#pragma unroll
            for (int b = 0; b < 2; ++b)
#pragma unroll
                for (int m = 0; m < 4; ++m)
#pragma unroll
                    for (int n = 0; n < 2; ++n) acc[a][b][m][n] = (f32x4){0.f, 0.f, 0.f, 0.f};
        cur = nxt; cA = nA; cB = nB; ++ui;
        if constexpr (Sched::GATHER) {
#pragma unroll
            for (int hh = 0; hh < 2; ++hh)
#pragma unroll
                for (int i = 0; i < 2; ++i) vaC[hh][i] = vaN[hh][i];
        }
        if (wr == 1) PG8_BAR;
    }
    PG8_WAIT_V(0);
    PG8_BAR;
#undef PG8_SA
#undef PG8_SB
#undef PG8_STAGE
#undef PG8_STAGE_A
#undef PG8_LDA
#undef PG8_LDB
#undef PG8_MMA
#undef PG8_WAIT_V
#undef PG8_WAIT_L
#undef PG8_BAR
#undef PG8_SCHED
}
}
using pg8::Unit;
struct SchedG1 { static constexpr bool GATHER = false; int G, c;
    __device__ __forceinline__ bool next(int i, Unit& u) const { const int L = i * G + c; if (L >= 681) return false;
        if (L < 672) { int pm, pn; pg8::static_unit(L, 32, 21, pm, pn); u.am = pm; u.bn = pn; } else { u.am = 32; u.bn = 12 + (L - 672); }
        u.acol = 0; u.ex = 0; return true; } };
struct EpiG1 { static constexpr bool PERM = true;
    unsigned char* ws; const float* gate_bias;
    __device__ __forceinline__ void operator()(const f32x4 (&acc)[2][2][4][2], const Unit& u, int wr, int wc, int fr, int fq) const {
        const int row0 = u.am * 256 + wr * 64 + fr; const int seg = u.bn >> 2;
        if (seg < 5) {
            const size_t so = seg == 0 ? WS_UP : seg == 1 ? WS_UQ : seg == 2 ? WS_UO : seg == 3 ? WS_UK : WS_UV;
            bf16_t* base = (bf16_t*)(ws + so); const int col0 = (u.bn & 3) * 256 + wc * 32 + 8 * fq;
#pragma unroll
            for (int ai = 0; ai < 2; ++ai)
#pragma unroll
                for (int m = 0; m < 4; ++m) { bf16_t* rowp = base + (size_t)(row0 + ai * 128 + m * 16) * 1024 + col0;
#pragma unroll
                    for (int bj = 0; bj < 2; ++bj) { const f32x4 v0 = acc[ai][bj][m][0], v1 = acc[ai][bj][m][1];
                        u32x4 w; w.x = cvtpk(v0[0], v0[1]); w.y = cvtpk(v0[2], v0[3]); w.z = cvtpk(v1[0], v1[1]); w.w = cvtpk(v1[2], v1[3]);
                        *(u32x4*)(rowp + bj * 128) = w; } }
        } else {
            if (wc == 0 && fq < 2) { float* G = (float*)(ws + WS_GATES);
                const f32x4 b0 = *(const f32x4*)(gate_bias + 8 * fq), b1 = *(const f32x4*)(gate_bias + 8 * fq + 4);
#pragma unroll
                for (int ai = 0; ai < 2; ++ai)
#pragma unroll
                    for (int m = 0; m < 4; ++m) { float* rowp = G + (size_t)(row0 + ai * 128 + m * 16) * 16 + 8 * fq;
                        *(f32x4*)(rowp) = acc[ai][0][m][0] + b0; *(f32x4*)(rowp + 4) = acc[ai][0][m][1] + b1; } }
        }
    } };
struct SchedWeff { static constexpr bool GATHER = false; int G, c;
    __device__ __forceinline__ bool next(int i, Unit& u) const { if (c < 0) return false; const int L = i * G + c; if (L >= 32) return false;
        u.am = L >> 2; u.bn = L & 3; u.acol = (L & 3) * 256; u.ex = 0; return true; } };
struct EpiWeff { static constexpr bool PERM = true;
    bf16_t* W;
    __device__ __forceinline__ void operator()(const f32x4 (&acc)[2][2][4][2], const Unit& u, int wr, int wc, int fr, int fq) const {
        const int row0 = u.am * 256 + wr * 64 + fr; const int col0 = u.bn * 256 + wc * 32 + 8 * fq;
#pragma unroll
        for (int ai = 0; ai < 2; ++ai)
#pragma unroll
            for (int m = 0; m < 4; ++m) { bf16_t* rowp = W + (size_t)(row0 + ai * 128 + m * 16) * 2048 + col0;
#pragma unroll
                for (int bj = 0; bj < 2; ++bj) { const f32x4 v0 = acc[ai][bj][m][0], v1 = acc[ai][bj][m][1];
                    u32x4 w; w.x = cvtpk(v0[0], v0[1]); w.y = cvtpk(v0[2], v0[3]); w.z = cvtpk(v1[0], v1[1]); w.w = cvtpk(v1[2], v1[3]);
                    *(u32x4*)(rowp + bj * 128) = w; } }
    } };
struct SchedG2 { static constexpr bool GATHER = false; int G, c;
    __device__ __forceinline__ bool next(int i, Unit& u) const { const int L = i * G + c; if (L >= 256) return false;
        int pm, pn; pg8::static_unit(L, 32, 8, pm, pn); u.am = pm; u.bn = pn; u.acol = 0; u.ex = 0; return true; } };
struct EpiG2 { static constexpr bool PERM = false;
    const float* x; const float* g1; float* out; float* sumsq;
    __device__ __forceinline__ void operator()(const f32x4 (&acc)[2][2][4][2], const Unit& u, int wr, int wc, int fr, int fq) const {
        const int row0 = u.am * 256 + wr * 64 + fr, col0 = u.bn * 256 + wc * 32 + 4 * fq;
        f32x4 gv[2][2];
#pragma unroll
        for (int bj = 0; bj < 2; ++bj)
#pragma unroll
            for (int n = 0; n < 2; ++n) gv[bj][n] = *(const f32x4*)(g1 + col0 + bj * 128 + n * 16);
#pragma unroll
        for (int ai = 0; ai < 2; ++ai)
#pragma unroll
            for (int m = 0; m < 4; ++m) { const int row = row0 + ai * 128 + m * 16; const size_t off = (size_t)row * 2048 + col0; float ss = 0.f;
#pragma unroll
                for (int bj = 0; bj < 2; ++bj)
#pragma unroll
                    for (int n = 0; n < 2; ++n) { const f32x4 xv = *(const f32x4*)(x + off + bj * 128 + n * 16); const f32x4 h = xv + gv[bj][n] * acc[ai][bj][m][n];
                        *(f32x4*)(out + off + bj * 128 + n * 16) = h; ss += (h[0] * h[0] + h[1] * h[1]) + (h[2] * h[2] + h[3] * h[3]); }
                ss += __shfl_xor(ss, 16); ss += __shfl_xor(ss, 32);
                if (fq == 0) sumsq[(size_t)row * 32 + u.bn * 4 + wc] = ss; }
    } };
struct SchedMoE { static constexpr bool GATHER = false; int G, c, NN, btpe; const LAS int* tab;
    __device__ __forceinline__ bool next(int i, Unit& u) const { const int L = i * G + c; const int nt = tab[0]; if (L >= nt * NN) return false;
        const int tau = L / NN, pn = L - tau * NN; const int e = tab[1 + tau]; u.am = tau; u.bn = e * btpe + pn; u.acol = 0; u.ex = pn; return true; } };
struct SchedMoEG { static constexpr bool GATHER = true; int G, c, NN, btpe; const LAS int* tab; const int* ptok; const int* cnt;
    __device__ __forceinline__ bool next(int i, Unit& u) const { const int L = i * G + c; const int nt = tab[0]; if (L >= nt * NN) return false;
        const int tau = L / NN, pn = L - tau * NN; const int e = tab[1 + tau]; u.am = tau; u.bn = e * btpe + pn; u.acol = e; u.ex = pn; return true; }
    __device__ __forceinline__ int arow(const Unit& u, int r) const { const int e = u.acol; const int pos = (u.am - tab[128 + e]) * 256 + r; return pos < cnt[e * 64] ? ptok[e * 8192 + pos] : 0; } };
struct EpiUp { static constexpr bool PERM = true;
    bf16_t* H;
    __device__ __forceinline__ void operator()(const f32x4 (&acc)[2][2][4][2], const Unit& u, int wr, int wc, int fr, int fq) const {
        const int row0 = u.am * 256 + wr * 64 + fr; const int col0 = u.ex * 128 + wc * 16 + 4 * fq;
#pragma unroll
        for (int ai = 0; ai < 2; ++ai)
#pragma unroll
            for (int m = 0; m < 4; ++m) { bf16_t* rowp = H + (size_t)(row0 + ai * 128 + m * 16) * 512 + col0;
#pragma unroll
                for (int bj = 0; bj < 2; ++bj) { const f32x4 v0 = acc[ai][bj][m][0], v1 = acc[ai][bj][m][1];
                    u32x2 w; w.x = cvtpk(siluf(v0[0]) * v0[1], siluf(v0[2]) * v0[3]); w.y = cvtpk(siluf(v1[0]) * v1[1], siluf(v1[2]) * v1[3]);
                    *(u32x2*)(rowp + bj * 64) = w; } }
    } };
struct EpiDown { static constexpr bool PERM = true;
    bf16_t* Y;
    __device__ __forceinline__ void operator()(const f32x4 (&acc)[2][2][4][2], const Unit& u, int wr, int wc, int fr, int fq) const {
        const int row0 = u.am * 256 + wr * 64 + fr; const int col0 = u.ex * 256 + wc * 32 + 8 * fq;
#pragma unroll
        for (int ai = 0; ai < 2; ++ai)
#pragma unroll
            for (int m = 0; m < 4; ++m) { bf16_t* rowp = Y + (size_t)(row0 + ai * 128 + m * 16) * 2048 + col0;
#pragma unroll
                for (int bj = 0; bj < 2; ++bj) { const f32x4 v0 = acc[ai][bj][m][0], v1 = acc[ai][bj][m][1];
                    u32x4 w; w.x = cvtpk(v0[0], v0[1]); w.y = cvtpk(v0[2], v0[3]); w.z = cvtpk(v1[0], v1[1]); w.w = cvtpk(v1[2], v1[3]);
                    *(u32x4*)(rowp + bj * 128) = w; } }
    } };
__device__ __forceinline__ void p0_adaln(const Params& P, LAS unsigned char* lds) {
    const int tid = otid();
    LAS float* sc = (LAS float*)lds; LAS float* scc = sc + 2048; LAS float* red = scc + 2048; LAS float* red2 = red + 42 * 48;
    const float* c = P.in[I_C]; const float* cc = P.in[I_CCTX]; const float* wmod = P.in[I_WMOD]; const float* bmod = P.in[I_BMOD];
    float* mod = (float*)(P.ws + WS_MOD); float* modc = mod + 16384;
    for (int i = tid; i < 2048; i += 512) { sc[i] = siluf(c[i]); scc[i] = siluf(cc[i]); }
    __syncthreads();
    for (int cb = blockIdx.x; cb < 256; cb += gridDim.x) {
        const int n0 = 48 * cb; const bool has_ctx = n0 < 4096;
        if (tid < 504) { const int col4 = tid % 12, rg = tid / 12;
            const f32x4* wp = (const f32x4*)(wmod + n0) + col4;
            f32x4 a = {0.f, 0.f, 0.f, 0.f}, a2 = {0.f, 0.f, 0.f, 0.f};
#pragma unroll 7
            for (int k = rg; k < 2048; k += 42) { const f32x4 w = wp[(size_t)k * 3072]; a += w * sc[k]; if (has_ctx) a2 += w * scc[k]; }
            *(LAS f32x4*)(red + rg * 48 + col4 * 4) = a; *(LAS f32x4*)(red2 + rg * 48 + col4 * 4) = a2; }
        __syncthreads();
        if (tid < 48) { float s = 0.f; for (int r = 0; r < 42; ++r) s += red[r * 48 + tid]; mod[n0 + tid] = s + bmod[n0 + tid]; }
        else if (has_ctx && tid >= 64 && tid < 112) { const int t = tid - 64; if (n0 + t < 4096) { float s = 0.f; for (int r = 0; r < 42; ++r) s += red2[r * 48 + t]; modc[n0 + t] = s + bmod[n0 + t]; } }
        __syncthreads();
    }
}
struct TrItem { const float* src; bf16_t* dst; int K, N, rmul; const float* nscale; bool ok; };
constexpr int I_IN = 32 * 161, I_OUT = 32 * 64, I_PL = 4 * 32, I_E13 = 32 * 16, I_E2 = 8 * 64;
constexpr int B_OUT = I_IN, B_PL = B_OUT + I_OUT, B_W1 = B_PL + I_PL, B_W3 = B_W1 + 32 * I_E13, B_W2 = B_W3 + 32 * I_E13, B_END = B_W2 + 32 * I_E2;
__device__ __forceinline__ void tr_decode(const Params& P, int it, int lane, const float*& W, bf16_t*& WT, int& K, int& N, int& row_off, int& rmul, int& item) {
    if (it < B_OUT) { W = P.in[I_WIN]; K = 2048; N = INC; WT = (bf16_t*)(P.ws + WS_WINT); row_off = 0; rmul = 1; item = it; }
    else if (it < B_W1) { W = P.in[I_WOUT]; K = 2048; N = 2048; WT = (bf16_t*)(P.ws + WS_WOUTT); row_off = 0; rmul = 1; item = it - B_OUT; }
    else if (it < B_W3) { const int r = it - B_W1, e = r / I_E13; W = P.in[I_W1] + (size_t)e * 2048 * 512; K = 2048; N = 512; WT = (bf16_t*)(P.ws + WS_W13T) + (size_t)e * 1024 * 2048; row_off = 0; rmul = 2; item = r - e * I_E13; }
    else if (it < B_W2) { const int r = it - B_W3, e = r / I_E13; W = P.in[I_W3] + (size_t)e * 2048 * 512; K = 2048; N = 512; WT = (bf16_t*)(P.ws + WS_W13T) + (size_t)e * 1024 * 2048; row_off = 1; rmul = 2; item = r - e * I_E13; }
    else { const int r = it - B_W2, e = r / I_E2; W = P.in[I_W2] + (size_t)e * 512 * 2048; K = 512; N = 2048; WT = (bf16_t*)(P.ws + WS_W2T) + (size_t)e * 2048 * 512; row_off = 0; rmul = 1; item = r - e * I_E2; }
}
__device__ __forceinline__ void tr_load(const Params& P, int it, int lane, f32x4 (&v)[8]) {
    const float* W; bf16_t* WT; int K, N, row_off, rmul, item; tr_decode(P, it, lane, W, WT, K, N, row_off, rmul, item);
    const int nblk = (N + 31) >> 5, kb = item / nblk, nb = item - kb * nblk, k0 = 64 * kb, n0 = 32 * nb; const int nn = n0 + 4 * (lane & 7); const bool ok = nn < N;
#pragma unroll
    for (int i = 0; i < 8; ++i) { const int kk = 8 * i + (lane >> 3); v[i] = ok ? *(const f32x4*)(W + (size_t)(k0 + kk) * N + nn) : (f32x4){0.f, 0.f, 0.f, 0.f}; }
}
__device__ __forceinline__ void tr_store(const Params& P, int it, int lane, const f32x4 (&v)[8], LAS float* scr) {
    const float* W; bf16_t* WT; int K, N, row_off, rmul, item; tr_decode(P, it, lane, W, WT, K, N, row_off, rmul, item);
    const int nblk = (N + 31) >> 5, kb = item / nblk, nb = item - kb * nblk, k0 = 64 * kb, n0 = 32 * nb; const int c4 = lane & 7;
#pragma unroll
    for (int i = 0; i < 8; ++i) { const int kk = 8 * i + (lane >> 3); LAS float* d = scr + kk * 33 + 4 * c4; d[0] = v[i][0]; d[1] = v[i][1]; d[2] = v[i][2]; d[3] = v[i][3]; }
    LDS_WAIT(); asm volatile("" ::: "memory");
    const int cch = lane & 7;
#pragma unroll
    for (int j = 0; j < 4; ++j) { const int n = (lane >> 3) + 8 * j; const LAS float* s = scr + (8 * cch) * 33 + n;
        u32x4 o; o.x = cvtpk(s[0 * 33], s[1 * 33]); o.y = cvtpk(s[2 * 33], s[3 * 33]); o.z = cvtpk(s[4 * 33], s[5 * 33]); o.w = cvtpk(s[6 * 33], s[7 * 33]);
        *(u32x4*)(WT + (size_t)(row_off + (n0 + n) * rmul) * K + k0 + 8 * cch) = o; }
    LDS_WAIT(); asm volatile("" ::: "memory");
}
__device__ __forceinline__ void p0_transposes(const Params& P, LAS unsigned char* lds, int lo_item, int hi_item, int gw, int NGW) {
    const int tid = otid(), lane = tid & 63, wave = __builtin_amdgcn_readfirstlane(tid >> 6);
    LAS float* scr = (LAS float*)(lds + 32768 + wave * 8704);
    if (hi_item > B_END) hi_item = B_END;
    int it = lo_item + gw; if (it >= hi_item) return;
    if (it >= B_PL && it < B_W1) it += NGW * ((B_W1 - it + NGW - 1) / NGW);
    if (it >= hi_item) return;
    f32x4 va[8], vb[8];
    tr_load(P, it, lane, va);
    for (;;) {
        int nx = it + NGW; if (nx >= B_PL && nx < B_W1) nx += NGW * ((B_W1 - nx + NGW - 1) / NGW);
        const bool h1 = nx < hi_item; if (h1) tr_load(P, nx, lane, vb);
        tr_store(P, it, lane, va, scr); if (!h1) break; it = nx;
        nx = it + NGW; if (nx >= B_PL && nx < B_W1) nx += NGW * ((B_W1 - nx + NGW - 1) / NGW);
        const bool h2 = nx < hi_item; if (h2) tr_load(P, nx, lane, va);
        tr_store(P, it, lane, vb, scr); if (!h2) break; it = nx;
    }
}
__device__ __forceinline__ int moe_run_item(int r, int kbi, int wave) {
    if (r < 512) { const int m = r >> 8, rr = r & 255, e = rr >> 3, q = rr & 7, nb = (q >> 2) * 8 + wave, kb = (q & 3) * 8 + kbi; return (m == 0 ? B_W1 : B_W3) + e * I_E13 + kb * 16 + nb; }
    const int r2 = r - 512, e = r2 >> 3, nb = (r2 & 7) * 8 + wave; return B_W2 + e * I_E2 + kbi * 64 + nb;
}
__device__ __forceinline__ void moe_run(const Params& P, LAS float* scr, int r, int lane, int wave) {
    f32x4 va[8], vb[8];
    tr_load(P, moe_run_item(r, 0, wave), lane, va);
#pragma unroll 1
    for (int kbi = 0; kbi < 8; kbi += 2) {
        tr_load(P, moe_run_item(r, kbi + 1, wave), lane, vb);
        tr_store(P, moe_run_item(r, kbi, wave), lane, va, scr);
        if (kbi + 2 < 8) tr_load(P, moe_run_item(r, kbi + 2, wave), lane, va);
        tr_store(P, moe_run_item(r, kbi + 1, wave), lane, vb, scr);
    }
}
__device__ __forceinline__ void p0_moe_weights(const Params& P, LAS unsigned char* lds, int rlo, int rhi) {
    const int tid = otid(), lane = tid & 63, wave = __builtin_amdgcn_readfirstlane(tid >> 6);
    LAS float* scr = (LAS float*)(lds + 32768 + wave * 8704);
    for (int r = rlo + blockIdx.x; r < rhi; r += gridDim.x) moe_run(P, scr, r, lane, wave);
}
__device__ __forceinline__ void moe_pull_runs(const Params& P, LAS unsigned char* lds, int ctr_word, int base, int limit) {
    const int tid = otid(), lane = tid & 63, wave = __builtin_amdgcn_readfirstlane(tid >> 6);
    LAS float* scr = (LAS float*)(lds + 32768 + wave * 8704); volatile LAS int* slot = (volatile LAS int*)(lds + LDS_BYTES - 384);
    for (;;) {
        __syncthreads();
        if (tid == 0) *slot = base + atomicAdd((int*)(P.ws + WS_CTL) + ctr_word, 1);
        __syncthreads();
        const int r = *slot; if (r >= limit) break;
        moe_run(P, scr, r, lane, wave);
    }
}
constexpr int RUNS_P0 = 373, RUNS_W13 = 512, RUNS_ALL = 768;
constexpr int TR_ITEMS_EARLY = 32 * 161 + 32 * 64 + 4 * 32;
constexpr int TR_ITEMS_ALL = TR_ITEMS_EARLY + 64 * 512 + 32 * 512;
#ifndef TR_SPLIT_PCT
#define TR_SPLIT_PCT 50
#endif
constexpr int TR_ITEMS_MID = TR_ITEMS_EARLY + (int)((long)(TR_ITEMS_ALL - TR_ITEMS_EARLY) * TR_SPLIT_PCT / 100);
__device__ __forceinline__ void p0_wpool_scaled(const Params& P) {
    const float* wp = P.in[I_WPOOL]; const float* ps = P.in[I_PSC]; u32x2* o = (u32x2*)(P.ws + WS_WPOOLS);
    for (int i = blockIdx.x * 512 + threadIdx.x; i < 65536; i += gridDim.x * 512) { const f32x4 w = *(const f32x4*)(wp + (size_t)4 * i); const int g = i >> 14, d0 = (4 * i) & 255; const f32x4 sc = *(const f32x4*)(ps + g * 256 + d0);
        const f32x4 y = w * sc; u32x2 r; r.x = cvtpk(y[0], y[1]); r.y = cvtpk(y[2], y[3]); o[i] = r; }
}
__device__ __forceinline__ void p0_zero_pad(const Params& P) {
    u32x4* z = (u32x4*)((bf16_t*)(P.ws + WS_WINT) + (size_t)5152 * 2048); const int n = (NPAD - 5152) * 2048 / 8;
    for (int i = blockIdx.x * 512 + threadIdx.x; i < n; i += gridDim.x * 512) z[i] = (u32x4){0u, 0u, 0u, 0u};
}
__device__ __forceinline__ void p1_router_prep(const Params& P) {
    const int tid = otid(), lane = tid & 63, wave = tid >> 6;
    const float* mod = (const float*)(P.ws + WS_MOD); const float* g = P.in[I_N2G]; const float* wg = P.in[I_WGRP]; const float* wr = P.in[I_WRT];
    float* WRP = (float*)(P.ws + WS_WRP); float* BRP = (float*)(P.ws + WS_WRP + 448 * 1024);
    for (int idx = blockIdx.x * 512 + tid; idx < 2048 * 48; idx += gridDim.x * 512) { const int k = idx / 48, c = idx - 48 * k;
        const float w = c < 32 ? wr[k * 32 + c] : c < 36 ? wg[k * 4 + c - 32] : 0.f;
        WRP[(size_t)((k >> 2) * 48 + c) * 4 + (k & 3)] = w * g[k] * (1.0f + mod[8192 + k]); }
    if (wave == 0) for (int c = blockIdx.x; c < 48; c += gridDim.x) { float s = 0.f;
        if (c < 36) { for (int k = lane; k < 2048; k += 64) s += mod[6144 + k] * (c < 32 ? wr[k * 32 + c] : wg[k * 4 + c - 32]); s = wave_sum(s) + (c < 32 ? P.in[I_BRT][c] : P.in[I_BGRP][c - 32]); }
        if (lane == 0) BRP[c] = s; }
}
__device__ __forceinline__ void p1_xn(const Params& P, int nwg) {
    const int tid = otid(), lane = tid & 63, wave = tid >> 6;
    const int gw = blockIdx.x * 8 + wave, NGW = nwg * 8;
    const float* mod = (const float*)(P.ws + WS_MOD); const float* modc = mod + 16384; const float* g = P.in[I_N1G];
    bf16_t* XN = (bf16_t*)(P.ws + WS_XN);
    for (int pass = 0; pass < 2; ++pass) {
        const float* sh = pass == 0 ? mod : modc; const float* scl = pass == 0 ? mod + 2048 : modc + 2048;
        const float* src = pass == 0 ? P.in[I_X] : P.in[I_CTX]; const int nrows = pass == 0 ? SEQ : CTXL; const int rbase = pass == 0 ? 0 : SEQ;
        if (gw >= nrows) continue;
        f32x4 a[8], s[8];
#pragma unroll
        for (int j = 0; j < 8; ++j) { const int d0 = 4 * lane + 256 * j; const f32x4 gg = *(const f32x4*)(g + d0), sv = *(const f32x4*)(scl + d0); a[j] = gg * (sv + 1.0f); s[j] = *(const f32x4*)(sh + d0); }
        for (int r = gw; r < nrows; r += 2 * NGW) {
            const int r2 = r + NGW; const bool h2 = r2 < nrows; const int rr2 = h2 ? r2 : r;
            const f32x4* xr = (const f32x4*)(src + (size_t)r * D) + lane; const f32x4* xq = (const f32x4*)(src + (size_t)rr2 * D) + lane; f32x4 v[8], w[8]; float ss = 0.f, st = 0.f;
#pragma unroll
            for (int j = 0; j < 8; ++j) { v[j] = xr[64 * j]; w[j] = xq[64 * j]; }
#pragma unroll
            for (int j = 0; j < 8; ++j) { ss += (v[j][0] * v[j][0] + v[j][1] * v[j][1]) + (v[j][2] * v[j][2] + v[j][3] * v[j][3]); st += (w[j][0] * w[j][0] + w[j][1] * w[j][1]) + (w[j][2] * w[j][2] + w[j][3] * w[j][3]); }
            const float rstd = 1.0f / sqrtf(wave_sum(ss) * (1.0f / D) + EPSF), rstd2 = 1.0f / sqrtf(wave_sum(st) * (1.0f / D) + EPSF);
            u32x2* o = (u32x2*)(XN + (size_t)(rbase + r) * D) + lane; u32x2* o2 = (u32x2*)(XN + (size_t)(rbase + rr2) * D) + lane;
#pragma unroll
            for (int j = 0; j < 8; ++j) { const f32x4 y = v[j] * rstd * a[j] + s[j]; u32x2 pk; pk.x = cvtpk(y[0], y[1]); pk.y = cvtpk(y[2], y[3]); o[64 * j] = pk; }
            if (h2) {
#pragma unroll
                for (int j = 0; j < 8; ++j) { const f32x4 y = w[j] * rstd2 * a[j] + s[j]; u32x2 pk; pk.x = cvtpk(y[0], y[1]); pk.y = cvtpk(y[2], y[3]); o2[64 * j] = pk; } }
        }
    }
}
__device__ __forceinline__ void p3_qk_task(const Params& P, int isk, int jp, int h) {
    const int tid = otid(), o = tid >> 6, f4 = tid & 63;
    const bf16_t* U = (const bf16_t*)(P.ws + (isk ? WS_UK : WS_UQ)); const float* wc = P.in[isk ? I_WCK : I_WCQ];
    const int f0 = h * 256 + 4 * f4;
    const f32x4 w0 = *(const f32x4*)(wc + f0), w1 = *(const f32x4*)(wc + 1024 + f0), w2 = *(const f32x4*)(wc + 2048 + f0);
    const float osc = isk ? 1.0f : 0.0625f;
    u32x2 raw[2][10];
#pragma unroll
    for (int q = 0; q < 2; ++q) { const int j = 2 * jp + q; const int t0 = 64 * j, seq_lo = j < 128 ? 0 : SEQ, seq_hi = j < 128 ? SEQ : MTOT;
#pragma unroll
        for (int i = 0; i < 10; ++i) { const int t = t0 + 8 * o - 1 + i; raw[q][i] = (t >= seq_lo && t < seq_hi) ? *(const u32x2*)(U + (size_t)t * 1024 + f0) : (u32x2){0u, 0u}; } }
    bf16_t* R = (bf16_t*)(P.ws + (isk ? WS_KC : WS_QC)); bf16_t* KT = (bf16_t*)(P.ws + WS_KT);
#pragma unroll
    for (int q = 0; q < 2; ++q) { const int j = 2 * jp + q; const int t0 = 64 * j;
        float outv[8][4];
#pragma unroll
        for (int i = 0; i < 8; ++i) {
            const f32x4 a = {bflo(raw[q][i].x), bfhi(raw[q][i].x), bflo(raw[q][i].y), bfhi(raw[q][i].y)}, b = {bflo(raw[q][i + 1].x), bfhi(raw[q][i + 1].x), bflo(raw[q][i + 1].y), bfhi(raw[q][i + 1].y)},
                        c = {bflo(raw[q][i + 2].x), bfhi(raw[q][i + 2].x), bflo(raw[q][i + 2].y), bfhi(raw[q][i + 2].y)};
            const f32x4 s = a * w0 + b * w1 + c * w2;
#pragma unroll
            for (int e = 0; e < 4; ++e) outv[i][e] = siluf(s[e]) * osc;
        }
#pragma unroll
        for (int i = 0; i < 8; ++i) { u32x2 w; w.x = cvtpk(outv[i][0], outv[i][1]); w.y = cvtpk(outv[i][2], outv[i][3]); *(u32x2*)(R + (size_t)(t0 + 8 * o + i) * 1024 + f0) = w; }
        if (isk) {
#pragma unroll
            for (int e = 0; e < 4; ++e) { u32x4 w; w.x = cvtpk(outv[0][e], outv[1][e]); w.y = cvtpk(outv[2][e], outv[3][e]); w.z = cvtpk(outv[4][e], outv[5][e]); w.w = cvtpk(outv[6][e], outv[7][e]);
                *(u32x4*)(KT + ((size_t)(h * 132 + j) * 256 + 4 * f4 + e) * 64 + 8 * o) = w; } }
    }
}
__device__ __forceinline__ void p3_v_task(const Params& P, LAS unsigned char* lds, int j, int h) {
    const int tid = otid(), lane = tid & 63, wave = tid >> 6, o = tid >> 6, f4 = tid & 63;
    const int t0 = 64 * j; LAS float* wkl = (LAS float*)lds;
    const bf16_t* U = (const bf16_t*)(P.ws + WS_UV); const int f0 = h * 256 + 4 * f4;
    u32x2 vraw[8];
#pragma unroll
    for (int i = 0; i < 8; ++i) vraw[i] = *(const u32x2*)(U + (size_t)(t0 + 8 * o + i) * 1024 + f0);
    __syncthreads();
    if (wave < 2) { const int d = wave; const float* G = (const float*)(P.ws + WS_GATES) + (size_t)(t0 + lane) * 16;
        const float ig = G[(2 * d) * 4 + h], fg = G[(2 * d + 1) * 4 + h];
        float b = logsigmoidf_(fg);
        if (d == 0) {
#pragma unroll
            for (int s = 1; s < 64; s <<= 1) { const float t = __shfl_up(b, s); if (lane >= s) b += t; }
        } else {
#pragma unroll
            for (int s = 1; s < 64; s <<= 1) { const float t = __shfl_down(b, s); if (lane + s < 64) b += t; }
        }
        const float gtot = __shfl(b, d == 0 ? 63 : 0); const float e = ig - b; const float em = wave_max(e);
        const size_t ix = (size_t)(d * 4 + h) * MTOT + t0 + lane;
        ((float*)(P.ws + WS_E))[ix] = e; ((float*)(P.ws + WS_BC))[ix] = b;
        if (lane == 0) { float* gc = (float*)(P.ws + WS_GC); gc[(d * 4 + h) * 132 + j] = gtot; gc[2048 + (d * 4 + h) * 132 + j] = em; }
        wkl[d * 64 + lane] = __expf(e - em);
    }
    __syncthreads();
    float v[8][4];
#pragma unroll
    for (int i = 0; i < 8; ++i) { v[i][0] = bflo(vraw[i].x); v[i][1] = bfhi(vraw[i].x); v[i][2] = bflo(vraw[i].y); v[i][3] = bfhi(vraw[i].y); }
    bf16_t* VT = (bf16_t*)(P.ws + WS_VT); bf16_t* VSF = (bf16_t*)(P.ws + WS_VSF); bf16_t* VSB = (bf16_t*)(P.ws + WS_VSB);
    float sf[8], sb[8];
#pragma unroll
    for (int i = 0; i < 8; ++i) { sf[i] = wkl[8 * o + i]; sb[i] = wkl[64 + 8 * o + i]; }
#pragma unroll
    for (int e = 0; e < 4; ++e) { const size_t off = ((size_t)(h * 132 + j) * 272 + 4 * f4 + e) * 64 + 8 * o; u32x4 w;
        w.x = cvtpk(v[0][e], v[1][e]); w.y = cvtpk(v[2][e], v[3][e]); w.z = cvtpk(v[4][e], v[5][e]); w.w = cvtpk(v[6][e], v[7][e]); *(u32x4*)(VT + off) = w;
        w.x = cvtpk(v[0][e] * sf[0], v[1][e] * sf[1]); w.y = cvtpk(v[2][e] * sf[2], v[3][e] * sf[3]); w.z = cvtpk(v[4][e] * sf[4], v[5][e] * sf[5]); w.w = cvtpk(v[6][e] * sf[6], v[7][e] * sf[7]); *(u32x4*)(VSF + off) = w;
        w.x = cvtpk(v[0][e] * sb[0], v[1][e] * sb[1]); w.y = cvtpk(v[2][e] * sb[2], v[3][e] * sb[3]); w.z = cvtpk(v[4][e] * sb[4], v[5][e] * sb[5]); w.w = cvtpk(v[6][e] * sb[6], v[7][e] * sb[7]); *(u32x4*)(VSB + off) = w; }
    if (tid < 128) {
        const int rr = tid >> 3, oc = tid & 7; const size_t off = ((size_t)(h * 132 + j) * 272 + 256 + rr) * 64 + 8 * oc; u32x4 w1 = {0u, 0u, 0u, 0u}, wf = w1, wb = w1;
        if (rr == 0) { w1 = (u32x4){0x3f803f80u, 0x3f803f80u, 0x3f803f80u, 0x3f803f80u};
            wf.x = cvtpk(wkl[8 * oc], wkl[8 * oc + 1]); wf.y = cvtpk(wkl[8 * oc + 2], wkl[8 * oc + 3]); wf.z = cvtpk(wkl[8 * oc + 4], wkl[8 * oc + 5]); wf.w = cvtpk(wkl[8 * oc + 6], wkl[8 * oc + 7]);
            wb.x = cvtpk(wkl[64 + 8 * oc], wkl[64 + 8 * oc + 1]); wb.y = cvtpk(wkl[64 + 8 * oc + 2], wkl[64 + 8 * oc + 3]); wb.z = cvtpk(wkl[64 + 8 * oc + 4], wkl[64 + 8 * oc + 5]); wb.w = cvtpk(wkl[64 + 8 * oc + 6], wkl[64 + 8 * oc + 7]); }
        *(u32x4*)(VT + off) = w1; *(u32x4*)(VSF + off) = wf; *(u32x4*)(VSB + off) = wb; }
}
__device__ __forceinline__ void p3_pool_task(const Params& P, LAS unsigned char* lds, int r, int gi) {
    const int tid = otid(), chunk = tid & 31, cb = tid >> 5; const int win = 2 << gi, hw = win >> 1;
    const int rlo = max(r - hw, 0), rhi = min(r - hw + win, 128);
    const bf16_t* U = (const bf16_t*)(P.ws + WS_UP) + gi * 256 + 8 * chunk; LAS float* vs = (LAS float*)lds;
    __syncthreads();
    float own[4][8];
#pragma unroll
    for (int i = 0; i < 4; ++i) { const int c = cb + 16 * i; float a[8];
#pragma unroll
        for (int e = 0; e < 8; ++e) a[e] = 0.f;
        u32x4 wv[16];
#pragma unroll
        for (int q = 0; q < 16; ++q) { const int rr = rlo + q; wv[q] = (q < win && rr < rhi) ? *(const u32x4*)(U + (size_t)(rr * 64 + c) * 1024) : (u32x4){0u, 0u, 0u, 0u}; }
#pragma unroll
        for (int q = 0; q < 16; ++q) { const int rr = rlo + q; const u32x4 w = wv[q];
            const float x[8] = {bflo(w.x), bfhi(w.x), bflo(w.y), bfhi(w.y), bflo(w.z), bfhi(w.z), bflo(w.w), bfhi(w.w)};
#pragma unroll
            for (int e = 0; e < 8; ++e) a[e] += x[e];
            if (rr == r) {
#pragma unroll
                for (int e = 0; e < 8; ++e) own[i][e] = x[e]; } }
        *(LAS f32x4*)(vs + c * 256 + 8 * chunk) = (f32x4){a[0], a[1], a[2], a[3]}; *(LAS f32x4*)(vs + c * 256 + 8 * chunk + 4) = (f32x4){a[4], a[5], a[6], a[7]}; }
    __syncthreads();
    bf16_t* Dp = (bf16_t*)(P.ws + WS_A2) + gi * 256 + 8 * chunk;
#pragma unroll
    for (int i = 0; i < 4; ++i) { const int c = cb + 16 * i; const int clo = max(c - hw, 0), chi = min(c - hw + win, 64);
        f32x4 s0 = {0.f, 0.f, 0.f, 0.f}, s1 = s0;
        for (int cc = clo; cc < chi; ++cc) { s0 += *(const LAS f32x4*)(vs + cc * 256 + 8 * chunk); s1 += *(const LAS f32x4*)(vs + cc * 256 + 8 * chunk + 4); }
        const float inv = 1.0f / (float)((rhi - rlo) * (chi - clo));
        u32x4 w; w.x = cvtpk(s0[0] * inv - own[i][0], s0[1] * inv - own[i][1]); w.y = cvtpk(s0[2] * inv - own[i][2], s0[3] * inv - own[i][3]);
        w.z = cvtpk(s1[0] * inv - own[i][4], s1[1] * inv - own[i][5]); w.w = cvtpk(s1[2] * inv - own[i][6], s1[3] * inv - own[i][7]);
        *(u32x4*)(Dp + (size_t)(r * 64 + c) * 2048) = w; }
}
__device__ __forceinline__ void p3_all(const Params& P, LAS unsigned char* lds) {
    for (int t = blockIdx.x; t < 1560; t += gridDim.x) {
        if (t < 256) p3_qk_task(P, 0, t >> 2, t & 3);
        else if (t < 520) p3_qk_task(P, 1, (t - 256) >> 2, (t - 256) & 3);
        else if (t < 1048) p3_v_task(P, lds, (t - 520) >> 2, (t - 520) & 3);
        else p3_pool_task(P, lds, (t - 1048) >> 2, (t - 1048) & 3);
    }
}
__device__ __forceinline__ int step_chunk(int d, int j) { return d == 0 ? (j < 4 ? 128 + j : j - 4) : (j < 4 ? 131 - j : 131 - j); }
__device__ __forceinline__ void p4_state(const Params& P, LAS unsigned char* lds, int sb, bool dry = false) {
    const int tid = otid(), lane = tid & 63, wave = __builtin_amdgcn_readfirstlane(tid >> 6);
    const int hd = sb & 7, h = hd >> 1, d = hd & 1, lb = sb >> 3;
    LAS float* tg = (LAS float*)(lds + 110592); LAS float* te = tg + 132; LAS float* tm = te + 132; LAS float* tdec = tm + 132; LAS float* tsf = tdec + 132;
    const float* gc = (const float*)(P.ws + WS_GC);
    if (tid < 132) { const int ci = step_chunk(d, tid); tg[tid] = gc[(d * 4 + h) * 132 + ci]; te[tid] = gc[2048 + (d * 4 + h) * 132 + ci]; }
    __syncthreads();
    if (tid == 0) { float m = 0.f;
#pragma unroll 4
        for (int j = 0; j < 132; ++j) { tm[j] = m; m = tg[j] + fmaxf(m, te[j]); } }
    __syncthreads();
    if (tid < 132) { const float m = tm[tid], em = te[tid], Mf = fmaxf(m, em); tdec[tid] = __expf(m - Mf); tsf[tid] = __expf(em - Mf);
        if (lb == 0 && !dry) ((float*)(P.ws + WS_GC))[4096 + (d * 4 + h) * 132 + step_chunk(d, tid)] = m; }
    __syncthreads();
    if (wave >= 3) return;
    const int task = lb + 32 * wave; if (task >= 72) return;
    const int kq = task / 9, vq = task - 9 * kq; const bool two = vq < 8; const int vt0 = two ? 2 * vq : 16;
    const int fr = lane & 15, fq = lane >> 4;
    const bf16_t* KT = (const bf16_t*)(P.ws + WS_KT) + ((size_t)(h * 132) * 256 + kq * 32) * 64 + lane * 8;
    const bf16_t* VS = (const bf16_t*)(P.ws + (d == 0 ? WS_VSF : WS_VSB)) + ((size_t)(h * 132) * 272 + vt0 * 16) * 64 + lane * 8;
    const int vs1 = two ? 16 * 64 : 0;
    LAS unsigned char* wb = lds + wave * 9216;
    const int wofs = (lane >> 3) * 144 + 16 * (lane & 7), rofs = fr * 144 + 16 * fq;
    bf16_t* CST = (bf16_t*)(P.ws + WS_CST); float* NST = (float*)(P.ws + WS_NST);
    f32x4 C[2][2];
#pragma unroll
    for (int a = 0; a < 2; ++a)
#pragma unroll
        for (int b = 0; b < 2; ++b) C[a][b] = (f32x4){0.f, 0.f, 0.f, 0.f};
    u32x4 rg[4][8];
#define P4_LOAD(slot, jj) do { const size_t cj_ = (size_t)step_chunk(d, (jj)); const bf16_t* kp_ = KT + cj_ * (256 * 64); const bf16_t* vp_ = VS + cj_ * (272 * 64); \
        rg[slot][0] = *(const u32x4*)(kp_); rg[slot][1] = *(const u32x4*)(kp_ + 512); rg[slot][2] = *(const u32x4*)(kp_ + 1024); rg[slot][3] = *(const u32x4*)(kp_ + 1536); \
        rg[slot][4] = *(const u32x4*)(vp_); rg[slot][5] = *(const u32x4*)(vp_ + 512); rg[slot][6] = *(const u32x4*)(vp_ + vs1); rg[slot][7] = *(const u32x4*)(vp_ + vs1 + 512); } while (0)
    P4_LOAD(0, 0); P4_LOAD(1, 1); P4_LOAD(2, 2);
    for (int j0 = 0; j0 < 132; j0 += 4) {
#pragma unroll
        for (int u = 0; u < 4; ++u) { const int j = j0 + u;
            if (j + 3 < 132) P4_LOAD((u + 3) & 3, j + 3);
#pragma unroll
            for (int i = 0; i < 8; ++i) *(LAS u32x4*)(wb + (i >> 1) * 2304 + (i & 1) * 1152 + wofs) = rg[u][i];
            const int ci = step_chunk(d, j);
            if (ci < 128 && !dry) {
                const size_t rb = (((size_t)ci * 4 + h) * 2 + d) * 256;
                if (two) {
#pragma unroll
                    for (int a = 0; a < 2; ++a)
#pragma unroll
                        for (int b = 0; b < 2; ++b) { u32x2 w; w.x = cvtpk(C[a][b][0], C[a][b][1]); w.y = cvtpk(C[a][b][2], C[a][b][3]); *(u32x2*)(CST + (rb + (vt0 + b) * 16 + fr) * 256 + kq * 32 + 16 * a + 4 * fq) = w; }
                } else if (fr == 0) {
#pragma unroll
                    for (int a = 0; a < 2; ++a) *(f32x4*)(NST + rb + kq * 32 + 16 * a + 4 * fq) = C[a][0]; }
            }
            const float dec = tdec[j], sf = tsf[j];
            bf16x8 fa[2][2], fb[2][2];
#pragma unroll
            for (int t = 0; t < 2; ++t)
#pragma unroll
                for (int ks = 0; ks < 2; ++ks) { fa[t][ks] = *(const LAS bf16x8*)(wb + t * 2304 + rofs + 64 * ks); fb[t][ks] = *(const LAS bf16x8*)(wb + (2 + t) * 2304 + rofs + 64 * ks); }
#pragma unroll
            for (int a = 0; a < 2; ++a)
#pragma unroll
                for (int b = 0; b < 2; ++b) { f32x4 Dt = {0.f, 0.f, 0.f, 0.f};
#pragma unroll
                    for (int ks = 0; ks < 2; ++ks) Dt = __builtin_amdgcn_mfma_f32_16x16x32_bf16(fa[a][ks], fb[b][ks], Dt, 0, 0, 0);
                    C[a][b] = C[a][b] * dec + Dt * sf; }
        }
    }
#undef P4_LOAD
}
constexpr int O_QS = 0, O_KS = 33792, O_VT = 67584, O_WS = 106752, O_SC = 125184, O_DEN = 127232, O_RED = 127744, O_END = 131840;
__device__ __forceinline__ void p5_task(const Params& P, LAS unsigned char* lds, int c, int h) {
    const int tid = otid(), lane = tid & 63, wave = __builtin_amdgcn_readfirstlane(tid >> 6), fr = lane & 15, fq = lane >> 4;
    const int t0 = 64 * c;
    LAS float* Es = (LAS float*)(lds + O_SC); LAS float* Ms = Es + 128; LAS float* Wi = Ms + 128; LAS float* Fl = Wi + 128; LAS float* dens = (LAS float*)(lds + O_DEN); LAS float* red = (LAS float*)(lds + O_RED);
    __syncthreads();
    { const bf16_t* Q = (const bf16_t*)(P.ws + WS_QC) + (size_t)t0 * 1024 + h * 256; const bf16_t* Kc = (const bf16_t*)(P.ws + WS_KC) + (size_t)t0 * 1024 + h * 256;
#pragma unroll
      for (int i = 0; i < 4; ++i) { const int idx = tid + 512 * i, r = idx >> 5, ch = idx & 31;
          const u32x4 qv = *(const u32x4*)(Q + (size_t)r * 1024 + 8 * ch), kv = *(const u32x4*)(Kc + (size_t)r * 1024 + 8 * ch);
          *(LAS u32x4*)(lds + O_QS + r * 528 + 16 * ch) = qv; *(LAS u32x4*)(lds + O_KS + r * 528 + 16 * ch) = kv; }
      const bf16_t* VT = (const bf16_t*)(P.ws + WS_VT) + (size_t)(h * 132 + c) * (272 * 64);
      for (int idx = tid; idx < 272 * 8; idx += 512) { const int r = idx >> 3, ch = idx & 7; *(LAS u32x4*)(lds + O_VT + r * 144 + 16 * ch) = *(const u32x4*)(VT + (size_t)r * 64 + 8 * ch); } }
    if (wave < 2) { const int d = wave; const size_t ix = (size_t)(d * 4 + h) * MTOT + t0 + lane;
        const float e = ((const float*)(P.ws + WS_E))[ix], b = ((const float*)(P.ws + WS_BC))[ix]; const float m = ((const float*)(P.ws + WS_GC))[4096 + (d * 4 + h) * 132 + c];
        float pm = e;
        if (d == 0) {
#pragma unroll
            for (int s = 1; s < 64; s <<= 1) { const float t = __shfl_up(pm, s); if (lane >= s) pm = fmaxf(pm, t); }
        } else {
#pragma unroll
            for (int s = 1; s < 64; s <<= 1) { const float t = __shfl_down(pm, s); if (lane + s < 64) pm = fmaxf(pm, t); }
        }
        const float Mt = fmaxf(m, pm);
        Es[d * 64 + lane] = e; Ms[d * 64 + lane] = Mt; Wi[d * 64 + lane] = __expf(m - Mt); Fl[d * 64 + lane] = __expf(-(b + Mt)); }
    __syncthreads();
    { const int st = wave >> 1, tt0 = 2 * (wave & 1); f32x4 S0 = {0.f, 0.f, 0.f, 0.f}, S1 = S0;
#pragma unroll
      for (int ks = 0; ks < 8; ++ks) { const bf16x8 ak = *(const LAS bf16x8*)(lds + O_KS + (16 * st + fr) * 528 + 64 * ks + 16 * fq);
          const bf16x8 bq0 = *(const LAS bf16x8*)(lds + O_QS + (16 * tt0 + fr) * 528 + 64 * ks + 16 * fq), bq1 = *(const LAS bf16x8*)(lds + O_QS + (16 * tt0 + 16 + fr) * 528 + 64 * ks + 16 * fq);
          S0 = __builtin_amdgcn_mfma_f32_16x16x32_bf16(ak, bq0, S0, 0, 0, 0); S1 = __builtin_amdgcn_mfma_f32_16x16x32_bf16(ak, bq1, S1, 0, 0, 0); }
      const int s0 = 16 * st + 4 * fq;
#pragma unroll
      for (int d = 0; d < 2; ++d) { const f32x4 ev = *(const LAS f32x4*)(Es + d * 64 + s0);
#pragma unroll
          for (int q = 0; q < 2; ++q) { const int t = 16 * (tt0 + q) + fr; const float Mt = Ms[d * 64 + t]; const f32x4 S = q == 0 ? S0 : S1; float w[4];
#pragma unroll
              for (int i = 0; i < 4; ++i) { const int s = s0 + i; const bool on = d == 0 ? (s <= t) : (s >= t); w[i] = on ? __expf(ev[i] - Mt) * S[i] : 0.f; }
              u32x2 pk; pk.x = cvtpk(w[0], w[1]); pk.y = cvtpk(w[2], w[3]); *(LAS u32x2*)(lds + O_WS + (d * 64 + t) * 144 + 2 * s0) = pk; } } }
    __syncthreads();
    f32x4 acc[2][2][4];
    const bf16_t* CST = (const bf16_t*)(P.ws + WS_CST);
#pragma unroll
    for (int d = 0; d < 2; ++d) {
        const bf16_t* Cp = CST + ((((size_t)c * 4 + h) * 2 + d) * 256 + 32 * wave + fr) * 256 + 8 * fq;
        bf16x8 ca[2][8];
#pragma unroll
        for (int v = 0; v < 2; ++v)
#pragma unroll
            for (int ks = 0; ks < 8; ++ks) ca[v][ks] = *(const bf16x8*)(Cp + (size_t)v * 16 * 256 + 32 * ks);
#pragma unroll
        for (int v = 0; v < 2; ++v)
#pragma unroll
            for (int tt = 0; tt < 4; ++tt) acc[d][v][tt] = (f32x4){0.f, 0.f, 0.f, 0.f};
#pragma unroll
        for (int ks = 0; ks < 8; ++ks) {
#pragma unroll
            for (int tt = 0; tt < 4; ++tt) { const bf16x8 bq = *(const LAS bf16x8*)(lds + O_QS + (16 * tt + fr) * 528 + 64 * ks + 16 * fq);
                acc[d][0][tt] = __builtin_amdgcn_mfma_f32_16x16x32_bf16(ca[0][ks], bq, acc[d][0][tt], 0, 0, 0); acc[d][1][tt] = __builtin_amdgcn_mfma_f32_16x16x32_bf16(ca[1][ks], bq, acc[d][1][tt], 0, 0, 0); } }
#pragma unroll
        for (int tt = 0; tt < 4; ++tt) { const float wi = Wi[d * 64 + 16 * tt + fr]; acc[d][0][tt] *= wi; acc[d][1][tt] *= wi; }
#pragma unroll
        for (int ks = 0; ks < 2; ++ks) { const bf16x8 va0 = *(const LAS bf16x8*)(lds + O_VT + (32 * wave + fr) * 144 + 64 * ks + 16 * fq), va1 = *(const LAS bf16x8*)(lds + O_VT + (32 * wave + 16 + fr) * 144 + 64 * ks + 16 * fq);
#pragma unroll
            for (int tt = 0; tt < 4; ++tt) { const bf16x8 bw = *(const LAS bf16x8*)(lds + O_WS + (d * 64 + 16 * tt + fr) * 144 + 64 * ks + 16 * fq);
                acc[d][0][tt] = __builtin_amdgcn_mfma_f32_16x16x32_bf16(va0, bw, acc[d][0][tt], 0, 0, 0); acc[d][1][tt] = __builtin_amdgcn_mfma_f32_16x16x32_bf16(va1, bw, acc[d][1][tt], 0, 0, 0); } }
    }
    { const int tt = wave & 3, d = wave >> 2; f32x4 dn = {0.f, 0.f, 0.f, 0.f};
      const float* np = (const float*)(P.ws + WS_NST) + (((size_t)c * 4 + h) * 2 + d) * 256 + 8 * fq;
#pragma unroll
      for (int ks = 0; ks < 8; ++ks) { bf16x8 an = {0, 0, 0, 0, 0, 0, 0, 0};
          if (fr == 0) { const f32x4 n0 = *(const f32x4*)(np + 32 * ks), n1 = *(const f32x4*)(np + 32 * ks + 4); u32x4 w; w.x = cvtpk(n0[0], n0[1]); w.y = cvtpk(n0[2], n0[3]); w.z = cvtpk(n1[0], n1[1]); w.w = cvtpk(n1[2], n1[3]); an = __builtin_bit_cast(bf16x8, w); }
          const bf16x8 bq = *(const LAS bf16x8*)(lds + O_QS + (16 * tt + fr) * 528 + 64 * ks + 16 * fq);
          dn = __builtin_amdgcn_mfma_f32_16x16x32_bf16(an, bq, dn, 0, 0, 0); }
      dn *= Wi[d * 64 + 16 * tt + fr];
#pragma unroll
      for (int ks = 0; ks < 2; ++ks) { const bf16x8 va = *(const LAS bf16x8*)(lds + O_VT + (256 + fr) * 144 + 64 * ks + 16 * fq); const bf16x8 bw = *(const LAS bf16x8*)(lds + O_WS + (d * 64 + 16 * tt + fr) * 144 + 64 * ks + 16 * fq);
          dn = __builtin_amdgcn_mfma_f32_16x16x32_bf16(va, bw, dn, 0, 0, 0); }
      if (fq == 0) dens[d * 64 + 16 * tt + fr] = dn[0]; }
    __syncthreads();
    float hv[2][4][4];
#pragma unroll
    for (int tt = 0; tt < 4; ++tt) { const int t = 16 * tt + fr; const float rf = 1.0f / fmaxf(fabsf(dens[t]), Fl[t]), rb = 1.0f / fmaxf(fabsf(dens[64 + t]), Fl[64 + t]);
        float s = 0.f, s2 = 0.f;
#pragma unroll
        for (int v = 0; v < 2; ++v)
#pragma unroll
            for (int i = 0; i < 4; ++i) { const float x = acc[0][v][tt][i] * rf + acc[1][v][tt][i] * rb; hv[v][tt][i] = x; s += x; s2 += x * x; }
        s += __shfl_xor(s, 16); s += __shfl_xor(s, 32); s2 += __shfl_xor(s2, 16); s2 += __shfl_xor(s2, 32);
        if (fq == 0) { red[(wave * 64 + t) * 2] = s; red[(wave * 64 + t) * 2 + 1] = s2; } }
    __syncthreads();
    { const float* hg = P.in[I_HNG] + h * 256; const bf16_t* UO = (const bf16_t*)(P.ws + WS_UO); bf16_t* A2 = (bf16_t*)(P.ws + WS_A2);
#pragma unroll
      for (int tt = 0; tt < 4; ++tt) { const int t = 16 * tt + fr; float s = 0.f, s2 = 0.f;
#pragma unroll
          for (int w = 0; w < 8; ++w) { s += red[(w * 64 + t) * 2]; s2 += red[(w * 64 + t) * 2 + 1]; }
          const float mu = s * (1.0f / 256.0f), var = fmaxf(s2 * (1.0f / 256.0f) - mu * mu, 0.f), rstd = 1.0f / sqrtf(var + EPSF);
#pragma unroll
          for (int v = 0; v < 2; ++v) { const int vf = 32 * wave + 16 * v + 4 * fq; const f32x4 g = *(const f32x4*)(hg + vf);
              const u32x2 ow = *(const u32x2*)(UO + (size_t)(t0 + t) * 1024 + h * 256 + vf); const float o[4] = {bflo(ow.x), bfhi(ow.x), bflo(ow.y), bfhi(ow.y)}; float r[4];
#pragma unroll
              for (int i = 0; i < 4; ++i) r[i] = (hv[v][tt][i] - mu) * rstd * g[i] * sigmoidf_(o[i]);
              u32x2 pk; pk.x = cvtpk(r[0], r[1]); pk.y = cvtpk(r[2], r[3]); *(u32x2*)(A2 + (size_t)(t0 + t) * 2048 + 1024 + h * 256 + vf) = pk; } } }
}
#define XB_TMO      128
#define XB_XCNT(j)  (256  + 64 * (j))
#define XB_XSUB(j)  (1280 + 64 * (j))
#define XB_XGEN(j)  (2304 + 64 * (j))
#define XB_TOP      3328
#define XB_TOPGEN   3392
#define XCD_BAR_WORDS 3456
#define XB_SPIN_CAP (1u << 18)
__device__ __forceinline__ unsigned xb_ld(unsigned* p)              { return __hip_atomic_load(p, __ATOMIC_RELAXED, __HIP_MEMORY_SCOPE_AGENT); }
__device__ __forceinline__ unsigned xb_add(unsigned* p, unsigned v) { return __hip_atomic_fetch_add(p, v, __ATOMIC_RELAXED, __HIP_MEMORY_SCOPE_AGENT); }
__device__ __forceinline__ unsigned xb_xcc_id() { return (unsigned)__builtin_amdgcn_s_getreg((3 << 11) | 20) & 0xFu; }
#define XB_SPIN(cond, bar) do { unsigned _sp = 0; while (cond) { __builtin_amdgcn_s_sleep(1); \
    if ((++_sp & 255u) == 0u) { if (xb_ld(&(bar)[XB_TMO])) break; if (_sp > XB_SPIN_CAP) { atomicAdd(&(bar)[XB_TMO], 1u); break; } } } } while (0)
struct XcdBarrier { unsigned* bar; unsigned x; volatile LAS unsigned* st; };
__device__ __forceinline__ XcdBarrier xcd_barrier_post(unsigned* bar, volatile LAS unsigned* st) {
    XcdBarrier b; b.bar = bar; b.x = xb_xcc_id(); b.st = st;
    if (threadIdx.x == 0) (void)xb_add(&bar[XB_XCNT(b.x)], 1u);
    return b;
}
__device__ __forceinline__ void xcd_barrier_complete(unsigned* bar, unsigned x, unsigned& nloc, unsigned& nx) {
    const unsigned G = gridDim.x * gridDim.y * gridDim.z;
    unsigned sum, cnt, mine, sp = 0u;
    for (;;) {
        sum = 0u; cnt = 0u; mine = 0u;
#pragma unroll
        for (unsigned j = 0; j < 16; ++j) { const unsigned c = xb_ld(&bar[XB_XCNT(j)]); sum += c; cnt += (c > 0u) ? 1u : 0u; mine = (j == x) ? c : mine; }
        if (sum == G) break;
        __builtin_amdgcn_s_sleep(1);
        if ((++sp & 255u) == 0u) { if (xb_ld(&bar[XB_TMO])) break; if (sp > XB_SPIN_CAP) { atomicAdd(&bar[XB_TMO], 1u); break; } }
    }
    nloc = mine > 0u ? mine : 1u; nx = cnt > 0u ? cnt : 1u;
}
__device__ __forceinline__ void xcd_barrier(const XcdBarrier& b) {
    asm volatile("s_waitcnt vmcnt(0)" ::: "memory");
    __syncthreads();
    if (threadIdx.x == 0) {
        unsigned* bar = b.bar;
        __builtin_amdgcn_s_waitcnt(0);
        unsigned nloc = b.st[0], nx = b.st[1];
        if (nloc == 0u) { xcd_barrier_complete(bar, b.x, nloc, nx); b.st[0] = nloc; b.st[1] = nx; }
        const unsigned old = xb_add(&bar[XB_XSUB(b.x)], 1u);
        const unsigned gen = old / nloc;
        if (old + 1u == (gen + 1u) * nloc) {
            __builtin_amdgcn_fence(__ATOMIC_RELEASE, "agent");
            asm volatile("s_waitcnt vmcnt(0)" ::: "memory");
            const unsigned og = xb_add(&bar[XB_TOP], 1u);
            const unsigned tg = og / nx;
            if (og + 1u == (tg + 1u) * nx) xb_add(&bar[XB_TOPGEN], 1u);
            else XB_SPIN(xb_ld(&bar[XB_TOPGEN]) == tg, bar);
            __builtin_amdgcn_fence(__ATOMIC_ACQUIRE, "agent");
            xb_add(&bar[XB_XGEN(b.x)], 1u);
            asm volatile("s_waitcnt vmcnt(0)" ::: "memory");
        } else {
            XB_SPIN(xb_ld(&bar[XB_XGEN(b.x)]) == gen, bar);
            __builtin_amdgcn_fence(__ATOMIC_ACQUIRE, "agent");
            asm volatile("s_waitcnt vmcnt(0)" ::: "memory");
        }
    }
    __syncthreads();
}
__device__ __forceinline__ void p7a_route(const Params& P, LAS unsigned char* lds, bool dry = false) {
    const int tid = otid(), lane = tid & 63, wave = __builtin_amdgcn_readfirstlane(tid >> 6), fr = lane & 15, fq = lane >> 4;
    const float* sumsq = (const float*)(P.ws + WS_SUMSQ); const float* BRP = (const float*)(P.ws + WS_WRP + 448 * 1024);
    int* cnt = (int*)(P.ws + WS_CTL) + (dry ? 8192 : 1024);   const size_t ro = dry ? 262144 : 0; int* eid = (int*)(P.ws + WS_ROUTE + ro); float* wtok = (float*)(P.ws + WS_ROUTE + ro + 65536); int* spos = (int*)(P.ws + WS_ROUTE + ro + 131072);
    LAS float* part = (LAS float*)lds; LAS float* lgs = part + 8 * 32 * 48;
    for (int rb = blockIdx.x; rb < SEQ / 32; rb += gridDim.x) {
        const int row0 = 32 * rb;
        f32x4 acc[2][3];
#pragma unroll
        for (int a = 0; a < 2; ++a)
#pragma unroll
            for (int c = 0; c < 3; ++c) acc[a][c] = (f32x4){0.f, 0.f, 0.f, 0.f};
        LAS unsigned char* hb = lds + wave * 16896; LAS float* rs = (LAS float*)(lds + 135168);
        const f32x4* wp = (const f32x4*)(P.ws + WS_WRP) + (size_t)(64 * wave + fq) * 48 + fr;
        __syncthreads();
        if (tid < 32) { const int r = row0 + tid; float ss = 0.f;
#pragma unroll
            for (int q = 0; q < 8; ++q) { const f32x4 v = *(const f32x4*)(sumsq + (size_t)r * 32 + 4 * q); ss += (v[0] + v[1]) + (v[2] + v[3]); }
            rs[tid] = 1.0f / sqrtf(ss * (1.0f / D) + EPSF); }
        const int lr = lane >> 5, lc = 4 * (lane & 31);
        f32x4 hv[2][16];
#pragma unroll
        for (int r = 0; r < 16; ++r) hv[0][r] = *(const f32x4*)(P.out + (size_t)(row0 + 2 * r + lr) * D + 256 * wave + lc);
        __syncthreads();
#pragma unroll
        for (int hf = 0; hf < 2; ++hf) {
            if (hf == 0) {
#pragma unroll
                for (int r = 0; r < 16; ++r) hv[1][r] = *(const f32x4*)(P.out + (size_t)(row0 + 2 * r + lr) * D + 256 * wave + 128 + lc); }
            const int dcol = 256 * wave + 128 * hf + lc;
            const f32x4 fA = *(const f32x4*)(P.in[I_N2G] + dcol) * (*(const f32x4*)((const float*)(P.ws + WS_MOD) + 8192 + dcol) + 1.0f), fS = *(const f32x4*)((const float*)(P.ws + WS_MOD) + 6144 + dcol);
#pragma unroll
            for (int r = 0; r < 16; ++r) *(LAS f32x4*)(hb + (2 * r + lr) * 528 + 4 * lc) = hv[hf][r];
            if (!dry) {
#pragma unroll
                for (int r = 0; r < 16; ++r) { const f32x4 y = hv[hf][r] * rs[2 * r + lr] * fA + fS; u32x2 pk; pk.x = cvtpk(y[0], y[1]); pk.y = cvtpk(y[2], y[3]);
                    *(u32x2*)((bf16_t*)(P.ws + WS_FN) + (size_t)(row0 + 2 * r + lr) * D + dcol) = pk; } }
#pragma unroll 2
            for (int j = 0; j < 8; ++j) { const f32x4 a0 = *(const LAS f32x4*)(hb + fr * 528 + 64 * j + 16 * fq), a1 = *(const LAS f32x4*)(hb + (16 + fr) * 528 + 64 * j + 16 * fq);
                f32x4 b[3];
#pragma unroll
                for (int c = 0; c < 3; ++c) b[c] = wp[(size_t)(32 * hf + 4 * j) * 48 + 16 * c];
#pragma unroll
                for (int i = 0; i < 4; ++i)
#pragma unroll
                    for (int c = 0; c < 3; ++c) { acc[0][c] = __builtin_amdgcn_mfma_f32_16x16x4f32(a0[i], b[c][i], acc[0][c], 0, 0, 0); acc[1][c] = __builtin_amdgcn_mfma_f32_16x16x4f32(a1[i], b[c][i], acc[1][c], 0, 0, 0); } }
        }
        __syncthreads();
#pragma unroll
        for (int a = 0; a < 2; ++a)
#pragma unroll
            for (int c = 0; c < 3; ++c)
#pragma unroll
                for (int i = 0; i < 4; ++i) part[(wave * 32 + 16 * a + 4 * fq + i) * 48 + 16 * c + fr] = acc[a][c][i];
        __syncthreads();
        { const int row = tid >> 4, pc = tid & 15;
#pragma unroll
          for (int c = 0; c < 3; ++c) { float s = 0.f;
#pragma unroll
              for (int w = 0; w < 8; ++w) s += part[(w * 32 + row) * 48 + 16 * c + pc];
              lgs[row * 48 + 16 * c + pc] = s; } }
        __syncthreads();
        if (tid < 32) { const int r = row0 + tid; const float rstd = rs[tid];
            float lg[4];
#pragma unroll
            for (int i = 0; i < 4; ++i) lg[i] = lgs[tid * 48 + 32 + i] * rstd + BRP[32 + i];
            int gs = 0; float gm = lg[0];
#pragma unroll
            for (int i = 1; i < 4; ++i) if (lg[i] > gm) { gm = lg[i]; gs = i; }
            float gsum = 0.f;
#pragma unroll
            for (int i = 0; i < 4; ++i) gsum += __expf(lg[i] - gm);
            const float pg = 1.0f / gsum;
            float sl[8];
#pragma unroll
            for (int i = 0; i < 8; ++i) sl[i] = lgs[tid * 48 + gs * 8 + i] * rstd + BRP[gs * 8 + i];
            int i1 = 0; float m1 = sl[0];
#pragma unroll
            for (int i = 1; i < 8; ++i) if (sl[i] > m1) { m1 = sl[i]; i1 = i; }
            int i2 = i1 == 0 ? 1 : 0; float m2 = sl[i2];
#pragma unroll
            for (int i = 0; i < 8; ++i) if (i != i1 && sl[i] > m2) { m2 = sl[i]; i2 = i; }
            const float p2 = __expf(m2 - m1); const float w1 = pg / (1.0f + p2), w2 = pg * p2 / (1.0f + p2);
            const int e1 = gs * 8 + i1, e2 = gs * 8 + i2;
            LAS int* lcnt = (LAS int*)(lds + 135168 + 256); LAS int* lbase = lcnt + 32;
            lcnt[tid] = 0; LDS_WAIT();
            const int q1 = __hip_atomic_fetch_add(lcnt + e1, 1, __ATOMIC_RELAXED, __HIP_MEMORY_SCOPE_WORKGROUP), q2 = __hip_atomic_fetch_add(lcnt + e2, 1, __ATOMIC_RELAXED, __HIP_MEMORY_SCOPE_WORKGROUP);
            LDS_WAIT();
            { const int n = lcnt[tid]; lbase[tid] = n > 0 ? atomicAdd(cnt + tid * 64, n) : 0; }
            LDS_WAIT();
            const int s1 = lbase[e1] + q1, s2 = lbase[e2] + q2;
            if (!dry) { int* ptok = (int*)(P.ws + WS_PTOK); ptok[e1 * 8192 + s1] = r; ptok[e2 * 8192 + s2] = r; }
            eid[2 * r] = e1; eid[2 * r + 1] = e2; wtok[2 * r] = w1; wtok[2 * r + 1] = w2; spos[2 * r] = s1; spos[2 * r + 1] = s2; }
    }
}
__device__ __forceinline__ void moe_tables(const Params& P, LAS int* tab) {
    __syncthreads();
    if (threadIdx.x == 0) { const int* cnt = (const int*)(P.ws + WS_CTL) + 1024; int tt = 0;
        for (int e = 0; e < NEXP; ++e) { const int c = __hip_atomic_load(cnt + e * 64, __ATOMIC_RELAXED, __HIP_MEMORY_SCOPE_AGENT); const int nt = (c + 255) >> 8; tab[128 + e] = tt; for (int i = 0; i < nt; ++i) tab[1 + tt + i] = e; tt += nt; }
        tab[0] = tt; }
    __syncthreads();
}
__device__ __forceinline__ void p7b_scatter(const Params& P, const LAS int* tab) {
    const int tid = otid(), lane = tid & 63, wave = tid >> 6; const int gw = blockIdx.x * 8 + wave, NGW = gridDim.x * 8;
    const float* mod = (const float*)(P.ws + WS_MOD); const float* g = P.in[I_N2G]; const float* sumsq = (const float*)(P.ws + WS_SUMSQ);
    const int* eid = (const int*)(P.ws + WS_ROUTE); const int* spos = (const int*)(P.ws + WS_ROUTE + 131072); bf16_t* FNS = (bf16_t*)(P.ws + WS_FNS);
    for (int r = gw; r < SEQ; r += NGW) {
        float ss = lane < 32 ? sumsq[(size_t)r * 32 + lane] : 0.f; ss = wave_sum(ss);
        const float rstd = 1.0f / sqrtf(ss * (1.0f / D) + EPSF);
        const int e1 = eid[2 * r], e2 = eid[2 * r + 1]; const size_t sl1 = (size_t)tab[128 + e1] * 256 + spos[2 * r], sl2 = (size_t)tab[128 + e2] * 256 + spos[2 * r + 1];
        const f32x4* hr = (const f32x4*)(P.out + (size_t)r * D) + lane; u32x2* o1 = (u32x2*)(FNS + sl1 * D) + lane; u32x2* o2 = (u32x2*)(FNS + sl2 * D) + lane;
#pragma unroll
        for (int j = 0; j < 8; ++j) { const int d0 = 4 * lane + 256 * j; const f32x4 hv = hr[64 * j]; const f32x4 gg = *(const f32x4*)(g + d0), sc = *(const f32x4*)(mod + 8192 + d0), sh = *(const f32x4*)(mod + 6144 + d0);
            const f32x4 y = hv * rstd * gg * (sc + 1.0f) + sh; u32x2 w; w.x = cvtpk(y[0], y[1]); w.y = cvtpk(y[2], y[3]); o1[64 * j] = w; o2[64 * j] = w; }
    }
}
__device__ __forceinline__ void p10_final(const Params& P, const LAS int* tab, bool dry = false) {
    const int tid = otid(), lane = tid & 63, wave = tid >> 6; const int gw = blockIdx.x * 8 + wave, NGW = gridDim.x * 8;
    const float* mod = (const float*)(P.ws + WS_MOD); const float* fg = P.in[I_FG];
    const int* eid = (const int*)(P.ws + WS_ROUTE); const float* wtok = (const float*)(P.ws + WS_ROUTE + 65536); const int* spos = (const int*)(P.ws + WS_ROUTE + 131072); const bf16_t* Y = (const bf16_t*)(P.ws + WS_Y);
    for (int r = gw; r < SEQ; r += NGW) {
        const int e1 = eid[2 * r], e2 = eid[2 * r + 1]; const size_t sl1 = (size_t)tab[128 + e1] * 256 + spos[2 * r], sl2 = (size_t)tab[128 + e2] * 256 + spos[2 * r + 1];
        const float w1 = wtok[2 * r], w2 = wtok[2 * r + 1];
        f32x4* hr = (f32x4*)(P.out + (size_t)r * D) + lane; f32x4* wrp = dry ? (f32x4*)((float*)(P.ws + WS_FNS) + (size_t)r * D) + lane : hr; const u32x2* y1 = (const u32x2*)(Y + sl1 * D) + lane; const u32x2* y2 = (const u32x2*)(Y + sl2 * D) + lane;
        f32x4 v[8]; float ss = 0.f;
#pragma unroll
        for (int j = 0; j < 8; ++j) { const int d0 = 4 * lane + 256 * j; const f32x4 hv = hr[64 * j]; const f32x4 g2 = *(const f32x4*)(mod + 10240 + d0); const u32x2 a = y1[64 * j], b = y2[64 * j];
            const f32x4 ya = {bflo(a.x), bfhi(a.x), bflo(a.y), bfhi(a.y)}, yb = {bflo(b.x), bfhi(b.x), bflo(b.y), bfhi(b.y)};
            v[j] = hv + g2 * (ya * w1 + yb * w2); ss += (v[j][0] * v[j][0] + v[j][1] * v[j][1]) + (v[j][2] * v[j][2] + v[j][3] * v[j][3]); }
        const float rstd = 1.0f / sqrtf(wave_sum(ss) * (1.0f / D) + EPSF);
#pragma unroll
        for (int j = 0; j < 8; ++j) { const int d0 = 4 * lane + 256 * j; wrp[64 * j] = v[j] * rstd * *(const f32x4*)(fg + d0); }
    }
}
__device__ __forceinline__ void p10_plain(const Params& P, const float* src) {
    const int tid = otid(), lane = tid & 63, wave = tid >> 6; const int gw = blockIdx.x * 8 + wave, NGW = gridDim.x * 8; const float* fg = P.in[I_FG];
    for (int r = gw; r < SEQ; r += NGW) { const f32x4* sr = (const f32x4*)(src + (size_t)r * D) + lane; f32x4* hr = (f32x4*)(P.out + (size_t)r * D) + lane; f32x4 v[8]; float ss = 0.f;
#pragma unroll
        for (int j = 0; j < 8; ++j) { v[j] = sr[64 * j]; ss += (v[j][0] * v[j][0] + v[j][1] * v[j][1]) + (v[j][2] * v[j][2] + v[j][3] * v[j][3]); }
        const float rstd = 1.0f / sqrtf(wave_sum(ss) * (1.0f / D) + EPSF);
#pragma unroll
        for (int j = 0; j < 8; ++j) hr[64 * j] = v[j] * rstd * *(const f32x4*)(fg + 4 * lane + 256 * j); }
}
#ifndef STAGE
#define STAGE 4
#endif
#ifndef N_LAUNCHES
#define N_LAUNCHES 1
#endif
constexpr int NPHASE = 12;
__global__ void __launch_bounds__(512, 2) mk_fwd(Params P) {
    extern __shared__ __attribute__((aligned(16))) unsigned char lds_raw[];
    LAS unsigned char* lds = (LAS unsigned char*)lds_raw;
    LAS int* tab = (LAS int*)(lds + LDSCTL_OFF + 4096);
    const int lo = P.ph_lo, hi = P.ph_hi; const int G = gridDim.x, bx = blockIdx.x;
#ifndef ONLYP
#define ONLYP -1
#endif
#define IN(k) ((ONLYP < 0 || ONLYP == (k)) && lo <= (k) && (k) < hi)
#ifndef TS_PHASE
#define TS_PHASE -1
#endif
#ifndef TS_MULT
#define TS_MULT 4
#endif
#ifndef P4SEL
#define P4SEL 0
#endif
#ifndef REP_PHASE
#define REP_PHASE -1
#endif
#define NREP(k) ((k) == REP_PHASE ? 2 : 1)
    { volatile LAS unsigned* st = (volatile LAS unsigned*)(lds + LDS_BYTES - 64); if (threadIdx.x < 2) st[threadIdx.x] = 0u; __syncthreads(); }
    XcdBarrier xbar = xcd_barrier_post((unsigned*)(P.ws + WS_CTL) + 4096, (volatile LAS unsigned*)(lds + LDS_BYTES - 64));
#if N_LAUNCHES == 2
#define SEAM(k) do { if ((k) + 1 < hi) { xcd_barrier(xbar); } if (TS_PHASE >= 0 && bx == 0 && threadIdx.x == 0) ((volatile LAS unsigned long long*)(lds + LDS_BYTES - 256))[(k) + 1] = __builtin_amdgcn_s_memrealtime(); } while (0)
#else
#define SEAM(k) do { if ((k) + 1 < hi) { cg::this_grid().sync(); } } while (0)
#endif
    if (TS_PHASE >= 0 && bx == 0 && threadIdx.x == 0) ((volatile LAS unsigned long long*)(lds + LDS_BYTES - 256))[0] = __builtin_amdgcn_s_memrealtime();
    if (IN(0)) { for (int rep_ = 0; rep_ < NREP(0); ++rep_) { if (rep_) xcd_barrier(xbar);
#if STAGE >= 2
        p0_adaln(P, lds); p0_transposes(P, lds, 0, TR_ITEMS_EARLY, bx * 8 + (threadIdx.x >> 6), G * 8); if (STAGE >= 4) p0_moe_weights(P, lds, 0, RUNS_P0); p0_zero_pad(P); p0_wpool_scaled(P);
#endif
        } SEAM(0); }
    if (IN(1)) { for (int rep_ = 0; rep_ < NREP(1); ++rep_) { if (rep_) xcd_barrier(xbar);
#if STAGE >= 2
        p1_router_prep(P);
        if (bx < G - 32) p1_xn(P, G - 32);
        else { pg8::Gemm g{(const bf16_t*)(P.ws + WS_WOUTT), (const bf16_t*)(P.ws + WS_WPOOLS), 2048, 256, 256}; SchedWeff S{32, bx - (G - 32)}; EpiWeff E{(bf16_t*)(P.ws + WS_WOUTT)};
            pg8::gemm_phase<EpiWeff, SchedWeff>(lds, g, S, E); }
#endif
        } SEAM(1); }
    if (IN(2)) { for (int rep_ = 0; rep_ < NREP(2); ++rep_) { if (rep_) xcd_barrier(xbar);
#if STAGE >= 2
        pg8::Gemm g{(const bf16_t*)(P.ws + WS_XN), (const bf16_t*)(P.ws + WS_WINT), 2048, 2048, 2048}; SchedG1 S{G, bx}; EpiG1 E{P.ws, P.in[I_GB]};
        pg8::gemm_phase<EpiG1, SchedG1>(lds, g, S, E);
        if (STAGE >= 4 && rep_ == 0) moe_pull_runs(P, lds, 1100, RUNS_P0, RUNS_W13);
#endif
        } SEAM(2); }
    if (IN(3)) { for (int rep_ = 0; rep_ < NREP(3); ++rep_) { if (rep_) xcd_barrier(xbar);
#if STAGE >= 2
        p3_all(P, lds);
#endif
        } SEAM(3); }
    if (IN(4)) { for (int rep_ = 0; rep_ < NREP(4); ++rep_) { if (rep_) xcd_barrier(xbar);
#if STAGE >= 2
        if (STAGE >= 3) { p4_state(P, lds, bx, rep_ > 0); }
#endif
        } SEAM(4); }
    if (IN(5)) { for (int rep_ = 0; rep_ < NREP(5); ++rep_) { if (rep_) xcd_barrier(xbar);
#if STAGE >= 3
        for (int t = bx; t < 512; t += G) p5_task(P, lds, t >> 2, t & 3);
#elif STAGE == 2
        { bf16_t* A2 = (bf16_t*)(P.ws + WS_A2); for (int i = bx * 512 + threadIdx.x; i < SEQ * 128; i += G * 512) { const int r = i >> 7, c8 = i & 127; *(u32x4*)(A2 + (size_t)r * 2048 + 1024 + 8 * c8) = (u32x4){0u, 0u, 0u, 0u}; } }
#endif
        } SEAM(5); }
    if (IN(6)) { for (int rep_ = 0; rep_ < NREP(6); ++rep_) { if (rep_) xcd_barrier(xbar);
#if STAGE >= 2
        pg8::Gemm g{(const bf16_t*)(P.ws + WS_A2), (const bf16_t*)(P.ws + WS_WOUTT), 2048, 2048, 2048}; SchedG2 S{G, bx};
        EpiG2 E{P.in[I_X], (const float*)(P.ws + WS_MOD) + 4096, P.out, (float*)(P.ws + WS_SUMSQ)};
        pg8::gemm_phase<EpiG2, SchedG2>(lds, g, S, E);
#endif
        } SEAM(6); }
    if (IN(7)) { for (int rep_ = 0; rep_ < NREP(7); ++rep_) { if (rep_) xcd_barrier(xbar);
#if STAGE >= 4
        p7a_route(P, lds, rep_ == 0 && NREP(7) == 2);
#endif
        } SEAM(7); }
    if (IN(9)) { for (int rep_ = 0; rep_ < NREP(9); ++rep_) { if (rep_) xcd_barrier(xbar);
#if STAGE >= 4
        if (rep_ == 0) moe_tables(P, tab);
        pg8::Gemm g{(const bf16_t*)(P.ws + WS_FN), (const bf16_t*)(P.ws + WS_W13T), 2048, 2048, 2048}; SchedMoEG S{G, bx, 4, 4, tab, (const int*)(P.ws + WS_PTOK), (const int*)(P.ws + WS_CTL) + 1024}; EpiUp E{(bf16_t*)(P.ws + WS_H)};
        pg8::gemm_phase<EpiUp, SchedMoEG>(lds, g, S, E);
        if (rep_ == 0) moe_pull_runs(P, lds, 1101, RUNS_W13, RUNS_ALL);
#endif
        } SEAM(9); }
    if (IN(10)) { for (int rep_ = 0; rep_ < NREP(10); ++rep_) { if (rep_) xcd_barrier(xbar);
#if STAGE >= 4
        if (lo == 10) moe_tables(P, tab);
        pg8::Gemm g{(const bf16_t*)(P.ws + WS_H), (const bf16_t*)(P.ws + WS_W2T), 512, 512, 512}; SchedMoE S{G, bx, 8, 8, tab}; EpiDown E{(bf16_t*)(P.ws + WS_Y)};
        pg8::gemm_phase<EpiDown, SchedMoE>(lds, g, S, E);
#endif
        } SEAM(10); }
    if (IN(11)) { for (int rep_ = 0; rep_ < NREP(11); ++rep_) { if (rep_) xcd_barrier(xbar);
#if STAGE >= 4
        if (lo == 11) moe_tables(P, tab);
        p10_final(P, tab, rep_ == 0 && NREP(11) == 2);
#elif STAGE >= 2
        p10_plain(P, P.out);
#else
        p10_plain(P, P.in[I_X]);
#endif
    } }
    if (TS_PHASE >= 0 && bx == 0 && threadIdx.x == 0) { volatile LAS unsigned long long* ts = (volatile LAS unsigned long long*)(lds + LDS_BYTES - 256);
        const unsigned long long tend = __builtin_amdgcn_s_memrealtime(); const int k = TS_PHASE; const unsigned long long t1 = k >= 11 ? tend : ts[k + 1]; const unsigned long long span = t1 - ts[k == 9 ? 8 : k];
        const unsigned long long until = tend + span * TS_MULT; while (__builtin_amdgcn_s_memrealtime() < until) __builtin_amdgcn_s_sleep(8); }
#undef IN
#undef SEAM
}

extern "C" void kernel_launch(void* const* d_in, const int* in_sizes, int n_in, void* d_out, int out_size, void* d_ws, size_t ws_size, hipStream_t stream) {
    static int grid = 0;
    if (grid == 0) {
        if (n_in != 24 || out_size != SEQ * D || ws_size < WS_END) { fprintf(stderr, "kernel_launch: unexpected shapes (n_in %d, out %d, ws %zu < %zu)\n", n_in, out_size, ws_size, (size_t)WS_END); grid = -1; return; }
        int dev = 0, cus = 0, per_cu = 0;
        if (hipGetDevice(&dev) != hipSuccess || hipDeviceGetAttribute(&cus, hipDeviceAttributeMultiprocessorCount, dev) != hipSuccess) { grid = -1; return; }
        if (hipFuncSetAttribute((const void*)mk_fwd, hipFuncAttributeMaxDynamicSharedMemorySize, LDS_BYTES) != hipSuccess) { fprintf(stderr, "kernel_launch: hipFuncSetAttribute failed\n"); grid = -1; return; }
        if (hipOccupancyMaxActiveBlocksPerMultiprocessor(&per_cu, (const void*)mk_fwd, 512, LDS_BYTES) != hipSuccess || per_cu < 1) { fprintf(stderr, "kernel_launch: occupancy query says %d\n", per_cu); per_cu = 1; }
        (void)hipGetLastError();
        grid = cus;
        if (grid < 160) { fprintf(stderr, "kernel_launch: %d CUs is too few for this kernel's phase split\n", grid); grid = -1; return; }
    }
    if (grid < 0) return;
    (void)hipMemsetAsync((char*)d_ws + WS_CTL, 0, 1 * MiB, stream);
    Params p{};
    for (int i = 0; i < 24; ++i) p.in[i] = (const float*)d_in[i];
    p.out = (float*)d_out; p.ws = (unsigned char*)d_ws;
#if N_LAUNCHES == 2
    p.ph_lo = 0; p.ph_hi = NPHASE;
    hipLaunchKernelGGL(mk_fwd, dim3(grid), dim3(512), LDS_BYTES, stream, p);
#elif N_LAUNCHES == 1
    p.ph_lo = 0; p.ph_hi = NPHASE;
    void* args[] = {&p};
    hipError_t e = hipLaunchCooperativeKernel((const void*)mk_fwd, dim3(grid), dim3(512), args, LDS_BYTES, stream);
    if (e != hipSuccess) fprintf(stderr, "cooperative launch failed: %s (grid %d)\n", hipGetErrorString(e), grid);
#else
    for (int k = 0; k < NPHASE; ++k) { p.ph_lo = k; p.ph_hi = k + 1; hipLaunchKernelGGL(mk_fwd, dim3(grid), dim3(512), LDS_BYTES, stream, p);
#ifdef REP_PHASE
        if (k == REP_PHASE) hipLaunchKernelGGL(mk_fwd, dim3(grid), dim3(512), LDS_BYTES, stream, p);
#endif
    }
#endif
}
```

```cpp
#define STAGE 4
#define N_LAUNCHES 2
#include <hip/hip_runtime.h>
#include <hip/hip_cooperative_groups.h>
#include <cstdio>
#include <cstdint>
namespace cg = cooperative_groups;

#define LAS __attribute__((address_space(3)))
#define GAS __attribute__((address_space(1)))
typedef unsigned short bf16_t;
typedef short bf16x8 __attribute__((ext_vector_type(8)));
typedef float f32x4 __attribute__((ext_vector_type(4)));
typedef float f32x2 __attribute__((ext_vector_type(2)));
typedef unsigned u32x4 __attribute__((ext_vector_type(4)));
typedef unsigned u32x2 __attribute__((ext_vector_type(2)));
typedef __bf16 bf16x2_t __attribute__((ext_vector_type(2)));

#ifndef PATPROBE
#define PATPROBE 0
#endif
constexpr int D = 2048, SEQ = 8192, CTXL = 256, MTOT = SEQ + CTXL;
constexpr int INC = 5136, NPAD = 5376;
constexpr int NCH = SEQ / 64, NCHT = MTOT / 64;
constexpr int NEXP = 32, DEXP = 512;
constexpr float EPSF = 1e-6f;

constexpr size_t MiB = 1u << 20;
constexpr size_t WS_CTL = 0;
constexpr size_t WS_MOD = 1 * MiB;
constexpr size_t WS_GATES = 2 * MiB;
constexpr size_t WS_E = 3 * MiB;
constexpr size_t WS_BC = 3 * MiB + 288 * 1024;
constexpr size_t WS_GC = 3 * MiB + 576 * 1024;
constexpr size_t WS_NST = 4 * MiB;
constexpr size_t WS_SUMSQ = 5 * MiB;
constexpr size_t WS_ROUTE = 6 * MiB;
constexpr size_t WS_WRP = 7 * MiB;
constexpr size_t WS_WPOOLS = 8 * MiB;
constexpr size_t WS_WOUTT = 9 * MiB;
constexpr size_t WS_WINT = 17 * MiB;
constexpr size_t WS_W13T = 38 * MiB;
constexpr size_t WS_W2T = 166 * MiB;
constexpr size_t WS_XN = 230 * MiB;
constexpr size_t WS_UP = 263 * MiB;
constexpr size_t WS_UQ = 279 * MiB;
constexpr size_t WS_A2 = 230 * MiB;
constexpr size_t WS_UO = 295 * MiB;
constexpr size_t WS_UK = 311 * MiB;
constexpr size_t WS_UV = 328 * MiB;
constexpr size_t WS_QC = 345 * MiB;
constexpr size_t WS_KC = 361 * MiB;
constexpr size_t WS_KT = 378 * MiB;
constexpr size_t WS_VT = 395 * MiB;
constexpr size_t WS_VSF = 413 * MiB;
constexpr size_t WS_VSB = 431 * MiB;
constexpr size_t WS_CST = 449 * MiB;
constexpr size_t WS_Y = 449 * MiB;
constexpr size_t WS_H = 545 * MiB;
constexpr size_t WS_FNS = 295 * MiB;
constexpr size_t WS_FN = 295 * MiB;
constexpr size_t WS_PTOK = 4 * MiB;
constexpr size_t WS_END = 577 * MiB;
constexpr int MAXSLOT = 24576;

constexpr int RING_BYTES = 131072;
constexpr int LDSCTL_OFF = RING_BYTES;
constexpr int LDS_BYTES = 147456;

__device__ __forceinline__ float bf2f(unsigned short b) { return __uint_as_float((unsigned)b << 16); }
__device__ __forceinline__ unsigned cvtpk(float lo, float hi) { f32x2 v = {lo, hi}; bf16x2_t b = __builtin_convertvector(v, bf16x2_t); return __builtin_bit_cast(unsigned, b); }
__device__ __forceinline__ float bflo(unsigned w) { return __uint_as_float(w << 16); }
__device__ __forceinline__ float bfhi(unsigned w) { return __uint_as_float(w & 0xffff0000u); }
__device__ __forceinline__ float siluf(float x) { return x / (1.0f + __expf(-x)); }
__device__ __forceinline__ float sigmoidf_(float x) { return 1.0f / (1.0f + __expf(-x)); }
__device__ __forceinline__ float logsigmoidf_(float x) { return fminf(x, 0.f) - log1pf(__expf(-fabsf(x))); }
__device__ __forceinline__ float wave_sum(float v) {
#pragma unroll
    for (int o = 1; o < 64; o <<= 1) v += __shfl_xor(v, o);
    return v;
}
__device__ __forceinline__ float wave_max(float v) {
#pragma unroll
    for (int o = 1; o < 64; o <<= 1) v = fmaxf(v, __shfl_xor(v, o));
    return v;
}
__device__ __forceinline__ int otid() { int t = threadIdx.x; asm volatile("" : "+v"(t)); return t; }
#define LDS_WAIT() asm volatile("s_waitcnt lgkmcnt(0)" ::: "memory")
#define VM_WAIT() asm volatile("s_waitcnt vmcnt(0)" ::: "memory")

struct Params { const float* in[24]; float* out; unsigned char* ws; int ph_lo, ph_hi; };
enum { I_X = 0, I_C, I_CTX, I_CCTX, I_WMOD, I_BMOD, I_N1G, I_WIN, I_WCQ, I_WCK, I_GB, I_HNG, I_WPOOL, I_PSC, I_WOUT, I_N2G, I_WGRP, I_BGRP, I_WRT, I_BRT, I_W1, I_W3, I_W2, I_FG };
namespace pg8 {
constexpr int BM = 256, BK = 64, HALF = 128, HTB = HALF * BK * 2, STAGE_BYTES = 8 * HTB, NXCD = 8, WGM = 8;
__host__ __device__ __forceinline__ int lds_byte(int r, int c) { const int st = (r >> 4) * 2 + (c >> 5), rr = r & 15, cc = c & 31, ob = rr * 64 + cc * 2; return st * 1024 + (ob ^ (((ob >> 9) & 1) << 5)); }
__host__ __device__ __forceinline__ void stage_rc(int b, int& R, int& C) { const int st = b / 1024, sb = b % 1024, swz = sb ^ (((sb >> 9) & 1) << 5); R = (st >> 1) * 16 + swz / 64; C = (st & 1) * 32 + (swz % 64) / 2; }
__host__ __device__ __forceinline__ int perm32(int rho) { const int n = rho >> 4, i = rho & 15; return 8 * (i >> 2) + 4 * n + (i & 3); }

struct Unit { int am, bn, acol, ex; };
struct Gemm { const bf16_t* A; const bf16_t* Bt; int lda, ldb, K; };

__device__ __forceinline__ void static_unit(int L, int nM, int nN, int& pm, int& pn) {
    const int nwg = nM * nN; int wgid = L; { const int q = nwg / NXCD, r = nwg % NXCD, xcd = wgid % NXCD, off = wgid / NXCD; wgid = (xcd < r ? xcd * (q + 1) : r * (q + 1) + (xcd - r) * q) + off; }
    const int nig = WGM * nN, gid = wgid / nig, fm = gid * WGM, gsz = (nM - fm) < WGM ? (nM - fm) : WGM;
    pm = fm + ((wgid % nig) % gsz); pn = (wgid % nig) / gsz;
}

template <class Epi, class Sched>
__device__ __forceinline__ void gemm_phase(LAS unsigned char* lds, const Gemm g, const Sched& S, const Epi& E) {
    const int tid = otid(), wid = __builtin_amdgcn_readfirstlane(tid >> 6), lane = tid & 63, wr = wid >> 2, wc = wid & 3, fr = lane & 15, fq = lane >> 4;
    const int K = g.K, nt = K / BK;
    unsigned voffA[2], voffB[2];
#pragma unroll
    for (int i = 0; i < 2; ++i) { int R, C; stage_rc(tid * 16 + i * 8192, R, C); const int Rb = Epi::PERM ? ((R & ~31) + perm32(R & 31)) : R;
        voffA[i] = (unsigned)(R * g.lda + C) * 2u; voffB[i] = (unsigned)(Rb * g.ldb + C) * 2u; }
    const size_t kstep = (size_t)(BK * 2);
    const size_t hstepA = (size_t)HALF * g.lda * 2, hstepB = (size_t)HALF * g.ldb * 2;
    const size_t tstepA = 2 * hstepA, tstepB = 2 * hstepB;
    const unsigned ldsw = (unsigned)wid * 1024u;
    const int aoff = lds_byte(wr * 64 + fr, fq * 8), boff = lds_byte(wc * 32 + fr, fq * 8);
#define PG8_SA(b, h) (((b) * 2 + (h)) * HTB)
#define PG8_SB(b, h) ((4 + (b) * 2 + (h)) * HTB)
#define PG8_STAGE(bufoff, gbase, voff) do { _Pragma("unroll") for (int _i = 0; _i < 2; ++_i) \
        __builtin_amdgcn_global_load_lds((const unsigned*)((const char*)(gbase) + (voff)[_i]), (LAS unsigned*)(lds + (bufoff) + ldsw + _i * 8192), 16, 0, 0); } while (0)
#define PG8_STAGE_A(bufoff, gbase, hh, vv) do { if constexpr (Sched::GATHER) { PG8_STAGE(bufoff, gbase, (vv)[hh]); } else { PG8_STAGE(bufoff, (gbase) + (hh) * hstepA, voffA); } } while (0)
#define PG8_LDA(dst, b, h) do { _Pragma("unroll") for (int m = 0; m < 4; ++m) _Pragma("unroll") for (int k = 0; k < 2; ++k) dst[m][k] = *(const LAS bf16x8*)(lds + PG8_SA(b, h) + aoff + m * 2048 + k * 1024); } while (0)
#define PG8_LDB(dst, b, h) do { _Pragma("unroll") for (int n = 0; n < 2; ++n) _Pragma("unroll") for (int k = 0; k < 2; ++k) dst[n][k] = *(const LAS bf16x8*)(lds + PG8_SB(b, h) + boff + n * 2048 + k * 1024); } while (0)
#define PG8_MMA(ai, bj, At, Bt) do { __builtin_amdgcn_s_setprio(1); _Pragma("unroll") for (int m = 0; m < 4; ++m) _Pragma("unroll") for (int n = 0; n < 2; ++n) _Pragma("unroll") for (int k = 0; k < 2; ++k) \
        acc[ai][bj][m][n] = __builtin_amdgcn_mfma_f32_16x16x32_bf16(Bt[n][k], At[m][k], acc[ai][bj][m][n], 0, 0, 0); __builtin_amdgcn_s_setprio(0); } while (0)
#define PG8_WAIT_V(n) asm volatile("s_waitcnt vmcnt(" #n ")" ::: "memory")
#define PG8_WAIT_L(n) asm volatile("s_waitcnt lgkmcnt(" #n ")" ::: "memory")
#define PG8_BAR __builtin_amdgcn_s_barrier()
#define PG8_SCHED __builtin_amdgcn_sched_barrier(0)
    Unit cur, nxt; int ui = 0;
    if (!S.next(0, cur)) return;
    unsigned vaC[2][2], vaN[2][2];
    int gR[2], gC[2];
#pragma unroll
    for (int i = 0; i < 2; ++i) stage_rc(tid * 16 + i * 8192, gR[i], gC[i]);
    if constexpr (Sched::GATHER) {
#pragma unroll
        for (int hh = 0; hh < 2; ++hh)
#pragma unroll
            for (int i = 0; i < 2; ++i) vaC[hh][i] = (unsigned)(S.arow(cur, hh * HALF + gR[i]) * g.lda + gC[i]) * 2u;
    }
    f32x4 acc[2][2][4][2];
#pragma unroll
    for (int a = 0; a < 2; ++a)
#pragma unroll
        for (int b = 0; b < 2; ++b)
#pragma unroll
            for (int m = 0; m < 4; ++m)
#pragma unroll
                for (int n = 0; n < 2; ++n) acc[a][b][m][n] = (f32x4){0.f, 0.f, 0.f, 0.f};
    bf16x8 At[4][2], B0[2][2], B1[2][2];
    const char* cA = Sched::GATHER ? (const char*)g.A : (const char*)g.A + (size_t)cur.am * tstepA + (size_t)cur.acol * 2; const char* cB = (const char*)g.Bt + (size_t)cur.bn * tstepB;
    PG8_STAGE(PG8_SB(0, 0), cB, voffB); PG8_STAGE(PG8_SB(0, 1), cB + hstepB, voffB); PG8_STAGE_A(PG8_SA(0, 0), cA, 0, vaC); PG8_STAGE_A(PG8_SA(0, 1), cA, 1, vaC);
    if (wr == 1) PG8_BAR;
    PG8_WAIT_V(2); PG8_BAR;
    PG8_STAGE(PG8_SB(1, 0), cB + kstep, voffB); PG8_STAGE_A(PG8_SA(1, 0), cA + kstep, 0, vaC); PG8_STAGE(PG8_SB(1, 1), cB + hstepB + kstep, voffB);
    PG8_WAIT_V(6); PG8_BAR;
    for (;;) {
        const bool has_next = S.next(ui + 1, nxt);
        if constexpr (Sched::GATHER) {
#pragma unroll
            for (int hh = 0; hh < 2; ++hh)
#pragma unroll
                for (int i = 0; i < 2; ++i) vaN[hh][i] = has_next ? (unsigned)(S.arow(nxt, hh * HALF + gR[i]) * g.lda + gC[i]) * 2u : vaC[hh][i];
        }
        const char* nA = Sched::GATHER ? cA : (has_next ? (const char*)g.A + (size_t)nxt.am * tstepA + (size_t)nxt.acol * 2 : cA); const char* nB = has_next ? (const char*)g.Bt + (size_t)nxt.bn * tstepB : cB;
#pragma unroll 1
        for (int t = 0; t < nt; t += 2) {
            const bool last = (t == nt - 2);
            const char* a1 = cA + (size_t)(t + 1) * kstep;
            const char* a2 = last ? nA : cA + (size_t)(t + 2) * kstep; const char* b2 = last ? nB : cB + (size_t)(t + 2) * kstep;
            const char* a3 = a2 + kstep; const char* b3 = b2 + kstep;
            PG8_LDB(B0, 0, 0); PG8_LDB(B1, 0, 1); PG8_SCHED; PG8_LDA(At, 0, 0); PG8_STAGE_A(PG8_SA(1, 1), a1, 1, vaC);
            PG8_WAIT_V(8); PG8_WAIT_L(0); PG8_BAR; PG8_MMA(0, 0, At, B0); PG8_MMA(0, 1, At, B1); PG8_BAR; PG8_SCHED;
            PG8_LDA(At, 0, 1); PG8_STAGE(PG8_SB(0, 0), b2, voffB); PG8_STAGE(PG8_SB(0, 1), b2 + hstepB, voffB); if (last) { PG8_STAGE_A(PG8_SA(0, 0), a2, 0, vaN); } else { PG8_STAGE_A(PG8_SA(0, 0), a2, 0, vaC); }
            PG8_WAIT_V(8); PG8_WAIT_L(0); PG8_BAR; PG8_MMA(1, 0, At, B0); PG8_MMA(1, 1, At, B1); PG8_BAR; PG8_SCHED;
            PG8_LDB(B0, 1, 0); PG8_LDB(B1, 1, 1); PG8_SCHED; PG8_LDA(At, 1, 0); if (last) { PG8_STAGE_A(PG8_SA(0, 1), a2, 1, vaN); } else { PG8_STAGE_A(PG8_SA(0, 1), a2, 1, vaC); }
            PG8_WAIT_V(8); PG8_WAIT_L(0); PG8_BAR; PG8_MMA(0, 0, At, B0); PG8_MMA(0, 1, At, B1); PG8_BAR; PG8_SCHED;
            PG8_LDA(At, 1, 1); PG8_STAGE(PG8_SB(1, 0), b3, voffB); PG8_STAGE(PG8_SB(1, 1), b3 + hstepB, voffB); if (last) { PG8_STAGE_A(PG8_SA(1, 0), a3, 0, vaN); } else { PG8_STAGE_A(PG8_SA(1, 0), a3, 0, vaC); }
            PG8_WAIT_V(8); PG8_WAIT_L(0); PG8_BAR; PG8_MMA(1, 0, At, B0); PG8_MMA(1, 1, At, B1); PG8_BAR; PG8_SCHED;
        }
        if (wr == 0) PG8_BAR;
        E(acc, cur, wr, wc, fr, fq);
        if (!has_next) break;
#pragma unroll
        for (int a = 0; a < 2; ++a)
#pragma unroll
            for (int b = 0; b < 2; ++b)
#pragma unroll
                for (int m = 0; m < 4; ++m)
#pragma unroll
                    for (int n = 0; n < 2; ++n) acc[a][b][m][n] = (f32x4){0.f, 0.f, 0.f, 0.f};
        cur = nxt; cA = nA; cB = nB; ++ui;
        if constexpr (Sched::GATHER) {
#pragma unroll
            for (int hh = 0; hh < 2; ++hh)
#pragma unroll
                for (int i = 0; i < 2; ++i) vaC[hh][i] = vaN[hh][i];
        }
        if (wr == 1) PG8_BAR;
    }
    PG8_WAIT_V(0);
    PG8_BAR;
#undef PG8_SA
#undef PG8_SB
#undef PG8_STAGE
#undef PG8_STAGE_A
#undef PG8_LDA
#undef PG8_LDB
#undef PG8_MMA
#undef PG8_WAIT_V
#undef PG8_WAIT_L
#undef PG8_BAR
#undef PG8_SCHED
}
}
using pg8::Unit;
struct SchedG1 { static constexpr bool GATHER = false; int G, c;
    __device__ __forceinline__ bool next(int i, Unit& u) const { const int L = i * G + c; if (L >= 681) return false;
        if (L < 672) { int pm, pn; pg8::static_unit(L, 32, 21, pm, pn); u.am = pm; u.bn = pn; } else { u.am = 32; u.bn = 12 + (L - 672); }
        u.acol = 0; u.ex = 0; return true; } };
struct EpiG1 { static constexpr bool PERM = true;
    unsigned char* ws; const float* gate_bias;
    __device__ __forceinline__ void operator()(const f32x4 (&acc)[2][2][4][2], const Unit& u, int wr, int wc, int fr, int fq) const {
        const int row0 = u.am * 256 + wr * 64 + fr; const int seg = u.bn >> 2;
        if (seg < 5) {
            const size_t so = seg == 0 ? WS_UP : seg == 1 ? WS_UQ : seg == 2 ? WS_UO : seg == 3 ? WS_UK : WS_UV;
            bf16_t* base = (bf16_t*)(ws + so); const int col0 = (u.bn & 3) * 256 + wc * 32 + 8 * fq;
#pragma unroll
            for (int ai = 0; ai < 2; ++ai)
#pragma unroll
                for (int m = 0; m < 4; ++m) { bf16_t* rowp = base + (size_t)(row0 + ai * 128 + m * 16) * 1024 + col0;
#pragma unroll
                    for (int bj = 0; bj < 2; ++bj) { const f32x4 v0 = acc[ai][bj][m][0], v1 = acc[ai][bj][m][1];
                        u32x4 w; w.x = cvtpk(v0[0], v0[1]); w.y = cvtpk(v0[2], v0[3]); w.z = cvtpk(v1[0], v1[1]); w.w = cvtpk(v1[2], v1[3]);
                        *(u32x4*)(rowp + bj * 128) = w; } }
        } else {
            if (wc == 0 && fq < 2) { float* G = (float*)(ws + WS_GATES);
                const f32x4 b0 = *(const f32x4*)(gate_bias + 8 * fq), b1 = *(const f32x4*)(gate_bias + 8 * fq + 4);
#pragma unroll
                for (int ai = 0; ai < 2; ++ai)
#pragma unroll
                    for (int m = 0; m < 4; ++m) { float* rowp = G + (size_t)(row0 + ai * 128 + m * 16) * 16 + 8 * fq;
                        *(f32x4*)(rowp) = acc[ai][0][m][0] + b0; *(f32x4*)(rowp + 4) = acc[ai][0][m][1] + b1; } }
        }
    } };
struct SchedWeff { static constexpr bool GATHER = false; int G, c;
    __device__ __forceinline__ bool next(int i, Unit& u) const { if (c < 0) return false; const int L = i * G + c; if (L >= 32) return false;
        u.am = L >> 2; u.bn = L & 3; u.acol = (L & 3) * 256; u.ex = 0; return true; } };
struct EpiWeff { static constexpr bool PERM = true;
    bf16_t* W;
    __device__ __forceinline__ void operator()(const f32x4 (&acc)[2][2][4][2], const Unit& u, int wr, int wc, int fr, int fq) const {
        const int row0 = u.am * 256 + wr * 64 + fr; const int col0 = u.bn * 256 + wc * 32 + 8 * fq;
#pragma unroll
        for (int ai = 0; ai < 2; ++ai)
#pragma unroll
            for (int m = 0; m < 4; ++m) { bf16_t* rowp = W + (size_t)(row0 + ai * 128 + m * 16) * 2048 + col0;
#pragma unroll
                for (int bj = 0; bj < 2; ++bj) { const f32x4 v0 = acc[ai][bj][m][0], v1 = acc[ai][bj][m][1];
                    u32x4 w; w.x = cvtpk(v0[0], v0[1]); w.y = cvtpk(v0[2], v0[3]); w.z = cvtpk(v1[0], v1[1]); w.w = cvtpk(v1[2], v1[3]);
                    *(u32x4*)(rowp + bj * 128) = w; } }
    } };
struct SchedG2 { static constexpr bool GATHER = false; int G, c;
    __device__ __forceinline__ bool next(int i, Unit& u) const { const int L = i * G + c; if (L >= 256) return false;
        int pm, pn; pg8::static_unit(L, 32, 8, pm, pn); u.am = pm; u.bn = pn; u.acol = 0; u.ex = 0; return true; } };
struct EpiG2 { static constexpr bool PERM = false;
    const float* x; const float* g1; float* out; float* sumsq;
    __device__ __forceinline__ void operator()(const f32x4 (&acc)[2][2][4][2], const Unit& u, int wr, int wc, int fr, int fq) const {
        const int row0 = u.am * 256 + wr * 64 + fr, col0 = u.bn * 256 + wc * 32 + 4 * fq;
        f32x4 gv[2][2];
#pragma unroll
        for (int bj = 0; bj < 2; ++bj)
#pragma unroll
            for (int n = 0; n < 2; ++n) gv[bj][n] = *(const f32x4*)(g1 + col0 + bj * 128 + n * 16);
#pragma unroll
        for (int ai = 0; ai < 2; ++ai)
#pragma unroll
            for (int m = 0; m < 4; ++m) { const int row = row0 + ai * 128 + m * 16; const size_t off = (size_t)row * 2048 + col0; float ss = 0.f;
#pragma unroll
                for (int bj = 0; bj < 2; ++bj)
#pragma unroll
                    for (int n = 0; n < 2; ++n) { const f32x4 xv = *(const f32x4*)(x + off + bj * 128 + n * 16); const f32x4 h = xv + gv[bj][n] * acc[ai][bj][m][n];
                        *(f32x4*)(out + off + bj * 128 + n * 16) = h; ss += (h[0] * h[0] + h[1] * h[1]) + (h[2] * h[2] + h[3] * h[3]); }
                ss += __shfl_xor(ss, 16); ss += __shfl_xor(ss, 32);
                if (fq == 0) sumsq[(size_t)row * 32 + u.bn * 4 + wc] = ss; }
    } };
struct SchedMoE { static constexpr bool GATHER = false; int G, c, NN, btpe; const LAS int* tab;
    __device__ __forceinline__ bool next(int i, Unit& u) const { const int L = i * G + c; const int nt = tab[0]; if (L >= nt * NN) return false;
        const int tau = L / NN, pn = L - tau * NN; const int e = tab[1 + tau]; u.am = tau; u.bn = e * btpe + pn; u.acol = 0; u.ex = pn; return true; } };
struct SchedMoEG { static constexpr bool GATHER = true; int G, c, NN, btpe; const LAS int* tab; const int* ptok; const int* cnt;
    __device__ __forceinline__ bool next(int i, Unit& u) const { const int L = i * G + c; const int nt = tab[0]; if (L >= nt * NN) return false;
        const int tau = L / NN, pn = L - tau * NN; const int e = tab[1 + tau]; u.am = tau; u.bn = e * btpe + pn; u.acol = e; u.ex = pn; return true; }
    __device__ __forceinline__ int arow(const Unit& u, int r) const { const int e = u.acol; const int pos = (u.am - tab[128 + e]) * 256 + r; return pos < cnt[e * 64] ? ptok[e * 8192 + pos] : 0; } };
struct EpiUp { static constexpr bool PERM = true;
    bf16_t* H;
    __device__ __forceinline__ void operator()(const f32x4 (&acc)[2][2][4][2], const Unit& u, int wr, int wc, int fr, int fq) const {
        const int row0 = u.am * 256 + wr * 64 + fr; const int col0 = u.ex * 128 + wc * 16 + 4 * fq;
#pragma unroll
        for (int ai = 0; ai < 2; ++ai)
#pragma unroll
            for (int m = 0; m < 4; ++m) { bf16_t* rowp = H + (size_t)(row0 + ai * 128 + m * 16) * 512 + col0;
#pragma unroll
                for (int bj = 0; bj < 2; ++bj) { const f32x4 v0 = acc[ai][bj][m][0], v1 = acc[ai][bj][m][1];
                    u32x2 w; w.x = cvtpk(siluf(v0[0]) * v0[1], siluf(v0[2]) * v0[3]); w.y = cvtpk(siluf(v1[0]) * v1[1], siluf(v1[2]) * v1[3]);
                    *(u32x2*)(rowp + bj * 64) = w; } }
    } };
struct EpiDown { static constexpr bool PERM = true;
    bf16_t* Y;
    __device__ __forceinline__ void operator()(const f32x4 (&acc)[2][2][4][2], const Unit& u, int wr, int wc, int fr, int fq) const {
        const int row0 = u.am * 256 + wr * 64 + fr; const int col0 = u.ex * 256 + wc * 32 + 8 * fq;
#pragma unroll
        for (int ai = 0; ai < 2; ++ai)
#pragma unroll
            for (int m = 0; m < 4; ++m) { bf16_t* rowp = Y + (size_t)(row0 + ai * 128 + m * 16) * 2048 + col0;
#pragma unroll
                for (int bj = 0; bj < 2; ++bj) { const f32x4 v0 = acc[ai][bj][m][0], v1 = acc[ai][bj][m][1];
                    u32x4 w; w.x = cvtpk(v0[0], v0[1]); w.y = cvtpk(v0[2], v0[3]); w.z = cvtpk(v1[0], v1[1]); w.w = cvtpk(v1[2], v1[3]);
                    *(u32x4*)(rowp + bj * 128) = w; } }
    } };
__device__ __forceinline__ void p0_adaln(const Params& P, LAS unsigned char* lds) {
    const int tid = otid();
    LAS float* sc = (LAS float*)lds; LAS float* scc = sc + 2048; LAS float* red = scc + 2048; LAS float* red2 = red + 42 * 48;
    const float* c = P.in[I_C]; const float* cc = P.in[I_CCTX]; const float* wmod = P.in[I_WMOD]; const float* bmod = P.in[I_BMOD];
    float* mod = (float*)(P.ws + WS_MOD); float* modc = mod + 16384;
    for (int i = tid; i < 2048; i += 512) { sc[i] = siluf(c[i]); scc[i] = siluf(cc[i]); }
    __syncthreads();
    for (int cb = blockIdx.x; cb < 256; cb += gridDim.x) {
        const int n0 = 48 * cb; const bool has_ctx = n0 < 4096;
        if (tid < 504) { const int col4 = tid % 12, rg = tid / 12;
            const f32x4* wp = (const f32x4*)(wmod + n0) + col4;
            f32x4 a = {0.f, 0.f, 0.f, 0.f}, a2 = {0.f, 0.f, 0.f, 0.f};
#pragma unroll 7
            for (int k = rg; k < 2048; k += 42) { const f32x4 w = wp[(size_t)k * 3072]; a += w * sc[k]; if (has_ctx) a2 += w * scc[k]; }
            *(LAS f32x4*)(red + rg * 48 + col4 * 4) = a; *(LAS f32x4*)(red2 + rg * 48 + col4 * 4) = a2; }
        __syncthreads();
        if (tid < 48) { float s = 0.f; for (int r = 0; r < 42; ++r) s += red[r * 48 + tid]; mod[n0 + tid] = s + bmod[n0 + tid]; }
        else if (has_ctx && tid >= 64 && tid < 112) { const int t = tid - 64; if (n0 + t < 4096) { float s = 0.f; for (int r = 0; r < 42; ++r) s += red2[r * 48 + t]; modc[n0 + t] = s + bmod[n0 + t]; } }
        __syncthreads();
    }
}
struct TrItem { const float* src; bf16_t* dst; int K, N, rmul; const float* nscale; bool ok; };
constexpr int I_IN = 32 * 161, I_OUT = 32 * 64, I_PL = 4 * 32, I_E13 = 32 * 16, I_E2 = 8 * 64;
constexpr int B_OUT = I_IN, B_PL = B_OUT + I_OUT, B_W1 = B_PL + I_PL, B_W3 = B_W1 + 32 * I_E13, B_W2 = B_W3 + 32 * I_E13, B_END = B_W2 + 32 * I_E2;
__device__ __forceinline__ void tr_decode(const Params& P, int it, int lane, const float*& W, bf16_t*& WT, int& K, int& N, int& row_off, int& rmul, int& item) {
    if (it < B_OUT) { W = P.in[I_WIN]; K = 2048; N = INC; WT = (bf16_t*)(P.ws + WS_WINT); row_off = 0; rmul = 1; item = it; }
    else if (it < B_W1) { W = P.in[I_WOUT]; K = 2048; N = 2048; WT = (bf16_t*)(P.ws + WS_WOUTT); row_off = 0; rmul = 1; item = it - B_OUT; }
    else if (it < B_W3) { const int r = it - B_W1, e = r / I_E13; W = P.in[I_W1] + (size_t)e * 2048 * 512; K = 2048; N = 512; WT = (bf16_t*)(P.ws + WS_W13T) + (size_t)e * 1024 * 2048; row_off = 0; rmul = 2; item = r - e * I_E13; }
    else if (it < B_W2) { const int r = it - B_W3, e = r / I_E13; W = P.in[I_W3] + (size_t)e * 2048 * 512; K = 2048; N = 512; WT = (bf16_t*)(P.ws + WS_W13T) + (size_t)e * 1024 * 2048; row_off = 1; rmul = 2; item = r - e * I_E13; }
    else { const int r = it - B_W2, e = r / I_E2; W = P.in[I_W2] + (size_t)e * 512 * 2048; K = 512; N = 2048; WT = (bf16_t*)(P.ws + WS_W2T) + (size_t)e * 2048 * 512; row_off = 0; rmul = 1; item = r - e * I_E2; }
}
__device__ __forceinline__ void tr_load(const Params& P, int it, int lane, f32x4 (&v)[8]) {
    const float* W; bf16_t* WT; int K, N, row_off, rmul, item; tr_decode(P, it, lane, W, WT, K, N, row_off, rmul, item);
    const int nblk = (N + 31) >> 5, kb = item / nblk, nb = item - kb * nblk, k0 = 64 * kb, n0 = 32 * nb; const int nn = n0 + 4 * (lane & 7); const bool ok = nn < N;
#pragma unroll
    for (int i = 0; i < 8; ++i) { const int kk = 8 * i + (lane >> 3); v[i] = ok ? *(const f32x4*)(W + (size_t)(k0 + kk) * N + nn) : (f32x4){0.f, 0.f, 0.f, 0.f}; }
}
__device__ __forceinline__ void tr_store(const Params& P, int it, int lane, const f32x4 (&v)[8], LAS float* scr) {
    const float* W; bf16_t* WT; int K, N, row_off, rmul, item; tr_decode(P, it, lane, W, WT, K, N, row_off, rmul, item);
    const int nblk = (N + 31) >> 5, kb = item / nblk, nb = item - kb * nblk, k0 = 64 * kb, n0 = 32 * nb; const int c4 = lane & 7;
#pragma unroll
    for (int i = 0; i < 8; ++i) { const int kk = 8 * i + (lane >> 3); LAS float* d = scr + kk * 33 + 4 * c4; d[0] = v[i][0]; d[1] = v[i][1]; d[2] = v[i][2]; d[3] = v[i][3]; }
    LDS_WAIT(); asm volatile("" ::: "memory");
    const int cch = lane & 7;
#pragma unroll
    for (int j = 0; j < 4; ++j) { const int n = (lane >> 3) + 8 * j; const LAS float* s = scr + (8 * cch) * 33 + n;
        u32x4 o; o.x = cvtpk(s[0 * 33], s[1 * 33]); o.y = cvtpk(s[2 * 33], s[3 * 33]); o.z = cvtpk(s[4 * 33], s[5 * 33]); o.w = cvtpk(s[6 * 33], s[7 * 33]);
        *(u32x4*)(WT + (size_t)(row_off + (n0 + n) * rmul) * K + k0 + 8 * cch) = o; }
    LDS_WAIT(); asm volatile("" ::: "memory");
}
__device__ __forceinline__ void p0_transposes(const Params& P, LAS unsigned char* lds, int lo_item, int hi_item, int gw, int NGW) {
    const int tid = otid(), lane = tid & 63, wave = __builtin_amdgcn_readfirstlane(tid >> 6);
    LAS float* scr = (LAS float*)(lds + 32768 + wave * 8704);
    if (hi_item > B_END) hi_item = B_END;
    int it = lo_item + gw; if (it >= hi_item) return;
    if (it >= B_PL && it < B_W1) it += NGW * ((B_W1 - it + NGW - 1) / NGW);
    if (it >= hi_item) return;
    f32x4 va[8], vb[8];
    tr_load(P, it, lane, va);
    for (;;) {
        int nx = it + NGW; if (nx >= B_PL && nx < B_W1) nx += NGW * ((B_W1 - nx + NGW - 1) / NGW);
        const bool h1 = nx < hi_item; if (h1) tr_load(P, nx, lane, vb);
        tr_store(P, it, lane, va, scr); if (!h1) break; it = nx;
        nx = it + NGW; if (nx >= B_PL && nx < B_W1) nx += NGW * ((B_W1 - nx + NGW - 1) / NGW);
        const bool h2 = nx < hi_item; if (h2) tr_load(P, nx, lane, va);
        tr_store(P, it, lane, vb, scr); if (!h2) break; it = nx;
    }
}
__device__ __forceinline__ int moe_run_item(int r, int kbi, int wave) {
    if (r < 512) { const int m = r >> 8, rr = r & 255, e = rr >> 3, q = rr & 7, nb = (q >> 2) * 8 + wave, kb = (q & 3) * 8 + kbi; return (m == 0 ? B_W1 : B_W3) + e * I_E13 + kb * 16 + nb; }
    const int r2 = r - 512, e = r2 >> 3, nb = (r2 & 7) * 8 + wave; return B_W2 + e * I_E2 + kbi * 64 + nb;
}
__device__ __forceinline__ void moe_run(const Params& P, LAS float* scr, int r, int lane, int wave) {
    f32x4 va[8], vb[8];
    tr_load(P, moe_run_item(r, 0, wave), lane, va);
#pragma unroll 1
    for (int kbi = 0; kbi < 8; kbi += 2) {
        tr_load(P, moe_run_item(r, kbi + 1, wave), lane, vb);
        tr_store(P, moe_run_item(r, kbi, wave), lane, va, scr);
        if (kbi + 2 < 8) tr_load(P, moe_run_item(r, kbi + 2, wave), lane, va);
        tr_store(P, moe_run_item(r, kbi + 1, wave), lane, vb, scr);
    }
}
__device__ __forceinline__ void p0_moe_weights(const Params& P, LAS unsigned char* lds, int rlo, int rhi) {
    const int tid = otid(), lane = tid & 63, wave = __builtin_amdgcn_readfirstlane(tid >> 6);
    LAS float* scr = (LAS float*)(lds + 32768 + wave * 8704);
    for (int r = rlo + blockIdx.x; r < rhi; r += gridDim.x) moe_run(P, scr, r, lane, wave);
}
__device__ __forceinline__ void moe_pull_runs(const Params& P, LAS unsigned char* lds, int ctr_word, int base, int limit) {
    const int tid = otid(), lane = tid & 63, wave = __builtin_amdgcn_readfirstlane(tid >> 6);
    LAS float* scr = (LAS float*)(lds + 32768 + wave * 8704); volatile LAS int* slot = (volatile LAS int*)(lds + LDS_BYTES - 384);
    for (;;) {
        __syncthreads();
        if (tid == 0) *slot = base + atomicAdd((int*)(P.ws + WS_CTL) + ctr_word, 1);
        __syncthreads();
        const int r = *slot; if (r >= limit) break;
        moe_run(P, scr, r, lane, wave);
    }
}
constexpr int RUNS_P0 = 256, RUNS_W13 = 512, RUNS_ALL = 768;
constexpr int TR_ITEMS_EARLY = 32 * 161 + 32 * 64 + 4 * 32;
constexpr int TR_ITEMS_ALL = TR_ITEMS_EARLY + 64 * 512 + 32 * 512;
#ifndef TR_SPLIT_PCT
#define TR_SPLIT_PCT 50
#endif
constexpr int TR_ITEMS_MID = TR_ITEMS_EARLY + (int)((long)(TR_ITEMS_ALL - TR_ITEMS_EARLY) * TR_SPLIT_PCT / 100);
__device__ __forceinline__ void p0_wpool_scaled(const Params& P) {
    const float* wp = P.in[I_WPOOL]; const float* ps = P.in[I_PSC]; u32x2* o = (u32x2*)(P.ws + WS_WPOOLS);
    for (int i = blockIdx.x * 512 + threadIdx.x; i < 65536; i += gridDim.x * 512) { const f32x4 w = *(const f32x4*)(wp + (size_t)4 * i); const int g = i >> 14, d0 = (4 * i) & 255; const f32x4 sc = *(const f32x4*)(ps + g * 256 + d0);
        const f32x4 y = w * sc; u32x2 r; r.x = cvtpk(y[0], y[1]); r.y = cvtpk(y[2], y[3]); o[i] = r; }
}
__device__ __forceinline__ void p0_zero_pad(const Params& P) {
    u32x4* z = (u32x4*)((bf16_t*)(P.ws + WS_WINT) + (size_t)5152 * 2048); const int n = (NPAD - 5152) * 2048 / 8;
    for (int i = blockIdx.x * 512 + threadIdx.x; i < n; i += gridDim.x * 512) z[i] = (u32x4){0u, 0u, 0u, 0u};
}
__device__ __forceinline__ void p1_router_prep(const Params& P) {
    const int tid = otid(), lane = tid & 63, wave = tid >> 6;
    const float* mod = (const float*)(P.ws + WS_MOD); const float* g = P.in[I_N2G]; const float* wg = P.in[I_WGRP]; const float* wr = P.in[I_WRT];
    float* WRP = (float*)(P.ws + WS_WRP); float* BRP = (float*)(P.ws + WS_WRP + 448 * 1024);
    for (int idx = blockIdx.x * 512 + tid; idx < 2048 * 48; idx += gridDim.x * 512) { const int k = idx / 48, c = idx - 48 * k;
        const float w = c < 32 ? wr[k * 32 + c] : c < 36 ? wg[k * 4 + c - 32] : 0.f;
        WRP[(size_t)((k >> 2) * 48 + c) * 4 + (k & 3)] = w * g[k] * (1.0f + mod[8192 + k]); }
    if (wave == 0) for (int c = blockIdx.x; c < 48; c += gridDim.x) { float s = 0.f;
        if (c < 36) { for (int k = lane; k < 2048; k += 64) s += mod[6144 + k] * (c < 32 ? wr[k * 32 + c] : wg[k * 4 + c - 32]); s = wave_sum(s) + (c < 32 ? P.in[I_BRT][c] : P.in[I_BGRP][c - 32]); }
        if (lane == 0) BRP[c] = s; }
}
__device__ __forceinline__ void p1_xn(const Params& P, int nwg) {
    const int tid = otid(), lane = tid & 63, wave = tid >> 6;
    const int gw = blockIdx.x * 8 + wave, NGW = nwg * 8;
    const float* mod = (const float*)(P.ws + WS_MOD); const float* modc = mod + 16384; const float* g = P.in[I_N1G];
    bf16_t* XN = (bf16_t*)(P.ws + WS_XN);
    for (int pass = 0; pass < 2; ++pass) {
        const float* sh = pass == 0 ? mod : modc; const float* scl = pass == 0 ? mod + 2048 : modc + 2048;
        const float* src = pass == 0 ? P.in[I_X] : P.in[I_CTX]; const int nrows = pass == 0 ? SEQ : CTXL; const int rbase = pass == 0 ? 0 : SEQ;
        if (gw >= nrows) continue;
        f32x4 a[8], s[8];
#pragma unroll
        for (int j = 0; j < 8; ++j) { const int d0 = 4 * lane + 256 * j; const f32x4 gg = *(const f32x4*)(g + d0), sv = *(const f32x4*)(scl + d0); a[j] = gg * (sv + 1.0f); s[j] = *(const f32x4*)(sh + d0); }
        for (int r = gw; r < nrows; r += 2 * NGW) {
            const int r2 = r + NGW; const bool h2 = r2 < nrows; const int rr2 = h2 ? r2 : r;
            const f32x4* xr = (const f32x4*)(src + (size_t)r * D) + lane; const f32x4* xq = (const f32x4*)(src + (size_t)rr2 * D) + lane; f32x4 v[8], w[8]; float ss = 0.f, st = 0.f;
#pragma unroll
            for (int j = 0; j < 8; ++j) { v[j] = xr[64 * j]; w[j] = xq[64 * j]; }
#pragma unroll
            for (int j = 0; j < 8; ++j) { ss += (v[j][0] * v[j][0] + v[j][1] * v[j][1]) + (v[j][2] * v[j][2] + v[j][3] * v[j][3]); st += (w[j][0] * w[j][0] + w[j][1] * w[j][1]) + (w[j][2] * w[j][2] + w[j][3] * w[j][3]); }
            const float rstd = 1.0f / sqrtf(wave_sum(ss) * (1.0f / D) + EPSF), rstd2 = 1.0f / sqrtf(wave_sum(st) * (1.0f / D) + EPSF);
            u32x2* o = (u32x2*)(XN + (size_t)(rbase + r) * D) + lane; u32x2* o2 = (u32x2*)(XN + (size_t)(rbase + rr2) * D) + lane;
#pragma unroll
            for (int j = 0; j < 8; ++j) { const f32x4 y = v[j] * rstd * a[j] + s[j]; u32x2 pk; pk.x = cvtpk(y[0], y[1]); pk.y = cvtpk(y[2], y[3]); o[64 * j] = pk; }
            if (h2) {
#pragma unroll
                for (int j = 0; j < 8; ++j) { const f32x4 y = w[j] * rstd2 * a[j] + s[j]; u32x2 pk; pk.x = cvtpk(y[0], y[1]); pk.y = cvtpk(y[2], y[3]); o2[64 * j] = pk; } }
        }
    }
}
__device__ __forceinline__ void p3_qk_task(const Params& P, int isk, int jp, int h) {
    const int tid = otid(), o = tid >> 6, f4 = tid & 63;
    const bf16_t* U = (const bf16_t*)(P.ws + (isk ? WS_UK : WS_UQ)); const float* wc = P.in[isk ? I_WCK : I_WCQ];
    const int f0 = h * 256 + 4 * f4;
    const f32x4 w0 = *(const f32x4*)(wc + f0), w1 = *(const f32x4*)(wc + 1024 + f0), w2 = *(const f32x4*)(wc + 2048 + f0);
    const float osc = isk ? 1.0f : 0.0625f;
    u32x2 raw[2][10];
#pragma unroll
    for (int q = 0; q < 2; ++q) { const int j = 2 * jp + q; const int t0 = 64 * j, seq_lo = j < 128 ? 0 : SEQ, seq_hi = j < 128 ? SEQ : MTOT;
#pragma unroll
        for (int i = 0; i < 10; ++i) { const int t = t0 + 8 * o - 1 + i; raw[q][i] = (t >= seq_lo && t < seq_hi) ? *(const u32x2*)(U + (size_t)t * 1024 + f0) : (u32x2){0u, 0u}; } }
    bf16_t* R = (bf16_t*)(P.ws + (isk ? WS_KC : WS_QC)); bf16_t* KT = (bf16_t*)(P.ws + WS_KT);
#pragma unroll
    for (int q = 0; q < 2; ++q) { const int j = 2 * jp + q; const int t0 = 64 * j;
        float outv[8][4];
#pragma unroll
        for (int i = 0; i < 8; ++i) {
            const f32x4 a = {bflo(raw[q][i].x), bfhi(raw[q][i].x), bflo(raw[q][i].y), bfhi(raw[q][i].y)}, b = {bflo(raw[q][i + 1].x), bfhi(raw[q][i + 1].x), bflo(raw[q][i + 1].y), bfhi(raw[q][i + 1].y)},
                        c = {bflo(raw[q][i + 2].x), bfhi(raw[q][i + 2].x), bflo(raw[q][i + 2].y), bfhi(raw[q][i + 2].y)};
            const f32x4 s = a * w0 + b * w1 + c * w2;
#pragma unroll
            for (int e = 0; e < 4; ++e) outv[i][e] = siluf(s[e]) * osc;
        }
#pragma unroll
        for (int i = 0; i < 8; ++i) { u32x2 w; w.x = cvtpk(outv[i][0], outv[i][1]); w.y = cvtpk(outv[i][2], outv[i][3]); *(u32x2*)(R + (size_t)(t0 + 8 * o + i) * 1024 + f0) = w; }
        if (isk) {
#pragma unroll
            for (int e = 0; e < 4; ++e) { u32x4 w; w.x = cvtpk(outv[0][e], outv[1][e]); w.y = cvtpk(outv[2][e], outv[3][e]); w.z = cvtpk(outv[4][e], outv[5][e]); w.w = cvtpk(outv[6][e], outv[7][e]);
                *(u32x4*)(KT + ((size_t)(h * 132 + j) * 256 + 4 * f4 + e) * 64 + 8 * o) = w; } }
    }
}
__device__ __forceinline__ void p3_v_task(const Params& P, LAS unsigned char* lds, int j, int h) {
    const int tid = otid(), lane = tid & 63, wave = tid >> 6, o = tid >> 6, f4 = tid & 63;
    const int t0 = 64 * j; LAS float* wkl = (LAS float*)lds;
    const bf16_t* U = (const bf16_t*)(P.ws + WS_UV); const int f0 = h * 256 + 4 * f4;
    u32x2 vraw[8];
#pragma unroll
    for (int i = 0; i < 8; ++i) vraw[i] = *(const u32x2*)(U + (size_t)(t0 + 8 * o + i) * 1024 + f0);
    __syncthreads();
    if (wave < 2) { const int d = wave; const float* G = (const float*)(P.ws + WS_GATES) + (size_t)(t0 + lane) * 16;
        const float ig = G[(2 * d) * 4 + h], fg = G[(2 * d + 1) * 4 + h];
        float b = logsigmoidf_(fg);
        if (d == 0) {
#pragma unroll
            for (int s = 1; s < 64; s <<= 1) { const float t = __shfl_up(b, s); if (lane >= s) b += t; }
        } else {
#pragma unroll
            for (int s = 1; s < 64; s <<= 1) { const float t = __shfl_down(b, s); if (lane + s < 64) b += t; }
        }
        const float gtot = __shfl(b, d == 0 ? 63 : 0); const float e = ig - b; const float em = wave_max(e);
        const size_t ix = (size_t)(d * 4 + h) * MTOT + t0 + lane;
        ((float*)(P.ws + WS_E))[ix] = e; ((float*)(P.ws + WS_BC))[ix] = b;
        if (lane == 0) { float* gc = (float*)(P.ws + WS_GC); gc[(d * 4 + h) * 132 + j] = gtot; gc[2048 + (d * 4 + h) * 132 + j] = em; }
        wkl[d * 64 + lane] = __expf(e - em);
    }
    __syncthreads();
    float v[8][4];
#pragma unroll
    for (int i = 0; i < 8; ++i) { v[i][0] = bflo(vraw[i].x); v[i][1] = bfhi(vraw[i].x); v[i][2] = bflo(vraw[i].y); v[i][3] = bfhi(vraw[i].y); }
    bf16_t* VT = (bf16_t*)(P.ws + WS_VT); bf16_t* VSF = (bf16_t*)(P.ws + WS_VSF); bf16_t* VSB = (bf16_t*)(P.ws + WS_VSB);
    float sf[8], sb[8];
#pragma unroll
    for (int i = 0; i < 8; ++i) { sf[i] = wkl[8 * o + i]; sb[i] = wkl[64 + 8 * o + i]; }
#pragma unroll
    for (int e = 0; e < 4; ++e) { const size_t off = ((size_t)(h * 132 + j) * 272 + 4 * f4 + e) * 64 + 8 * o; u32x4 w;
        w.x = cvtpk(v[0][e], v[1][e]); w.y = cvtpk(v[2][e], v[3][e]); w.z = cvtpk(v[4][e], v[5][e]); w.w = cvtpk(v[6][e], v[7][e]); *(u32x4*)(VT + off) = w;
        w.x = cvtpk(v[0][e] * sf[0], v[1][e] * sf[1]); w.y = cvtpk(v[2][e] * sf[2], v[3][e] * sf[3]); w.z = cvtpk(v[4][e] * sf[4], v[5][e] * sf[5]); w.w = cvtpk(v[6][e] * sf[6], v[7][e] * sf[7]); *(u32x4*)(VSF + off) = w;
        w.x = cvtpk(v[0][e] * sb[0], v[1][e] * sb[1]); w.y = cvtpk(v[2][e] * sb[2], v[3][e] * sb[3]); w.z = cvtpk(v[4][e] * sb[4], v[5][e] * sb[5]); w.w = cvtpk(v[6][e] * sb[6], v[7][e] * sb[7]); *(u32x4*)(VSB + off) = w; }
    if (tid < 128) {
        const int rr = tid >> 3, oc = tid & 7; const size_t off = ((size_t)(h * 132 + j) * 272 + 256 + rr) * 64 + 8 * oc; u32x4 w1 = {0u, 0u, 0u, 0u}, wf = w1, wb = w1;
        if (rr == 0) { w1 = (u32x4){0x3f803f80u, 0x3f803f80u, 0x3f803f80u, 0x3f803f80u};
            wf.x = cvtpk(wkl[8 * oc], wkl[8 * oc + 1]); wf.y = cvtpk(wkl[8 * oc + 2], wkl[8 * oc + 3]); wf.z = cvtpk(wkl[8 * oc + 4], wkl[8 * oc + 5]); wf.w = cvtpk(wkl[8 * oc + 6], wkl[8 * oc + 7]);
            wb.x = cvtpk(wkl[64 + 8 * oc], wkl[64 + 8 * oc + 1]); wb.y = cvtpk(wkl[64 + 8 * oc + 2], wkl[64 + 8 * oc + 3]); wb.z = cvtpk(wkl[64 + 8 * oc + 4], wkl[64 + 8 * oc + 5]); wb.w = cvtpk(wkl[64 + 8 * oc + 6], wkl[64 + 8 * oc + 7]); }
        *(u32x4*)(VT + off) = w1; *(u32x4*)(VSF + off) = wf; *(u32x4*)(VSB + off) = wb; }
}
__device__ __forceinline__ void p3_pool_task(const Params& P, LAS unsigned char* lds, int r, int gi) {
    const int tid = otid(), chunk = tid & 31, cb = tid >> 5; const int win = 2 << gi, hw = win >> 1;
    const int rlo = max(r - hw, 0), rhi = min(r - hw + win, 128);
    const bf16_t* U = (const bf16_t*)(P.ws + WS_UP) + gi * 256 + 8 * chunk; LAS float* vs = (LAS float*)lds;
    __syncthreads();
    float own[4][8];
#pragma unroll
    for (int i = 0; i < 4; ++i) { const int c = cb + 16 * i; float a[8];
#pragma unroll
        for (int e = 0; e < 8; ++e) a[e] = 0.f;
        u32x4 wv[16];
#pragma unroll
        for (int q = 0; q < 16; ++q) { const int rr = rlo + q; wv[q] = (q < win && rr < rhi) ? *(const u32x4*)(U + (size_t)(rr * 64 + c) * 1024) : (u32x4){0u, 0u, 0u, 0u}; }
#pragma unroll
        for (int q = 0; q < 16; ++q) { const int rr = rlo + q; const u32x4 w = wv[q];
            const float x[8] = {bflo(w.x), bfhi(w.x), bflo(w.y), bfhi(w.y), bflo(w.z), bfhi(w.z), bflo(w.w), bfhi(w.w)};
#pragma unroll
            for (int e = 0; e < 8; ++e) a[e] += x[e];
            if (rr == r) {
#pragma unroll
                for (int e = 0; e < 8; ++e) own[i][e] = x[e]; } }
        *(LAS f32x4*)(vs + c * 256 + 8 * chunk) = (f32x4){a[0], a[1], a[2], a[3]}; *(LAS f32x4*)(vs + c * 256 + 8 * chunk + 4) = (f32x4){a[4], a[5], a[6], a[7]}; }
    __syncthreads();
    bf16_t* Dp = (bf16_t*)(P.ws + WS_A2) + gi * 256 + 8 * chunk;
#pragma unroll
    for (int i = 0; i < 4; ++i) { const int c = cb + 16 * i; const int clo = max(c - hw, 0), chi = min(c - hw + win, 64);
        f32x4 s0 = {0.f, 0.f, 0.f, 0.f}, s1 = s0;
        for (int cc = clo; cc < chi; ++cc) { s0 += *(const LAS f32x4*)(vs + cc * 256 + 8 * chunk); s1 += *(const LAS f32x4*)(vs + cc * 256 + 8 * chunk + 4); }
        const float inv = 1.0f / (float)((rhi - rlo) * (chi - clo));
        u32x4 w; w.x = cvtpk(s0[0] * inv - own[i][0], s0[1] * inv - own[i][1]); w.y = cvtpk(s0[2] * inv - own[i][2], s0[3] * inv - own[i][3]);
        w.z = cvtpk(s1[0] * inv - own[i][4], s1[1] * inv - own[i][5]); w.w = cvtpk(s1[2] * inv - own[i][6], s1[3] * inv - own[i][7]);
        *(u32x4*)(Dp + (size_t)(r * 64 + c) * 2048) = w; }
}
__device__ __forceinline__ void p3_all(const Params& P, LAS unsigned char* lds) {
    for (int t = blockIdx.x; t < 1560; t += gridDim.x) {
        if (t < 256) p3_qk_task(P, 0, t >> 2, t & 3);
        else if (t < 520) p3_qk_task(P, 1, (t - 256) >> 2, (t - 256) & 3);
        else if (t < 1048) p3_v_task(P, lds, (t - 520) >> 2, (t - 520) & 3);
        else p3_pool_task(P, lds, (t - 1048) >> 2, (t - 1048) & 3);
    }
}
__device__ __forceinline__ int step_chunk(int d, int j) { return d == 0 ? (j < 4 ? 128 + j : j - 4) : (j < 4 ? 131 - j : 131 - j); }
__device__ __forceinline__ void p4_state(const Params& P, LAS unsigned char* lds, int sb, bool dry = false) {
    const int tid = otid(), lane = tid & 63, wave = __builtin_amdgcn_readfirstlane(tid >> 6);
    const int hd = sb & 7, h = hd >> 1, d = hd & 1, lb = sb >> 3;
    LAS float* tg = (LAS float*)(lds + 110592); LAS float* te = tg + 132; LAS float* tm = te + 132; LAS float* tdec = tm + 132; LAS float* tsf = tdec + 132;
    const float* gc = (const float*)(P.ws + WS_GC);
    if (tid < 132) { const int ci = step_chunk(d, tid); tg[tid] = gc[(d * 4 + h) * 132 + ci]; te[tid] = gc[2048 + (d * 4 + h) * 132 + ci]; }
    __syncthreads();
    if (tid == 0) { float m = 0.f;
#pragma unroll 4
        for (int j = 0; j < 132; ++j) { tm[j] = m; m = tg[j] + fmaxf(m, te[j]); } }
    __syncthreads();
    if (tid < 132) { const float m = tm[tid], em = te[tid], Mf = fmaxf(m, em); tdec[tid] = __expf(m - Mf); tsf[tid] = __expf(em - Mf);
        if (lb == 0 && !dry) ((float*)(P.ws + WS_GC))[4096 + (d * 4 + h) * 132 + step_chunk(d, tid)] = m; }
    __syncthreads();
    if (wave >= 3) return;
    const int task = lb + 32 * wave; if (task >= 72) return;
    const int kq = task / 9, vq = task - 9 * kq; const bool two = vq < 8; const int vt0 = two ? 2 * vq : 16;
    const int fr = lane & 15, fq = lane >> 4;
    const bf16_t* KT = (const bf16_t*)(P.ws + WS_KT) + ((size_t)(h * 132) * 256 + kq * 32) * 64 + lane * 8;
    const bf16_t* VS = (const bf16_t*)(P.ws + (d == 0 ? WS_VSF : WS_VSB)) + ((size_t)(h * 132) * 272 + vt0 * 16) * 64 + lane * 8;
    const int vs1 = two ? 16 * 64 : 0;
    LAS unsigned char* wb = lds + wave * 9216;
    const int wofs = (lane >> 3) * 144 + 16 * (lane & 7), rofs = fr * 144 + 16 * fq;
    bf16_t* CST = (bf16_t*)(P.ws + WS_CST); float* NST = (float*)(P.ws + WS_NST);
    f32x4 C[2][2];
#pragma unroll
    for (int a = 0; a < 2; ++a)
#pragma unroll
        for (int b = 0; b < 2; ++b) C[a][b] = (f32x4){0.f, 0.f, 0.f, 0.f};
    u32x4 rg[4][8];
#define P4_LOAD(slot, jj) do { const size_t cj_ = (size_t)step_chunk(d, (jj)); const bf16_t* kp_ = KT + cj_ * (256 * 64); const bf16_t* vp_ = VS + cj_ * (272 * 64); \
        rg[slot][0] = *(const u32x4*)(kp_); rg[slot][1] = *(const u32x4*)(kp_ + 512); rg[slot][2] = *(const u32x4*)(kp_ + 1024); rg[slot][3] = *(const u32x4*)(kp_ + 1536); \
        rg[slot][4] = *(const u32x4*)(vp_); rg[slot][5] = *(const u32x4*)(vp_ + 512); rg[slot][6] = *(const u32x4*)(vp_ + vs1); rg[slot][7] = *(const u32x4*)(vp_ + vs1 + 512); } while (0)
    P4_LOAD(0, 0); P4_LOAD(1, 1); P4_LOAD(2, 2);
    for (int j0 = 0; j0 < 132; j0 += 4) {
#pragma unroll
        for (int u = 0; u < 4; ++u) { const int j = j0 + u;
            if (j + 3 < 132) P4_LOAD((u + 3) & 3, j + 3);
#pragma unroll
            for (int i = 0; i < 8; ++i) *(LAS u32x4*)(wb + (i >> 1) * 2304 + (i & 1) * 1152 + wofs) = rg[u][i];
            const int ci = step_chunk(d, j);
            if (ci < 128 && !dry) {
                const size_t rb = (((size_t)ci * 4 + h) * 2 + d) * 256;
                if (two) {
#pragma unroll
                    for (int a = 0; a < 2; ++a)
#pragma unroll
                        for (int b = 0; b < 2; ++b) { u32x2 w; w.x = cvtpk(C[a][b][0], C[a][b][1]); w.y = cvtpk(C[a][b][2], C[a][b][3]); *(u32x2*)(CST + ((rb >> 4) + (vt0 + b)) * 4096 + kq * 512 + ((2 * a + (fq >> 1)) * 16 + fr) * 8 + 4 * (fq & 1)) = w; }
                } else if (fr == 0) {
#pragma unroll
                    for (int a = 0; a < 2; ++a) *(f32x4*)(NST + rb + kq * 32 + 16 * a + 4 * fq) = C[a][0]; }
            }
            const float dec = tdec[j], sf = tsf[j];
            bf16x8 fa[2][2], fb[2][2];
#pragma unroll
            for (int t = 0; t < 2; ++t)
#pragma unroll
                for (int ks = 0; ks < 2; ++ks) { fa[t][ks] = *(const LAS bf16x8*)(wb + t * 2304 + rofs + 64 * ks); fb[t][ks] = *(const LAS bf16x8*)(wb + (2 + t) * 2304 + rofs + 64 * ks); }
#pragma unroll
            for (int a = 0; a < 2; ++a)
#pragma unroll
                for (int b = 0; b < 2; ++b) { f32x4 Dt = {0.f, 0.f, 0.f, 0.f};
#pragma unroll
                    for (int ks = 0; ks < 2; ++ks) Dt = __builtin_amdgcn_mfma_f32_16x16x32_bf16(fa[a][ks], fb[b][ks], Dt, 0, 0, 0);
                    C[a][b] = C[a][b] * dec + Dt * sf; }
        }
    }
#undef P4_LOAD
}
constexpr int O_QS = 0, O_KS = 33792, O_VT = 67584, O_WS = 106752, O_SC = 125184, O_DEN = 127232, O_RED = 127744, O_END = 131840;
__device__ __forceinline__ void p5_task(const Params& P, LAS unsigned char* lds, int c, int h) {
    const int tid = otid(), lane = tid & 63, wave = __builtin_amdgcn_readfirstlane(tid >> 6), fr = lane & 15, fq = lane >> 4;
    const int t0 = 64 * c;
    LAS float* Es = (LAS float*)(lds + O_SC); LAS float* Ms = Es + 128; LAS float* Wi = Ms + 128; LAS float* Fl = Wi + 128; LAS float* dens = (LAS float*)(lds + O_DEN); LAS float* red = (LAS float*)(lds + O_RED);
    const bf16_t* CST = (const bf16_t*)(P.ws + WS_CST);
    bf16x8 ca[2][2][8];
#define P5_CLOAD(d) do { const bf16_t* Cp = CST + ((((size_t)c * 4 + h) * 2 + (d)) * 16 + 2 * wave) * 4096 + lane * 8; _Pragma("unroll") for (int v = 0; v < 2; ++v) _Pragma("unroll") for (int ks = 0; ks < 8; ++ks) ca[d][v][ks] = *(const bf16x8*)(Cp + (size_t)v * 4096 + 512 * ks); } while (0)
    P5_CLOAD(0);
    __syncthreads();
    { const bf16_t* Q = (const bf16_t*)(P.ws + WS_QC) + (size_t)t0 * 1024 + h * 256; const bf16_t* Kc = (const bf16_t*)(P.ws + WS_KC) + (size_t)t0 * 1024 + h * 256;
#pragma unroll
      for (int i = 0; i < 4; ++i) { const int idx = tid + 512 * i, r = idx >> 5, ch = idx & 31;
          const u32x4 qv = *(const u32x4*)(Q + (size_t)r * 1024 + 8 * ch), kv = *(const u32x4*)(Kc + (size_t)r * 1024 + 8 * ch);
          *(LAS u32x4*)(lds + O_QS + r * 528 + 16 * ch) = qv; *(LAS u32x4*)(lds + O_KS + r * 528 + 16 * ch) = kv; }
      const bf16_t* VT = (const bf16_t*)(P.ws + WS_VT) + (size_t)(h * 132 + c) * (272 * 64);
      for (int idx = tid; idx < 272 * 8; idx += 512) { const int r = idx >> 3, ch = idx & 7; *(LAS u32x4*)(lds + O_VT + r * 144 + 16 * ch) = *(const u32x4*)(VT + (size_t)r * 64 + 8 * ch); } }
    if (wave < 2) { const int d = wave; const size_t ix = (size_t)(d * 4 + h) * MTOT + t0 + lane;
        const float e = ((const float*)(P.ws + WS_E))[ix], b = ((const float*)(P.ws + WS_BC))[ix]; const float m = ((const float*)(P.ws + WS_GC))[4096 + (d * 4 + h) * 132 + c];
        float pm = e;
        if (d == 0) {
#pragma unroll
            for (int s = 1; s < 64; s <<= 1) { const float t = __shfl_up(pm, s); if (lane >= s) pm = fmaxf(pm, t); }
        } else {
#pragma unroll
            for (int s = 1; s < 64; s <<= 1) { const float t = __shfl_down(pm, s); if (lane + s < 64) pm = fmaxf(pm, t); }
        }
        const float Mt = fmaxf(m, pm);
        Es[d * 64 + lane] = e; Ms[d * 64 + lane] = Mt; Wi[d * 64 + lane] = __expf(m - Mt); Fl[d * 64 + lane] = __expf(-(b + Mt)); }
    __syncthreads();
    { const int st = wave >> 1, tt0 = 2 * (wave & 1); f32x4 S0 = {0.f, 0.f, 0.f, 0.f}, S1 = S0;
#pragma unroll
      for (int ks = 0; ks < 8; ++ks) { const bf16x8 ak = *(const LAS bf16x8*)(lds + O_KS + (16 * st + fr) * 528 + 64 * ks + 16 * fq);
          const bf16x8 bq0 = *(const LAS bf16x8*)(lds + O_QS + (16 * tt0 + fr) * 528 + 64 * ks + 16 * fq), bq1 = *(const LAS bf16x8*)(lds + O_QS + (16 * tt0 + 16 + fr) * 528 + 64 * ks + 16 * fq);
          S0 = __builtin_amdgcn_mfma_f32_16x16x32_bf16(ak, bq0, S0, 0, 0, 0); S1 = __builtin_amdgcn_mfma_f32_16x16x32_bf16(ak, bq1, S1, 0, 0, 0); }
      const int s0 = 16 * st + 4 * fq;
#pragma unroll
      for (int d = 0; d < 2; ++d) { const f32x4 ev = *(const LAS f32x4*)(Es + d * 64 + s0);
#pragma unroll
          for (int q = 0; q < 2; ++q) { const int t = 16 * (tt0 + q) + fr; const float Mt = Ms[d * 64 + t]; const f32x4 S = q == 0 ? S0 : S1; float w[4];
#pragma unroll
              for (int i = 0; i < 4; ++i) { const int s = s0 + i; const bool on = d == 0 ? (s <= t) : (s >= t); w[i] = on ? __expf(ev[i] - Mt) * S[i] : 0.f; }
              u32x2 pk; pk.x = cvtpk(w[0], w[1]); pk.y = cvtpk(w[2], w[3]); *(LAS u32x2*)(lds + O_WS + (d * 64 + t) * 144 + 2 * s0) = pk; } } }
    __syncthreads();
    f32x4 acc[2][2][4];
    P5_CLOAD(1);
#undef P5_CLOAD
#pragma unroll
    for (int d = 0; d < 2; ++d) {
#pragma unroll
        for (int v = 0; v < 2; ++v)
#pragma unroll
            for (int tt = 0; tt < 4; ++tt) acc[d][v][tt] = (f32x4){0.f, 0.f, 0.f, 0.f};
#pragma unroll
        for (int ks = 0; ks < 8; ++ks) {
#pragma unroll
            for (int tt = 0; tt < 4; ++tt) { const bf16x8 bq = *(const LAS bf16x8*)(lds + O_QS + (16 * tt + fr) * 528 + 64 * ks + 16 * fq);
                acc[d][0][tt] = __builtin_amdgcn_mfma_f32_16x16x32_bf16(ca[d][0][ks], bq, acc[d][0][tt], 0, 0, 0); acc[d][1][tt] = __builtin_amdgcn_mfma_f32_16x16x32_bf16(ca[d][1][ks], bq, acc[d][1][tt], 0, 0, 0); } }
#pragma unroll
        for (int tt = 0; tt < 4; ++tt) { const float wi = Wi[d * 64 + 16 * tt + fr]; acc[d][0][tt] *= wi; acc[d][1][tt] *= wi; }
#pragma unroll
        for (int ks = 0; ks < 2; ++ks) { const bf16x8 va0 = *(const LAS bf16x8*)(lds + O_VT + (32 * wave + fr) * 144 + 64 * ks + 16 * fq), va1 = *(const LAS bf16x8*)(lds + O_VT + (32 * wave + 16 + fr) * 144 + 64 * ks + 16 * fq);
#pragma unroll
            for (int tt = 0; tt < 4; ++tt) { const bf16x8 bw = *(const LAS bf16x8*)(lds + O_WS + (d * 64 + 16 * tt + fr) * 144 + 64 * ks + 16 * fq);
                acc[d][0][tt] = __builtin_amdgcn_mfma_f32_16x16x32_bf16(va0, bw, acc[d][0][tt], 0, 0, 0); acc[d][1][tt] = __builtin_amdgcn_mfma_f32_16x16x32_bf16(va1, bw, acc[d][1][tt], 0, 0, 0); } }
    }
    { const int tt = wave & 3, d = wave >> 2; f32x4 dn = {0.f, 0.f, 0.f, 0.f};
      const float* np = (const float*)(P.ws + WS_NST) + (((size_t)c * 4 + h) * 2 + d) * 256 + 8 * fq;
#pragma unroll
      for (int ks = 0; ks < 8; ++ks) { bf16x8 an = {0, 0, 0, 0, 0, 0, 0, 0};
          if (fr == 0) { const f32x4 n0 = *(const f32x4*)(np + 32 * ks), n1 = *(const f32x4*)(np + 32 * ks + 4); u32x4 w; w.x = cvtpk(n0[0], n0[1]); w.y = cvtpk(n0[2], n0[3]); w.z = cvtpk(n1[0], n1[1]); w.w = cvtpk(n1[2], n1[3]); an = __builtin_bit_cast(bf16x8, w); }
          const bf16x8 bq = *(const LAS bf16x8*)(lds + O_QS + (16 * tt + fr) * 528 + 64 * ks + 16 * fq);
          dn = __builtin_amdgcn_mfma_f32_16x16x32_bf16(an, bq, dn, 0, 0, 0); }
      dn *= Wi[d * 64 + 16 * tt + fr];
#pragma unroll
      for (int ks = 0; ks < 2; ++ks) { const bf16x8 va = *(const LAS bf16x8*)(lds + O_VT + (256 + fr) * 144 + 64 * ks + 16 * fq); const bf16x8 bw = *(const LAS bf16x8*)(lds + O_WS + (d * 64 + 16 * tt + fr) * 144 + 64 * ks + 16 * fq);
          dn = __builtin_amdgcn_mfma_f32_16x16x32_bf16(va, bw, dn, 0, 0, 0); }
      if (fq == 0) dens[d * 64 + 16 * tt + fr] = dn[0]; }
    __syncthreads();
    float hv[2][4][4];
#pragma unroll
    for (int tt = 0; tt < 4; ++tt) { const int t = 16 * tt + fr; const float rf = 1.0f / fmaxf(fabsf(dens[t]), Fl[t]), rb = 1.0f / fmaxf(fabsf(dens[64 + t]), Fl[64 + t]);
        float s = 0.f, s2 = 0.f;
#pragma unroll
        for (int v = 0; v < 2; ++v)
#pragma unroll
            for (int i = 0; i < 4; ++i) { const float x = acc[0][v][tt][i] * rf + acc[1][v][tt][i] * rb; hv[v][tt][i] = x; s += x; s2 += x * x; }
        s += __shfl_xor(s, 16); s += __shfl_xor(s, 32); s2 += __shfl_xor(s2, 16); s2 += __shfl_xor(s2, 32);
        if (fq == 0) { red[(wave * 64 + t) * 2] = s; red[(wave * 64 + t) * 2 + 1] = s2; } }
    __syncthreads();
    { const float* hg = P.in[I_HNG] + h * 256; const bf16_t* UO = (const bf16_t*)(P.ws + WS_UO); bf16_t* A2 = (bf16_t*)(P.ws + WS_A2);
#pragma unroll
      for (int tt = 0; tt < 4; ++tt) { const int t = 16 * tt + fr; float s = 0.f, s2 = 0.f;
#pragma unroll
          for (int w = 0; w < 8; ++w) { s += red[(w * 64 + t) * 2]; s2 += red[(w * 64 + t) * 2 + 1]; }
          const float mu = s * (1.0f / 256.0f), var = fmaxf(s2 * (1.0f / 256.0f) - mu * mu, 0.f), rstd = 1.0f / sqrtf(var + EPSF);
#pragma unroll
          for (int v = 0; v < 2; ++v) { const int vf = 32 * wave + 16 * v + 4 * fq; const f32x4 g = *(const f32x4*)(hg + vf);
              const u32x2 ow = *(const u32x2*)(UO + (size_t)(t0 + t) * 1024 + h * 256 + vf); const float o[4] = {bflo(ow.x), bfhi(ow.x), bflo(ow.y), bfhi(ow.y)}; float r[4];
#pragma unroll
              for (int i = 0; i < 4; ++i) r[i] = (hv[v][tt][i] - mu) * rstd * g[i] * sigmoidf_(o[i]);
              u32x2 pk; pk.x = cvtpk(r[0], r[1]); pk.y = cvtpk(r[2], r[3]); *(u32x2*)(A2 + (size_t)(t0 + t) * 2048 + 1024 + h * 256 + vf) = pk; } } }
}
#define XB_TMO      128
#define XB_XCNT(j)  (256  + 64 * (j))
#define XB_XSUB(j)  (1280 + 64 * (j))
#define XB_XGEN(j)  (2304 + 64 * (j))
#define XB_TOP      3328
#define XB_TOPGEN   3392
#define XCD_BAR_WORDS 3456
#define XB_SPIN_CAP (1u << 18)
__device__ __forceinline__ unsigned xb_ld(unsigned* p)              { return __hip_atomic_load(p, __ATOMIC_RELAXED, __HIP_MEMORY_SCOPE_AGENT); }
__device__ __forceinline__ unsigned xb_add(unsigned* p, unsigned v) { return __hip_atomic_fetch_add(p, v, __ATOMIC_RELAXED, __HIP_MEMORY_SCOPE_AGENT); }
__device__ __forceinline__ unsigned xb_xcc_id() { return (unsigned)__builtin_amdgcn_s_getreg((3 << 11) | 20) & 0xFu; }
#define XB_SPIN(cond, bar) do { unsigned _sp = 0; while (cond) { __builtin_amdgcn_s_sleep(1); \
    if ((++_sp & 255u) == 0u) { if (xb_ld(&(bar)[XB_TMO])) break; if (_sp > XB_SPIN_CAP) { atomicAdd(&(bar)[XB_TMO], 1u); break; } } } } while (0)
struct XcdBarrier { unsigned* bar; unsigned x; volatile LAS unsigned* st; };
__device__ __forceinline__ XcdBarrier xcd_barrier_post(unsigned* bar, volatile LAS unsigned* st) {
    XcdBarrier b; b.bar = bar; b.x = xb_xcc_id(); b.st = st;
    if (threadIdx.x == 0) (void)xb_add(&bar[XB_XCNT(b.x)], 1u);
    return b;
}
__device__ __forceinline__ void xcd_barrier_complete(unsigned* bar, unsigned x, unsigned& nloc, unsigned& nx) {
    const unsigned G = gridDim.x * gridDim.y * gridDim.z;
    unsigned sum, cnt, mine, sp = 0u;
    for (;;) {
        sum = 0u; cnt = 0u; mine = 0u;
#pragma unroll
        for (unsigned j = 0; j < 16; ++j) { const unsigned c = xb_ld(&bar[XB_XCNT(j)]); sum += c; cnt += (c > 0u) ? 1u : 0u; mine = (j == x) ? c : mine; }
        if (sum == G) break;
        __builtin_amdgcn_s_sleep(1);
        if ((++sp & 255u) == 0u) { if (xb_ld(&bar[XB_TMO])) break; if (sp > XB_SPIN_CAP) { atomicAdd(&bar[XB_TMO], 1u); break; } }
    }
    nloc = mine > 0u ? mine : 1u; nx = cnt > 0u ? cnt : 1u;
}
__device__ __forceinline__ void xcd_barrier(const XcdBarrier& b) {
    asm volatile("s_waitcnt vmcnt(0)" ::: "memory");
    __syncthreads();
    if (threadIdx.x == 0) {
        unsigned* bar = b.bar;
        __builtin_amdgcn_s_waitcnt(0);
        unsigned nloc = b.st[0], nx = b.st[1];
        if (nloc == 0u) { xcd_barrier_complete(bar, b.x, nloc, nx); b.st[0] = nloc; b.st[1] = nx; }
        const unsigned old = xb_add(&bar[XB_XSUB(b.x)], 1u);
        const unsigned gen = old / nloc;
        if (old + 1u == (gen + 1u) * nloc) {
            __builtin_amdgcn_fence(__ATOMIC_RELEASE, "agent");
            asm volatile("s_waitcnt vmcnt(0)" ::: "memory");
            const unsigned og = xb_add(&bar[XB_TOP], 1u);
            const unsigned tg = og / nx;
            if (og + 1u == (tg + 1u) * nx) xb_add(&bar[XB_TOPGEN], 1u);
            else XB_SPIN(xb_ld(&bar[XB_TOPGEN]) == tg, bar);
            __builtin_amdgcn_fence(__ATOMIC_ACQUIRE, "agent");
            xb_add(&bar[XB_XGEN(b.x)], 1u);
            asm volatile("s_waitcnt vmcnt(0)" ::: "memory");
        } else {
            XB_SPIN(xb_ld(&bar[XB_XGEN(b.x)]) == gen, bar);
            __builtin_amdgcn_fence(__ATOMIC_ACQUIRE, "agent");
            asm volatile("s_waitcnt vmcnt(0)" ::: "memory");
        }
    }
    __syncthreads();
}
__device__ __forceinline__ void p7a_route(const Params& P, LAS unsigned char* lds, bool dry = false) {
    const int tid = otid(), lane = tid & 63, wave = __builtin_amdgcn_readfirstlane(tid >> 6), fr = lane & 15, fq = lane >> 4;
    const float* sumsq = (const float*)(P.ws + WS_SUMSQ); const float* BRP = (const float*)(P.ws + WS_WRP + 448 * 1024);
    int* cnt = (int*)(P.ws + WS_CTL) + (dry ? 8192 : 1024);   const size_t ro = dry ? 262144 : 0; int* eid = (int*)(P.ws + WS_ROUTE + ro); float* wtok = (float*)(P.ws + WS_ROUTE + ro + 65536); int* spos = (int*)(P.ws + WS_ROUTE + ro + 131072);
    LAS float* part = (LAS float*)lds; LAS float* lgs = part + 8 * 32 * 48;
    for (int rb = blockIdx.x; rb < SEQ / 32; rb += gridDim.x) {
        const int row0 = 32 * rb;
        f32x4 acc[2][3];
#pragma unroll
        for (int a = 0; a < 2; ++a)
#pragma unroll
            for (int c = 0; c < 3; ++c) acc[a][c] = (f32x4){0.f, 0.f, 0.f, 0.f};
        LAS unsigned char* hb = lds + wave * 16896; LAS float* rs = (LAS float*)(lds + 135168);
        const f32x4* wp = (const f32x4*)(P.ws + WS_WRP) + (size_t)(64 * wave + fq) * 48 + fr;
        __syncthreads();
        if (tid < 32) { const int r = row0 + tid; float ss = 0.f;
#pragma unroll
            for (int q = 0; q < 8; ++q) { const f32x4 v = *(const f32x4*)(sumsq + (size_t)r * 32 + 4 * q); ss += (v[0] + v[1]) + (v[2] + v[3]); }
            rs[tid] = 1.0f / sqrtf(ss * (1.0f / D) + EPSF); }
        const int lr = lane >> 5, lc = 4 * (lane & 31);
        f32x4 hv[2][16];
#pragma unroll
        for (int r = 0; r < 16; ++r) hv[0][r] = *(const f32x4*)(P.out + (size_t)(row0 + 2 * r + lr) * D + 256 * wave + lc);
        __syncthreads();
#pragma unroll
        for (int hf = 0; hf < 2; ++hf) {
            if (hf == 0) {
#pragma unroll
                for (int r = 0; r < 16; ++r) hv[1][r] = *(const f32x4*)(P.out + (size_t)(row0 + 2 * r + lr) * D + 256 * wave + 128 + lc); }
            const int dcol = 256 * wave + 128 * hf + lc;
            const f32x4 fA = *(const f32x4*)(P.in[I_N2G] + dcol) * (*(const f32x4*)((const float*)(P.ws + WS_MOD) + 8192 + dcol) + 1.0f), fS = *(const f32x4*)((const float*)(P.ws + WS_MOD) + 6144 + dcol);
#pragma unroll
            for (int r = 0; r < 16; ++r) *(LAS f32x4*)(hb + (2 * r + lr) * 528 + 4 * lc) = hv[hf][r];
            if (!dry) {
#pragma unroll
                for (int r = 0; r < 16; ++r) { const f32x4 y = hv[hf][r] * rs[2 * r + lr] * fA + fS; u32x2 pk; pk.x = cvtpk(y[0], y[1]); pk.y = cvtpk(y[2], y[3]);
                    *(u32x2*)((bf16_t*)(P.ws + WS_FN) + (size_t)(row0 + 2 * r + lr) * D + dcol) = pk; } }
#pragma unroll 2
            for (int j = 0; j < 8; ++j) { const f32x4 a0 = *(const LAS f32x4*)(hb + fr * 528 + 64 * j + 16 * fq), a1 = *(const LAS f32x4*)(hb + (16 + fr) * 528 + 64 * j + 16 * fq);
                f32x4 b[3];
#pragma unroll
                for (int c = 0; c < 3; ++c) b[c] = wp[(size_t)(32 * hf + 4 * j) * 48 + 16 * c];
#pragma unroll
                for (int i = 0; i < 4; ++i)
#pragma unroll
                    for (int c = 0; c < 3; ++c) { acc[0][c] = __builtin_amdgcn_mfma_f32_16x16x4f32(a0[i], b[c][i], acc[0][c], 0, 0, 0); acc[1][c] = __builtin_amdgcn_mfma_f32_16x16x4f32(a1[i], b[c][i], acc[1][c], 0, 0, 0); } }
        }
        __syncthreads();
#pragma unroll
        for (int a = 0; a < 2; ++a)
#pragma unroll
            for (int c = 0; c < 3; ++c)
#pragma unroll
                for (int i = 0; i < 4; ++i) part[(wave * 32 + 16 * a + 4 * fq + i) * 48 + 16 * c + fr] = acc[a][c][i];
        __syncthreads();
        { const int row = tid >> 4, pc = tid & 15;
#pragma unroll
          for (int c = 0; c < 3; ++c) { float s = 0.f;
#pragma unroll
              for (int w = 0; w < 8; ++w) s += part[(w * 32 + row) * 48 + 16 * c + pc];
              lgs[row * 48 + 16 * c + pc] = s; } }
        __syncthreads();
        if (tid < 32) { const int r = row0 + tid; const float rstd = rs[tid];
            float lg[4];
#pragma unroll
            for (int i = 0; i < 4; ++i) lg[i] = lgs[tid * 48 + 32 + i] * rstd + BRP[32 + i];
            int gs = 0; float gm = lg[0];
#pragma unroll
            for (int i = 1; i < 4; ++i) if (lg[i] > gm) { gm = lg[i]; gs = i; }
            float gsum = 0.f;
#pragma unroll
            for (int i = 0; i < 4; ++i) gsum += __expf(lg[i] - gm);
            const float pg = 1.0f / gsum;
            float sl[8];
#pragma unroll
            for (int i = 0; i < 8; ++i) sl[i] = lgs[tid * 48 + gs * 8 + i] * rstd + BRP[gs * 8 + i];
            int i1 = 0; float m1 = sl[0];
#pragma unroll
            for (int i = 1; i < 8; ++i) if (sl[i] > m1) { m1 = sl[i]; i1 = i; }
            int i2 = i1 == 0 ? 1 : 0; float m2 = sl[i2];
#pragma unroll
            for (int i = 0; i < 8; ++i) if (i != i1 && sl[i] > m2) { m2 = sl[i]; i2 = i; }
            const float p2 = __expf(m2 - m1); const float w1 = pg / (1.0f + p2), w2 = pg * p2 / (1.0f + p2);
            const int e1 = gs * 8 + i1, e2 = gs * 8 + i2;
            LAS int* lcnt = (LAS int*)(lds + 135168 + 256); LAS int* lbase = lcnt + 32;
            lcnt[tid] = 0; LDS_WAIT();
            const int q1 = __hip_atomic_fetch_add(lcnt + e1, 1, __ATOMIC_RELAXED, __HIP_MEMORY_SCOPE_WORKGROUP), q2 = __hip_atomic_fetch_add(lcnt + e2, 1, __ATOMIC_RELAXED, __HIP_MEMORY_SCOPE_WORKGROUP);
            LDS_WAIT();
            { const int n = lcnt[tid]; lbase[tid] = n > 0 ? atomicAdd(cnt + tid * 64, n) : 0; }
            LDS_WAIT();
            const int s1 = lbase[e1] + q1, s2 = lbase[e2] + q2;
            if (!dry) { int* ptok = (int*)(P.ws + WS_PTOK); ptok[e1 * 8192 + s1] = r; ptok[e2 * 8192 + s2] = r; }
            eid[2 * r] = e1; eid[2 * r + 1] = e2; wtok[2 * r] = w1; wtok[2 * r + 1] = w2; spos[2 * r] = s1; spos[2 * r + 1] = s2; }
    }
}
__device__ __forceinline__ void moe_tables(const Params& P, LAS int* tab) {
    __syncthreads();
    if (threadIdx.x == 0) { const int* cnt = (const int*)(P.ws + WS_CTL) + 1024; int tt = 0;
        for (int e = 0; e < NEXP; ++e) { const int c = __hip_atomic_load(cnt + e * 64, __ATOMIC_RELAXED, __HIP_MEMORY_SCOPE_AGENT); const int nt = (c + 255) >> 8; tab[128 + e] = tt; for (int i = 0; i < nt; ++i) tab[1 + tt + i] = e; tt += nt; }
        tab[0] = tt; }
    __syncthreads();
}
__device__ __forceinline__ void p7b_scatter(const Params& P, const LAS int* tab) {
    const int tid = otid(), lane = tid & 63, wave = tid >> 6; const int gw = blockIdx.x * 8 + wave, NGW = gridDim.x * 8;
    const float* mod = (const float*)(P.ws + WS_MOD); const float* g = P.in[I_N2G]; const float* sumsq = (const float*)(P.ws + WS_SUMSQ);
    const int* eid = (const int*)(P.ws + WS_ROUTE); const int* spos = (const int*)(P.ws + WS_ROUTE + 131072); bf16_t* FNS = (bf16_t*)(P.ws + WS_FNS);
    for (int r = gw; r < SEQ; r += NGW) {
        float ss = lane < 32 ? sumsq[(size_t)r * 32 + lane] : 0.f; ss = wave_sum(ss);
        const float rstd = 1.0f / sqrtf(ss * (1.0f / D) + EPSF);
        const int e1 = eid[2 * r], e2 = eid[2 * r + 1]; const size_t sl1 = (size_t)tab[128 + e1] * 256 + spos[2 * r], sl2 = (size_t)tab[128 + e2] * 256 + spos[2 * r + 1];
        const f32x4* hr = (const f32x4*)(P.out + (size_t)r * D) + lane; u32x2* o1 = (u32x2*)(FNS + sl1 * D) + lane; u32x2* o2 = (u32x2*)(FNS + sl2 * D) + lane;
#pragma unroll
        for (int j = 0; j < 8; ++j) { const int d0 = 4 * lane + 256 * j; const f32x4 hv = hr[64 * j]; const f32x4 gg = *(const f32x4*)(g + d0), sc = *(const f32x4*)(mod + 8192 + d0), sh = *(const f32x4*)(mod + 6144 + d0);
            const f32x4 y = hv * rstd * gg * (sc + 1.0f) + sh; u32x2 w; w.x = cvtpk(y[0], y[1]); w.y = cvtpk(y[2], y[3]); o1[64 * j] = w; o2[64 * j] = w; }
    }
}
__device__ __forceinline__ void p10_final(const Params& P, const LAS int* tab, bool dry = false) {
    const int tid = otid(), lane = tid & 63, wave = tid >> 6; const int gw = blockIdx.x * 8 + wave, NGW = gridDim.x * 8;
    const float* mod = (const float*)(P.ws + WS_MOD); const float* fg = P.in[I_FG];
    const int* eid = (const int*)(P.ws + WS_ROUTE); const float* wtok = (const float*)(P.ws + WS_ROUTE + 65536); const int* spos = (const int*)(P.ws + WS_ROUTE + 131072); const bf16_t* Y = (const bf16_t*)(P.ws + WS_Y);
    for (int r = gw; r < SEQ; r += NGW) {
        const int e1 = eid[2 * r], e2 = eid[2 * r + 1]; const size_t sl1 = (size_t)tab[128 + e1] * 256 + spos[2 * r], sl2 = (size_t)tab[128 + e2] * 256 + spos[2 * r + 1];
        const float w1 = wtok[2 * r], w2 = wtok[2 * r + 1];
        f32x4* hr = (f32x4*)(P.out + (size_t)r * D) + lane; f32x4* wrp = dry ? (f32x4*)((float*)(P.ws + WS_FNS) + (size_t)r * D) + lane : hr; const u32x2* y1 = (const u32x2*)(Y + sl1 * D) + lane; const u32x2* y2 = (const u32x2*)(Y + sl2 * D) + lane;
        f32x4 v[8]; float ss = 0.f;
#pragma unroll
        for (int j = 0; j < 8; ++j) { const int d0 = 4 * lane + 256 * j; const f32x4 hv = hr[64 * j]; const f32x4 g2 = *(const f32x4*)(mod + 10240 + d0); const u32x2 a = y1[64 * j], b = y2[64 * j];
            const f32x4 ya = {bflo(a.x), bfhi(a.x), bflo(a.y), bfhi(a.y)}, yb = {bflo(b.x), bfhi(b.x), bflo(b.y), bfhi(b.y)};
            v[j] = hv + g2 * (ya * w1 + yb * w2); ss += (v[j][0] * v[j][0] + v[j][1] * v[j][1]) + (v[j][2] * v[j][2] + v[j][3] * v[j][3]); }
        const float rstd = 1.0f / sqrtf(wave_sum(ss) * (1.0f / D) + EPSF);
#pragma unroll
        for (int j = 0; j < 8; ++j) { const int d0 = 4 * lane + 256 * j; wrp[64 * j] = v[j] * rstd * *(const f32x4*)(fg + d0); }
    }
}
__device__ __forceinline__ void p10_plain(const Params& P, const float* src) {
    const int tid = otid(), lane = tid & 63, wave = tid >> 6; const int gw = blockIdx.x * 8 + wave, NGW = gridDim.x * 8; const float* fg = P.in[I_FG];
    for (int r = gw; r < SEQ; r += NGW) { const f32x4* sr = (const f32x4*)(src + (size_t)r * D) + lane; f32x4* hr = (f32x4*)(P.out + (size_t)r * D) + lane; f32x4 v[8]; float ss = 0.f;
#pragma unroll
        for (int j = 0; j < 8; ++j) { v[j] = sr[64 * j]; ss += (v[j][0] * v[j][0] + v[j][1] * v[j][1]) + (v[j][2] * v[j][2] + v[j][3] * v[j][3]); }
        const float rstd = 1.0f / sqrtf(wave_sum(ss) * (1.0f / D) + EPSF);
#pragma unroll
        for (int j = 0; j < 8; ++j) hr[64 * j] = v[j] * rstd * *(const f32x4*)(fg + 4 * lane + 256 * j); }
}
#ifndef STAGE
#define STAGE 4
#endif
#ifndef N_LAUNCHES
#define N_LAUNCHES 1
#endif
constexpr int NPHASE = 12;
__global__ void __launch_bounds__(512, 2) mk_fwd(Params P) {
    extern __shared__ __attribute__((aligned(16))) unsigned char lds_raw[];
    LAS unsigned char* lds = (LAS unsigned char*)lds_raw;
    LAS int* tab = (LAS int*)(lds + LDSCTL_OFF + 4096);
    const int lo = P.ph_lo, hi = P.ph_hi; const int G = gridDim.x, bx = blockIdx.x;
#ifndef ONLYP
#define ONLYP -1
#endif
#define IN(k) ((ONLYP < 0 || ONLYP == (k)) && lo <= (k) && (k) < hi)
#ifndef TS_PHASE
#define TS_PHASE -1
#endif
#ifndef TS_MULT
#define TS_MULT 4
#endif
#ifndef P4SEL
#define P4SEL 0
#endif
#ifndef REP_PHASE
#define REP_PHASE -1
#endif
#define NREP(k) ((k) == REP_PHASE ? 2 : 1)
    { volatile LAS unsigned* st = (volatile LAS unsigned*)(lds + LDS_BYTES - 64); if (threadIdx.x < 2) st[threadIdx.x] = 0u; __syncthreads(); }
    XcdBarrier xbar = xcd_barrier_post((unsigned*)(P.ws + WS_CTL) + 4096, (volatile LAS unsigned*)(lds + LDS_BYTES - 64));
#if N_LAUNCHES == 2
#define SEAM(k) do { if ((k) + 1 < hi) { xcd_barrier(xbar); } if (TS_PHASE >= 0 && bx == 0 && threadIdx.x == 0) ((volatile LAS unsigned long long*)(lds + LDS_BYTES - 256))[(k) + 1] = __builtin_amdgcn_s_memrealtime(); } while (0)
#else
#define SEAM(k) do { if ((k) + 1 < hi) { cg::this_grid().sync(); } } while (0)
#endif
    if (TS_PHASE >= 0 && bx == 0 && threadIdx.x == 0) ((volatile LAS unsigned long long*)(lds + LDS_BYTES - 256))[0] = __builtin_amdgcn_s_memrealtime();
    if (IN(0)) { for (int rep_ = 0; rep_ < NREP(0); ++rep_) { if (rep_) xcd_barrier(xbar);
#if STAGE >= 2
        p0_adaln(P, lds); p0_transposes(P, lds, 0, TR_ITEMS_EARLY, bx * 8 + (threadIdx.x >> 6), G * 8); if (STAGE >= 4) p0_moe_weights(P, lds, 0, RUNS_P0); p0_zero_pad(P); p0_wpool_scaled(P);
#endif
        } SEAM(0); }
    if (IN(1)) { for (int rep_ = 0; rep_ < NREP(1); ++rep_) { if (rep_) xcd_barrier(xbar);
#if STAGE >= 2
        p1_router_prep(P);
        if (bx < G - 32) p1_xn(P, G - 32);
        else { pg8::Gemm g{(const bf16_t*)(P.ws + WS_WOUTT), (const bf16_t*)(P.ws + WS_WPOOLS), 2048, 256, 256}; SchedWeff S{32, bx - (G - 32)}; EpiWeff E{(bf16_t*)(P.ws + WS_WOUTT)};
            pg8::gemm_phase<EpiWeff, SchedWeff>(lds, g, S, E); }
#endif
        } SEAM(1); }
    if (IN(2)) { for (int rep_ = 0; rep_ < NREP(2); ++rep_) { if (rep_) xcd_barrier(xbar);
#if STAGE >= 2
        pg8::Gemm g{(const bf16_t*)(P.ws + WS_XN), (const bf16_t*)(P.ws + WS_WINT), 2048, 2048, 2048}; SchedG1 S{G, bx}; EpiG1 E{P.ws, P.in[I_GB]};
        pg8::gemm_phase<EpiG1, SchedG1>(lds, g, S, E);
        if (STAGE >= 4 && rep_ == 0) moe_pull_runs(P, lds, 1100, RUNS_P0, RUNS_W13);
#endif
        } SEAM(2); }
    if (IN(3)) { for (int rep_ = 0; rep_ < NREP(3); ++rep_) { if (rep_) xcd_barrier(xbar);
#if STAGE >= 2
        p3_all(P, lds);
#endif
        } SEAM(3); }
    if (IN(4)) { for (int rep_ = 0; rep_ < NREP(4); ++rep_) { if (rep_) xcd_barrier(xbar);
#if STAGE >= 2
        if (STAGE >= 3) { p4_state(P, lds, bx, rep_ > 0); }
#endif
        } SEAM(4); }
    if (IN(5)) { for (int rep_ = 0; rep_ < NREP(5); ++rep_) { if (rep_) xcd_barrier(xbar);
#if STAGE >= 3
        for (int t = bx; t < 512; t += G) p5_task(P, lds, t >> 2, t & 3);
#elif STAGE == 2
        { bf16_t* A2 = (bf16_t*)(P.ws + WS_A2); for (int i = bx * 512 + threadIdx.x; i < SEQ * 128; i += G * 512) { const int r = i >> 7, c8 = i & 127; *(u32x4*)(A2 + (size_t)r * 2048 + 1024 + 8 * c8) = (u32x4){0u, 0u, 0u, 0u}; } }
#endif
        } SEAM(5); }
    if (IN(6)) { for (int rep_ = 0; rep_ < NREP(6); ++rep_) { if (rep_) xcd_barrier(xbar);
#if STAGE >= 2
        pg8::Gemm g{(const bf16_t*)(P.ws + WS_A2), (const bf16_t*)(P.ws + WS_WOUTT), 2048, 2048, 2048}; SchedG2 S{G, bx};
        EpiG2 E{P.in[I_X], (const float*)(P.ws + WS_MOD) + 4096, P.out, (float*)(P.ws + WS_SUMSQ)};
        pg8::gemm_phase<EpiG2, SchedG2>(lds, g, S, E);
#endif
        } SEAM(6); }
    if (IN(7)) { for (int rep_ = 0; rep_ < NREP(7); ++rep_) { if (rep_) xcd_barrier(xbar);
#if STAGE >= 4
        p7a_route(P, lds, rep_ == 0 && NREP(7) == 2);
#endif
        } SEAM(7); }
    if (IN(9)) { for (int rep_ = 0; rep_ < NREP(9); ++rep_) { if (rep_) xcd_barrier(xbar);
#if STAGE >= 4
        if (rep_ == 0) moe_tables(P, tab);
        pg8::Gemm g{(const bf16_t*)(P.ws + WS_FN), (const bf16_t*)(P.ws + WS_W13T), 2048, 2048, 2048}; SchedMoEG S{G, bx, 4, 4, tab, (const int*)(P.ws + WS_PTOK), (const int*)(P.ws + WS_CTL) + 1024}; EpiUp E{(bf16_t*)(P.ws + WS_H)};
        pg8::gemm_phase<EpiUp, SchedMoEG>(lds, g, S, E);
        if (rep_ == 0) moe_pull_runs(P, lds, 1101, RUNS_W13, RUNS_ALL);
#endif
        } SEAM(9); }
    if (IN(10)) { for (int rep_ = 0; rep_ < NREP(10); ++rep_) { if (rep_) xcd_barrier(xbar);
#if STAGE >= 4
        if (lo == 10) moe_tables(P, tab);
        pg8::Gemm g{(const bf16_t*)(P.ws + WS_H), (const bf16_t*)(P.ws + WS_W2T), 512, 512, 512}; SchedMoE S{G, bx, 8, 8, tab}; EpiDown E{(bf16_t*)(P.ws + WS_Y)};
        pg8::gemm_phase<EpiDown, SchedMoE>(lds, g, S, E);
#endif
        } SEAM(10); }
    if (IN(11)) { for (int rep_ = 0; rep_ < NREP(11); ++rep_) { if (rep_) xcd_barrier(xbar);
#if STAGE >= 4
        if (lo == 11) moe_tables(P, tab);
        p10_final(P, tab, rep_ == 0 && NREP(11) == 2);
#elif STAGE >= 2
        p10_plain(P, P.out);
#else
        p10_plain(P, P.in[I_X]);
#endif
    } }
    if (TS_PHASE >= 0 && bx == 0 && threadIdx.x == 0) { volatile LAS unsigned long long* ts = (volatile LAS unsigned long long*)(lds + LDS_BYTES - 256);
        const unsigned long long tend = __builtin_amdgcn_s_memrealtime(); const int k = TS_PHASE; const unsigned long long t1 = k >= 11 ? tend : ts[k + 1]; const unsigned long long span = t1 - ts[k == 9 ? 8 : k];
        const unsigned long long until = tend + span * TS_MULT; while (__builtin_amdgcn_s_memrealtime() < until) __builtin_amdgcn_s_sleep(8); }
#undef IN
#undef SEAM
}

extern "C" void kernel_launch(void* const* d_in, const int* in_sizes, int n_in, void* d_out, int out_size, void* d_ws, size_t ws_size, hipStream_t stream) {
    static int grid = 0;
    if (grid == 0) {
        if (n_in != 24 || out_size != SEQ * D || ws_size < WS_END) { fprintf(stderr, "kernel_launch: unexpected shapes (n_in %d, out %d, ws %zu < %zu)\n", n_in, out_size, ws_size, (size_t)WS_END); grid = -1; return; }
        int dev = 0, cus = 0, per_cu = 0;
        if (hipGetDevice(&dev) != hipSuccess || hipDeviceGetAttribute(&cus, hipDeviceAttributeMultiprocessorCount, dev) != hipSuccess) { grid = -1; return; }
        if (hipFuncSetAttribute((const void*)mk_fwd, hipFuncAttributeMaxDynamicSharedMemorySize, LDS_BYTES) != hipSuccess) { fprintf(stderr, "kernel_launch: hipFuncSetAttribute failed\n"); grid = -1; return; }
        if (hipOccupancyMaxActiveBlocksPerMultiprocessor(&per_cu, (const void*)mk_fwd, 512, LDS_BYTES) != hipSuccess || per_cu < 1) { fprintf(stderr, "kernel_launch: occupancy query says %d\n", per_cu); per_cu = 1; }
        (void)hipGetLastError();
        grid = cus;
        if (grid < 160) { fprintf(stderr, "kernel_launch: %d CUs is too few for this kernel's phase split\n", grid); grid = -1; return; }
    }
    if (grid < 0) return;
    (void)hipMemsetAsync((char*)d_ws + WS_CTL, 0, 1 * MiB, stream);
    Params p{};
    for (int i = 0; i < 24; ++i) p.in[i] = (const float*)d_in[i];
    p.out = (float*)d_out; p.ws = (unsigned char*)d_ws;
#if N_LAUNCHES == 2
    p.ph_lo = 0; p.ph_hi = NPHASE;
    hipLaunchKernelGGL(mk_fwd, dim3(grid), dim3(512), LDS_BYTES, stream, p);
#elif N_LAUNCHES == 1
    p.ph_lo = 0; p.ph_hi = NPHASE;
    void* args[] = {&p};
    hipError_t e = hipLaunchCooperativeKernel((const void*)mk_fwd, dim3(grid), dim3(512), args, LDS_BYTES, stream);
    if (e != hipSuccess) fprintf(stderr, "cooperative launch failed: %s (grid %d)\n", hipGetErrorString(e), grid);
#else
    for (int k = 0; k < NPHASE; ++k) { p.ph_lo = k; p.ph_hi = k + 1; hipLaunchKernelGGL(mk_fwd, dim3(grid), dim3(512), LDS_BYTES, stream, p);
#ifdef REP_PHASE
        if (k == REP_PHASE) hipLaunchKernelGGL(mk_fwd, dim3(grid), dim3(512), LDS_BYTES, stream, p);
#endif
    }
#endif
}
```
